# Optimizing an MI355X kernel written in HIP

```python
import jax, jax.numpy as jnp
from jax import lax
import numpy as np

D_MODEL = 1024
BATCH = 4
SEQ = 4096
DEPTH = 1

GRID_W = 64
CTX_LEN = 256
CONV_CH = 512
CONV_GROUPS = 8
LRU_WIDTH = 512
LRU_HEADS = 8
LRU_HEAD_DIM = LRU_WIDTH // LRU_HEADS
MIX_WIDTH = CONV_CH + LRU_WIDTH
IN_COLS = 2 * CONV_CH + 2 * LRU_WIDTH
CONV_TAPS = 31
LRU_CONV_TAPS = 4
LRU_C = 8.0
N_GROUPS = 4
EXPERTS_PER_GROUP = 8
N_EXPERTS = N_GROUPS * EXPERTS_PER_GROUP
TOP_K = 2
D_EXPERT = 1024
MOE_BLOCK = 256
EPS = 1e-6

kernel_name = "hybrid_conformer_rglru_hmoe_prefix_dit"


def rms_norm(x, g):
    xf = x.astype(jnp.float32)
    y = xf * lax.rsqrt(jnp.mean(xf * xf, axis=-1, keepdims=True) + EPS)
    return (y * g.astype(jnp.float32)).astype(x.dtype)


def layer_norm(x, g, b):
    xf = x.astype(jnp.float32)
    mu = jnp.mean(xf, axis=-1, keepdims=True)
    var = jnp.mean(jnp.square(xf - mu), axis=-1, keepdims=True)
    y = (xf - mu) * lax.rsqrt(var + EPS)
    return (y * g.astype(jnp.float32) + b.astype(jnp.float32)).astype(x.dtype)


def modulate(h, shift, scale):
    return h * (1.0 + scale) + shift


def dwconv(u, w, b, pad):
    C = u.shape[-1]
    y = lax.conv_general_dilated(u, w.astype(u.dtype)[:, None, :], window_strides=(1,),
                                 padding=[pad], dimension_numbers=("NWC", "WIO", "NWC"),
                                 feature_group_count=C)
    return y + b.astype(u.dtype)


def conformer_conv(val, gate, dw, b, ln_g, ln_b):
    u = val * jax.nn.sigmoid(gate)
    u = dwconv(u, dw, b, (CONV_TAPS // 2, CONV_TAPS // 2))
    return jax.nn.silu(layer_norm(u, ln_g, ln_b))


def rglru_coeffs(u, wa, ba, wx, bx, lam):
    B_, L, C = u.shape
    uf = u.astype(jnp.float32)
    uh = uf.reshape(B_, L, LRU_HEADS, LRU_HEAD_DIM)
    r = jax.nn.sigmoid(jnp.einsum("blhi,hij->blhj", uh, wa.astype(jnp.float32)).reshape(B_, L, C) + ba.astype(jnp.float32))
    i = jax.nn.sigmoid(jnp.einsum("blhi,hij->blhj", uh, wx.astype(jnp.float32)).reshape(B_, L, C) + bx.astype(jnp.float32))
    log_a = -LRU_C * r * jax.nn.softplus(-lam.astype(jnp.float32))
    a = jnp.exp(log_a)
    mult = jnp.sqrt(jnp.maximum(-jnp.expm1(2.0 * log_a), 1e-12))
    return a, mult * i * uf


def linear_scan(a, b, h0):
    b = b.at[:, 0].add(a[:, 0] * h0)

    def combine(left, right):
        return (left[0] * right[0], right[0] * left[1] + right[1])

    _, h = lax.associative_scan(combine, (a, b), axis=1)
    return h


def directional_scan(a, b, h0, reverse):
    if reverse:
        return jnp.flip(linear_scan(jnp.flip(a, 1), jnp.flip(b, 1), h0), 1)
    return linear_scan(a, b, h0)


def swiglu_expert(xb, w1, w3, w2):
    return (jax.nn.silu(xb @ w1) * (xb @ w3)) @ w2


def hier_moe(h, wg, bg, we, be, w1, w3, w2):
    T, D = h.shape
    hf = h.astype(jnp.float32)
    pg = jax.nn.softmax(hf @ wg.astype(jnp.float32) + bg.astype(jnp.float32), axis=-1)
    p_grp, grp = lax.top_k(pg, 1)
    p_grp, grp = p_grp[:, 0], grp[:, 0]
    le = jnp.einsum("td,dge->tge", hf, we.astype(jnp.float32)) + be.astype(jnp.float32)
    le = jnp.take_along_axis(le, grp[:, None, None], axis=1)[:, 0]
    top_p, top_i = lax.top_k(jax.nn.softmax(le, axis=-1), TOP_K)
    gates = p_grp[:, None] * top_p / jnp.sum(top_p, axis=-1, keepdims=True)
    eid = (grp[:, None] * EXPERTS_PER_GROUP + top_i).reshape(-1)
    tok = jnp.repeat(jnp.arange(T, dtype=jnp.int32), TOP_K)
    gflat = gates.reshape(-1)
    order = jnp.argsort(eid)
    e_sorted, tok_sorted, g_sorted = eid[order], tok[order], gflat[order]
    counts = jnp.bincount(eid, length=N_EXPERTS)
    padded = ((counts + MOE_BLOCK - 1) // MOE_BLOCK) * MOE_BLOCK
    start = jnp.cumsum(counts) - counts
    pend = jnp.cumsum(padded)
    pstart = pend - padded
    dest = pstart[e_sorted] + (jnp.arange(T * TOP_K) - start[e_sorted])
    n_rows = -(-(T * TOP_K) // MOE_BLOCK) * MOE_BLOCK + N_EXPERTS * MOE_BLOCK
    n_blocks = n_rows // MOE_BLOCK
    tok_buf = jnp.zeros((n_rows,), jnp.int32).at[dest].set(tok_sorted)
    gate_buf = jnp.zeros((n_rows,), h.dtype).at[dest].set(g_sorted.astype(h.dtype))
    blk_e = jnp.minimum(jnp.searchsorted(pend, jnp.arange(n_blocks) * MOE_BLOCK, side="right"), N_EXPERTS - 1)
    xb = h[tok_buf].reshape(n_blocks, MOE_BLOCK, D)

    def run(args):
        xblk, e = args
        return swiglu_expert(xblk, w1[e], w3[e], w2[e])

    yb = lax.map(run, (xb, blk_e)).reshape(n_rows, D)
    return jnp.zeros_like(h).at[tok_buf].add(yb * gate_buf[:, None])


def setup_inputs(seed: int = 0) -> dict:
    key = jax.random.key(seed)
    ks = jax.random.split(key, 32)
    f32 = jnp.float32

    def n(k, shape, s):
        return jax.random.normal(k, shape, f32) * s

    L = DEPTH
    u = jax.random.uniform(ks[20], (L, 2, LRU_WIDTH), f32, 0.9, 0.999)
    a0 = u ** (1.0 / LRU_C)
    lam = jnp.log(a0) - jnp.log1p(-a0)
    return {
        "x": n(ks[0], (BATCH, SEQ, D_MODEL), 1.0),
        "c": n(ks[1], (BATCH, D_MODEL), 1.0),
        "ctx": n(ks[2], (BATCH, CTX_LEN, D_MODEL), 1.0),
        "c_ctx": n(ks[3], (D_MODEL,), 1.0),
        "w_ada": n(ks[4], (L, D_MODEL, 6 * D_MODEL), 0.5 * D_MODEL ** -0.5),
        "b_ada": n(ks[5], (L, 6 * D_MODEL), 0.02),
        "norm1_g": 1.0 + n(ks[6], (L, D_MODEL), 0.02),
        "norm2_g": 1.0 + n(ks[7], (L, D_MODEL), 0.02),
        "w_in": n(ks[8], (L, D_MODEL, IN_COLS), D_MODEL ** -0.5),
        "conv_dw": n(ks[9], (L, CONV_TAPS, CONV_CH), CONV_TAPS ** -0.5),
        "conv_b": n(ks[10], (L, CONV_CH), 0.02),
        "conv_ln_g": 1.0 + n(ks[11], (L, CONV_CH), 0.02),
        "conv_ln_b": n(ks[12], (L, CONV_CH), 0.02),
        "lru_conv_w": n(ks[13], (L, LRU_CONV_TAPS, LRU_WIDTH), LRU_CONV_TAPS ** -0.5),
        "lru_conv_b": n(ks[14], (L, LRU_WIDTH), 0.02),
        "lru_wa": n(ks[15], (L, 2, LRU_HEADS, LRU_HEAD_DIM, LRU_HEAD_DIM), LRU_HEAD_DIM ** -0.5),
        "lru_ba": n(ks[16], (L, 2, LRU_WIDTH), 0.02),
        "lru_wx": n(ks[17], (L, 2, LRU_HEADS, LRU_HEAD_DIM, LRU_HEAD_DIM), LRU_HEAD_DIM ** -0.5),
        "lru_bx": n(ks[18], (L, 2, LRU_WIDTH), 0.02),
        "lru_lam": lam,
        "w_out": n(ks[19], (L, MIX_WIDTH, D_MODEL), MIX_WIDTH ** -0.5),
        "router_wg": n(ks[21], (L, D_MODEL, N_GROUPS), D_MODEL ** -0.5),
        "router_bg": n(ks[22], (L, N_GROUPS), 0.01),
        "router_we": n(ks[23], (L, D_MODEL, N_GROUPS, EXPERTS_PER_GROUP), D_MODEL ** -0.5),
        "router_be": n(ks[24], (L, N_GROUPS, EXPERTS_PER_GROUP), 0.01),
        "w1": n(ks[25], (L, N_EXPERTS, D_MODEL, D_EXPERT), D_MODEL ** -0.5),
        "w3": n(ks[26], (L, N_EXPERTS, D_MODEL, D_EXPERT), D_MODEL ** -0.5),
        "w2": n(ks[27], (L, N_EXPERTS, D_EXPERT, D_MODEL), D_EXPERT ** -0.5),
        "final_g": 1.0 + n(ks[28], (D_MODEL,), 0.02),
    }


def reference(x, c, ctx, c_ctx, w_ada, b_ada, norm1_g, norm2_g, w_in, conv_dw, conv_b, conv_ln_g, conv_ln_b,
              lru_conv_w, lru_conv_b, lru_wa, lru_ba, lru_wx, lru_bx, lru_lam, w_out,
              router_wg, router_bg, router_we, router_be, w1, w3, w2, final_g):
    B, S, D = x.shape
    rows = S // GRID_W
    xc = ctx
    Cc, Lw = CONV_CH, LRU_WIDTH
    for l in range(DEPTH):
        last = l == DEPTH - 1
        mod_l = (jax.nn.silu(c) @ w_ada[l] + b_ada[l])[:, None, :]
        mod_c = jax.nn.silu(c_ctx) @ w_ada[l] + b_ada[l]
        sh1, sc1, g1, sh2, sc2, g2 = jnp.split(mod_l, 6, axis=-1)
        csh1, csc1, cg1, csh2, csc2, cg2 = jnp.split(mod_c, 6, axis=-1)

        zl = modulate(rms_norm(x, norm1_g[l]), sh1, sc1) @ w_in[l]
        zc = modulate(rms_norm(xc, norm1_g[l]), csh1, csc1) @ w_in[l]

        conv_l = conformer_conv(zl[..., :Cc].reshape(B * rows, GRID_W, Cc),
                                zl[..., Cc:2 * Cc].reshape(B * rows, GRID_W, Cc),
                                conv_dw[l], conv_b[l], conv_ln_g[l], conv_ln_b[l]).reshape(B, S, Cc)

        ul = dwconv(zl[..., 2 * Cc:2 * Cc + Lw], lru_conv_w[l], lru_conv_b[l], (2, 1))
        uc = dwconv(zc[..., 2 * Cc:2 * Cc + Lw], lru_conv_w[l], lru_conv_b[l], (2, 1))
        h_lat = jnp.zeros((B, S, Lw), jnp.float32)
        h_ctx = jnp.zeros((B, uc.shape[1], Lw), jnp.float32)
        for d, reverse in enumerate((False, True)):
            ac, bc = rglru_coeffs(uc, lru_wa[l, d], lru_ba[l, d], lru_wx[l, d], lru_bx[l, d], lru_lam[l, d])
            al, bl = rglru_coeffs(ul, lru_wa[l, d], lru_ba[l, d], lru_wx[l, d], lru_bx[l, d], lru_lam[l, d])
            hc_d = directional_scan(ac, bc, jnp.zeros((B, Lw), jnp.float32), reverse)
            h0 = hc_d[:, 0] if reverse else hc_d[:, -1]
            h_lat = h_lat + directional_scan(al, bl, h0, reverse)
            if not last:
                h_ctx = h_ctx + hc_d
        lru_l = h_lat.astype(x.dtype) * jax.nn.gelu(zl[..., 2 * Cc + Lw:])

        x = x + g1 * (jnp.concatenate([conv_l, lru_l], axis=-1) @ w_out[l])

        if not last:
            conv_c = conformer_conv(zc[..., :Cc], zc[..., Cc:2 * Cc],
                                    conv_dw[l], conv_b[l], conv_ln_g[l], conv_ln_b[l])
            lru_c = h_ctx.astype(xc.dtype) * jax.nn.gelu(zc[..., 2 * Cc + Lw:])
            xc = xc + cg1 * (jnp.concatenate([conv_c, lru_c], axis=-1) @ w_out[l])

        h2 = modulate(rms_norm(x, norm2_g[l]), sh2, sc2).reshape(B * S, D)
        y2 = hier_moe(h2, router_wg[l], router_bg[l], router_we[l], router_be[l], w1[l], w3[l], w2[l])
        x = x + g2 * y2.reshape(B, S, D)

        if not last:
            hc2 = modulate(rms_norm(xc, norm2_g[l]), csh2, csc2).reshape(-1, D)
            yc2 = hier_moe(hc2, router_wg[l], router_bg[l], router_we[l], router_be[l], w1[l], w3[l], w2[l])
            xc = xc + cg2 * yc2.reshape(xc.shape)

    return rms_norm(x, final_g)
```

```cpp
#include <hip/hip_runtime.h>
#include <cstdio>
#include <cstdint>
namespace pg8 {
#define PG8_LAS __attribute__((address_space(3)))
typedef unsigned short bf16_t;
typedef short bf16x8 __attribute__((ext_vector_type(8)));
typedef float f32x4 __attribute__((ext_vector_type(4)));
typedef unsigned u32x4 __attribute__((ext_vector_type(4)));
constexpr int BM = 256, BK = 64, HALF = 128, HTB = HALF * BK * 2  , STAGE_BYTES = 8 * HTB, NXCD = 8, WGM = 8;

__host__ __device__ __forceinline__ int lds_byte(int r, int c) { const int st = (r >> 4) * 2 + (c >> 5), rr = r & 15, cc = c & 31, ob = rr * 64 + cc * 2; return st * 1024 + (ob ^ (((ob >> 9) & 1) << 5)); }
__host__ __device__ __forceinline__ void stage_rc(int b, int& R, int& C) { const int st = b / 1024, sb = b % 1024, swz = sb ^ (((sb >> 9) & 1) << 5); R = (st >> 1) * 16 + swz / 64; C = (st & 1) * 32 + (swz % 64) / 2; }
__host__ __device__ __forceinline__ int perm32(int rho) { const int n = rho >> 4, i = rho & 15; return 8 * (i >> 2) + 4 * n + (i & 3); }

struct Unit { int pm, pn; };
struct Gemm { const bf16_t* A; const bf16_t* Bt; int M, N, K; };

struct StaticOrder {
    int nM, nN, nwg, G, c;
    __host__ __device__ void init(int M, int N, int G_, int c_) { nM = M / BM; nN = N / BM; nwg = nM * nN; G = G_; c = c_; }
    __host__ __device__ bool next(int i, Unit& u) const {
        const long L = (long)i * G + c; if (L >= nwg) return false;
        int wgid = (int)L; { const int q = nwg / NXCD, r = nwg % NXCD, xcd = wgid % NXCD, off = wgid / NXCD; wgid = (xcd < r ? xcd * (q + 1) : r * (q + 1) + (xcd - r) * q) + off; }
        const int nig = WGM * nN, gid = wgid / nig, fm = gid * WGM, gsz = (nM - fm) < WGM ? (nM - fm) : WGM;
        u.pm = fm + ((wgid % nig) % gsz); u.pn = (wgid % nig) / gsz; return true;
    }
    __device__ __forceinline__ void a_ready(const Unit&) const {}
    __device__ __forceinline__ void done(const Unit&) const {}
};

__device__ __forceinline__ unsigned cvt_pk_bf16(float lo, float hi) { unsigned r; asm volatile("v_cvt_pk_bf16_f32 %0, %1, %2" : "=v"(r) : "v"(lo), "v"(hi)); return r; }
typedef unsigned u32x2 __attribute__((ext_vector_type(2)));
__device__ __forceinline__ float silu_f(float v) { return v / (1.0f + __expf(-v)); }

struct EpiStoreBf16 {
    static constexpr bool PERM = true, AFTER_DRAIN = false;
    bf16_t* O; int ldc;
    __device__ __forceinline__ void operator()(const f32x4 (&acc)[2][2][4][2], const Unit& u, int wr, int wc, int fr, int fq) const {
        const int row0 = u.pm * BM + wr * 64 + fr, col0 = u.pn * BM + wc * 32 + 8 * fq;
#pragma unroll
        for (int ai = 0; ai < 2; ++ai)
#pragma unroll
            for (int m = 0; m < 4; ++m) { bf16_t* rowp = O + (size_t)(row0 + ai * HALF + m * 16) * ldc + col0;
#pragma unroll
                for (int bj = 0; bj < 2; ++bj) { const f32x4 v0 = acc[ai][bj][m][0], v1 = acc[ai][bj][m][1];
                    u32x4 w; w.x = cvt_pk_bf16(v0[0], v0[1]); w.y = cvt_pk_bf16(v0[2], v0[3]); w.z = cvt_pk_bf16(v1[0], v1[1]); w.w = cvt_pk_bf16(v1[2], v1[3]);
                    *(u32x4*)(rowp + bj * HALF) = w; } }
    }
};
struct EpiResid {
    static constexpr bool PERM = true, AFTER_DRAIN = false;
    const float* x; const float* g; int gp; float* out;
    __device__ __forceinline__ void operator()(const f32x4 (&acc)[2][2][4][2], const Unit& u, int wr, int wc, int fr, int fq) const {
        const int row0 = u.pm * BM + wr * 64 + fr, col0 = u.pn * BM + wc * 32 + 8 * fq;
        const float* gb = g + (size_t)((u.pm * BM) >> 12) * gp + col0;
        f32x4 gv[2][2];
#pragma unroll
        for (int bj = 0; bj < 2; ++bj) { gv[bj][0] = *(const f32x4*)(gb + bj * HALF); gv[bj][1] = *(const f32x4*)(gb + bj * HALF + 4); }
#pragma unroll
        for (int ai = 0; ai < 2; ++ai)
#pragma unroll
            for (int m = 0; m < 4; ++m) { const size_t off = (size_t)(row0 + ai * HALF + m * 16) * 1024 + col0;
#pragma unroll
                for (int bj = 0; bj < 2; ++bj) {
                    const f32x4 x0 = *(const f32x4*)(x + off + bj * HALF), x1 = *(const f32x4*)(x + off + bj * HALF + 4);
                    *(f32x4*)(out + off + bj * HALF) = x0 + gv[bj][0] * acc[ai][bj][m][0];
                    *(f32x4*)(out + off + bj * HALF + 4) = x1 + gv[bj][1] * acc[ai][bj][m][1]; } }
    }
};
struct EpiSwiglu {
    static constexpr bool PERM = true, AFTER_DRAIN = false;
    bf16_t* H;
    __device__ __forceinline__ void operator()(const f32x4 (&acc)[2][2][4][2], const Unit& u, int wr, int wc, int fr, int fq) const {
        const int row0 = u.pm * BM + wr * 64 + fr, col0 = (u.pn & 7) * 128 + wc * 16 + 4 * fq;
#pragma unroll
        for (int ai = 0; ai < 2; ++ai)
#pragma unroll
            for (int m = 0; m < 4; ++m) { bf16_t* rowp = H + (size_t)(row0 + ai * HALF + m * 16) * 1024 + col0;
#pragma unroll
                for (int bj = 0; bj < 2; ++bj) { const f32x4 v0 = acc[ai][bj][m][0], v1 = acc[ai][bj][m][1];
                    u32x2 w; w.x = cvt_pk_bf16(silu_f(v0[0]) * v0[1], silu_f(v0[2]) * v0[3]); w.y = cvt_pk_bf16(silu_f(v1[0]) * v1[1], silu_f(v1[2]) * v1[3]);
                    *(u32x2*)(rowp + bj * 64) = w; } }
    }
};
struct EpiGateBf16 {
    static constexpr bool PERM = true, AFTER_DRAIN = false;
    bf16_t* Y; const float* gate;
    __device__ __forceinline__ void operator()(const f32x4 (&acc)[2][2][4][2], const Unit& u, int wr, int wc, int fr, int fq) const {
        const int row0 = u.pm * BM + wr * 64 + fr, col0 = (u.pn & 3) * BM + wc * 32 + 8 * fq;
#pragma unroll
        for (int ai = 0; ai < 2; ++ai)
#pragma unroll
            for (int m = 0; m < 4; ++m) { const int row = row0 + ai * HALF + m * 16; const float gt = gate[row]; bf16_t* rowp = Y + (size_t)row * 1024 + col0;
#pragma unroll
                for (int bj = 0; bj < 2; ++bj) { const f32x4 v0 = acc[ai][bj][m][0] * gt, v1 = acc[ai][bj][m][1] * gt;
                    u32x4 w; w.x = cvt_pk_bf16(v0[0], v0[1]); w.y = cvt_pk_bf16(v0[2], v0[3]); w.z = cvt_pk_bf16(v1[0], v1[1]); w.w = cvt_pk_bf16(v1[2], v1[3]);
                    *(u32x4*)(rowp + bj * HALF) = w; } }
    }
};
struct OrderInProj {
    StaticOrder so;
    __device__ bool next(int i, Unit& u) const {
        const long L = (long)i * so.G + so.c;
        if (L < so.nwg) return so.next(i, u);
        const int j = (int)(L - so.nwg); if (j >= 8) return false;
        u.pm = 64 + (j >> 1); u.pn = 4 + (j & 1); return true;
    }
    __device__ __forceinline__ void a_ready(const Unit&) const {}
    __device__ __forceinline__ void done(const Unit&) const {}
};
struct OrderMoe {
    int G, c, ntn, nunits; const PG8_LAS int* tile_e;
    __device__ bool next(int i, Unit& u) const {
        const long L = (long)i * G + c; if (L >= nunits) return false;
        const int rt = (int)L / ntn, pn = (int)L % ntn;
        u.pm = rt; u.pn = tile_e[rt] * ntn + pn; return true;
    }
    __device__ __forceinline__ void a_ready(const Unit&) const {}
    __device__ __forceinline__ void done(const Unit&) const {}
};
template <class Epi, class Sched, bool ALIGN_EPI = false, bool SP2 = false>
__device__ __forceinline__ void gemm_phase(PG8_LAS unsigned char* lds, const Gemm g, const Sched& S, const Epi& E) {
    const int tid = threadIdx.x, wid = __builtin_amdgcn_readfirstlane(tid >> 6), lane = tid & 63, wr = wid >> 2, wc = wid & 3, fr = lane & 15, fq = lane >> 4;
    const int K = g.K, nt = K / BK;
    unsigned voffA[2], voffB[2];
#pragma unroll
    for (int i = 0; i < 2; ++i) { int R, C; stage_rc(tid * 16 + i * 8192, R, C); const int Rb = Epi::PERM ? ((R & ~31) + perm32(R & 31)) : R;
        voffA[i] = (unsigned)(R * K + C) * 2u; voffB[i] = (unsigned)(Rb * K + C) * 2u; }
    const size_t kstep = (size_t)(BK * 2);
    const size_t hstep = (size_t)HALF * K * 2;
    const size_t tstep = 2 * hstep;
    const unsigned ldsw = (unsigned)wid * 1024u;
    const int aoff = lds_byte(wr * 64 + fr, fq * 8), boff = lds_byte(wc * 32 + fr, fq * 8);
#define PG8_SA(b, h) (((b) * 2 + (h)) * HTB)
#define PG8_SB(b, h) ((4 + (b) * 2 + (h)) * HTB)
#define PG8_STAGE(bufoff, gbase, voff) do { _Pragma("unroll") for (int _i = 0; _i < 2; ++_i) \
        __builtin_amdgcn_global_load_lds((const unsigned*)((const char*)(gbase) + (voff)[_i]), (PG8_LAS unsigned*)(lds + (bufoff) + ldsw + _i * 8192), 16, 0, 0); } while (0)
#define PG8_LDA(dst, b, h) do { _Pragma("unroll") for (int m = 0; m < 4; ++m) _Pragma("unroll") for (int k = 0; k < 2; ++k) dst[m][k] = *(const PG8_LAS bf16x8*)(lds + PG8_SA(b, h) + aoff + m * 2048 + k * 1024); } while (0)
#define PG8_LDB(dst, b, h) do { _Pragma("unroll") for (int n = 0; n < 2; ++n) _Pragma("unroll") for (int k = 0; k < 2; ++k) dst[n][k] = *(const PG8_LAS bf16x8*)(lds + PG8_SB(b, h) + boff + n * 2048 + k * 1024); } while (0)
#define PG8_MMA(ai, bj, At, Bt) do { __builtin_amdgcn_s_setprio(1); _Pragma("unroll") for (int m = 0; m < 4; ++m) _Pragma("unroll") for (int n = 0; n < 2; ++n) _Pragma("unroll") for (int k = 0; k < 2; ++k) \
        acc[ai][bj][m][n] = __builtin_amdgcn_mfma_f32_16x16x32_bf16(Bt[n][k], At[m][k], acc[ai][bj][m][n], 0, 0, 0); __builtin_amdgcn_s_setprio(0); } while (0)
#define PG8_WAIT_V(n) asm volatile("s_waitcnt vmcnt(" #n ")" ::: "memory")
#define PG8_WAIT_L(n) asm volatile("s_waitcnt lgkmcnt(" #n ")" ::: "memory")
#define PG8_BAR __builtin_amdgcn_s_barrier()
#define PG8_SCHED __builtin_amdgcn_sched_barrier(0)
    Unit cur, nxt; int ui = 0;
    if (!S.next(0, cur)) return;
    f32x4 acc[2][2][4][2];
#pragma unroll
    for (int a = 0; a < 2; ++a)
#pragma unroll
        for (int b = 0; b < 2; ++b)
#pragma unroll
            for (int m = 0; m < 4; ++m)
#pragma unroll
                for (int n = 0; n < 2; ++n) acc[a][b][m][n] = (f32x4){0.f, 0.f, 0.f, 0.f};
    bf16x8 At[4][2], B0[2][2], B1[2][2];
    const char* cA = (const char*)g.A + (size_t)cur.pm * tstep; const char* cB = (const char*)g.Bt + (size_t)cur.pn * tstep;
    S.a_ready(cur);
    if constexpr (SP2) {
        PG8_STAGE(PG8_SB(0, 0), cB, voffB); PG8_STAGE(PG8_SB(0, 1), cB + hstep, voffB); PG8_STAGE(PG8_SA(0, 0), cA, voffA); PG8_STAGE(PG8_SA(0, 1), cA + hstep, voffA);
        if (wr == 1) PG8_BAR;
        PG8_WAIT_V(2); PG8_BAR;
        PG8_STAGE(PG8_SB(1, 0), cB + kstep, voffB); PG8_STAGE(PG8_SA(1, 0), cA + kstep, voffA); PG8_STAGE(PG8_SB(1, 1), cB + hstep + kstep, voffB);
        PG8_WAIT_V(6); PG8_BAR;
    } else {
        PG8_STAGE(PG8_SB(0, 0), cB, voffB); PG8_STAGE(PG8_SA(0, 0), cA, voffA); PG8_STAGE(PG8_SB(0, 1), cB + hstep, voffB); PG8_STAGE(PG8_SA(0, 1), cA + hstep, voffA);
        if (wr == 1) PG8_BAR;
        PG8_WAIT_V(4); PG8_BAR;
        PG8_STAGE(PG8_SB(1, 0), cB + kstep, voffB); PG8_STAGE(PG8_SA(1, 0), cA + kstep, voffA); PG8_STAGE(PG8_SB(1, 1), cB + hstep + kstep, voffB);
        PG8_WAIT_V(6); PG8_BAR;
    }
    for (;;) {
        const bool has_next = S.next(ui + 1, nxt);
        const char* nA = has_next ? (const char*)g.A + (size_t)nxt.pm * tstep : cA; const char* nB = has_next ? (const char*)g.Bt + (size_t)nxt.pn * tstep : cB;
        for (int t = 0; t < nt; t += 2) {
            const bool last = (t == nt - 2);
            const char* a1 = cA + (size_t)(t + 1) * kstep;
            const char* a2 = last ? nA : cA + (size_t)(t + 2) * kstep; const char* b2 = last ? nB : cB + (size_t)(t + 2) * kstep;
            const char* a3 = a2 + kstep; const char* b3 = b2 + kstep;
            if (last && has_next) S.a_ready(nxt);
            if constexpr (SP2) {
            PG8_LDB(B0, 0, 0); PG8_LDB(B1, 0, 1); PG8_SCHED; PG8_LDA(At, 0, 0); PG8_STAGE(PG8_SA(1, 1), a1 + hstep, voffA);
            PG8_WAIT_V(8); PG8_WAIT_L(0); PG8_BAR; PG8_MMA(0, 0, At, B0); PG8_MMA(0, 1, At, B1); PG8_BAR; PG8_SCHED;
            PG8_LDA(At, 0, 1); PG8_STAGE(PG8_SB(0, 0), b2, voffB); PG8_STAGE(PG8_SB(0, 1), b2 + hstep, voffB); PG8_STAGE(PG8_SA(0, 0), a2, voffA);
            PG8_WAIT_V(8); PG8_WAIT_L(0); PG8_BAR; PG8_MMA(1, 0, At, B0); PG8_MMA(1, 1, At, B1); PG8_BAR; PG8_SCHED;
            PG8_LDB(B0, 1, 0); PG8_LDB(B1, 1, 1); PG8_SCHED; PG8_LDA(At, 1, 0); PG8_STAGE(PG8_SA(0, 1), a2 + hstep, voffA);
            PG8_WAIT_V(8); PG8_WAIT_L(0); PG8_BAR; PG8_MMA(0, 0, At, B0); PG8_MMA(0, 1, At, B1); PG8_BAR; PG8_SCHED;
            PG8_LDA(At, 1, 1); PG8_STAGE(PG8_SB(1, 0), b3, voffB); PG8_STAGE(PG8_SB(1, 1), b3 + hstep, voffB); PG8_STAGE(PG8_SA(1, 0), a3, voffA);
            PG8_WAIT_V(8); PG8_WAIT_L(0); PG8_BAR; PG8_MMA(1, 0, At, B0); PG8_MMA(1, 1, At, B1); PG8_BAR; PG8_SCHED;
            } else {
            PG8_LDB(B0, 0, 0); PG8_SCHED; PG8_LDA(At, 0, 0); PG8_STAGE(PG8_SA(1, 1), a1 + hstep, voffA);
            PG8_WAIT_L(8); PG8_BAR; PG8_WAIT_L(0); PG8_MMA(0, 0, At, B0); PG8_BAR; PG8_SCHED;
            PG8_LDB(B1, 0, 1); PG8_STAGE(PG8_SB(0, 0), b2, voffB);
            PG8_BAR; PG8_WAIT_L(0); PG8_MMA(0, 1, At, B1); PG8_BAR;
            PG8_LDA(At, 0, 1); PG8_STAGE(PG8_SA(0, 0), a2, voffA);
            PG8_BAR; PG8_WAIT_L(0); PG8_MMA(1, 0, At, B0); PG8_BAR; PG8_SCHED;
            PG8_STAGE(PG8_SB(0, 1), b2 + hstep, voffB);
            PG8_WAIT_V(6); PG8_BAR; PG8_MMA(1, 1, At, B1); PG8_BAR;
            PG8_LDB(B0, 1, 0); PG8_SCHED; PG8_LDA(At, 1, 0); PG8_STAGE(PG8_SA(0, 1), a2 + hstep, voffA);
            PG8_WAIT_L(8); PG8_BAR; PG8_WAIT_L(0); PG8_MMA(0, 0, At, B0); PG8_BAR; PG8_SCHED;
            PG8_LDB(B1, 1, 1); PG8_STAGE(PG8_SB(1, 0), b3, voffB);
            PG8_BAR; PG8_WAIT_L(0); PG8_MMA(0, 1, At, B1); PG8_BAR;
            PG8_LDA(At, 1, 1); PG8_STAGE(PG8_SA(1, 0), a3, voffA);
            PG8_BAR; PG8_WAIT_L(0); PG8_MMA(1, 0, At, B0); PG8_BAR; PG8_SCHED;
            PG8_STAGE(PG8_SB(1, 1), b3 + hstep, voffB);
            PG8_WAIT_V(6); PG8_BAR; PG8_MMA(1, 1, At, B1); PG8_BAR;
            }
        }
        if constexpr (ALIGN_EPI) { if (wr == 0) PG8_BAR; }
        if constexpr (!Epi::AFTER_DRAIN) { E(acc, cur, wr, wc, fr, fq); S.done(cur); }
        if (!has_next) break;
#pragma unroll
        for (int a = 0; a < 2; ++a)
#pragma unroll
            for (int b = 0; b < 2; ++b)
#pragma unroll
                for (int m = 0; m < 4; ++m)
#pragma unroll
                    for (int n = 0; n < 2; ++n) acc[a][b][m][n] = (f32x4){0.f, 0.f, 0.f, 0.f};
        cur = nxt; cA = nA; cB = nB; ++ui;
        if constexpr (ALIGN_EPI) { if (wr == 1) PG8_BAR; }
    }
    PG8_WAIT_V(0);
    if constexpr (!ALIGN_EPI) { if (wr == 0) PG8_BAR; }
    PG8_BAR;
    if constexpr (Epi::AFTER_DRAIN) { E.fused(acc, cur, wr, wc, fr, fq, lds, wid, lane); S.done(cur); }
#undef PG8_SA
#undef PG8_SB
#undef PG8_STAGE
#undef PG8_LDA
#undef PG8_LDB
#undef PG8_MMA
#undef PG8_WAIT_V
#undef PG8_WAIT_L
#undef PG8_BAR
#undef PG8_SCHED
}
}

constexpr int NWAVES = 8;
#ifndef MK_N_LAUNCHES
#define MK_N_LAUNCHES 1
#endif
constexpr int NPH = 12;
constexpr int N_LAUNCHES = MK_N_LAUNCHES;

constexpr int NB = 4, SEQ = 4096, D = 1024, T = NB * SEQ, CTXL = 256, TC = NB * CTXL, TA = T + TC;
constexpr int CC = 512, LW = 512, INC = 2048, NE = 32, NSLOT = 2 * T + NE * 256;
constexpr int NCH = 68;
constexpr float EPS = 1e-6f;

constexpr size_t MiB = 1u << 20;
constexpr size_t WS_CTL = 0, CTL_ZERO_BYTES = 64 * 1024;
constexpr size_t WS_MOD = 1 * MiB;
constexpr size_t WS_RW = WS_MOD + 128 * 1024;
constexpr size_t WS_RB = WS_RW + 160 * 1024;
constexpr size_t WS_WG = 2 * MiB;
constexpr size_t WS_WIN = 3 * MiB;
constexpr size_t WS_WOUT = 7 * MiB;
constexpr size_t WS_AGG = 9 * MiB;
constexpr size_t WS_CARRY = 12 * MiB;
constexpr size_t WS_ROUTE = 13 * MiB;
constexpr size_t WS_RG = WS_ROUTE + 256 * 1024;
constexpr size_t WS_SLOT = WS_RG + 128 * 1024;
constexpr size_t WS_GATE = WS_SLOT + 128 * 1024;
constexpr size_t WS_W13 = 16 * MiB;
constexpr size_t WS_W2 = 144 * MiB;
constexpr size_t WS_RA = 208 * MiB;
constexpr size_t WS_RBB = 288 * MiB;
constexpr size_t WS_RC = 368 * MiB;
constexpr size_t WS_END = 448 * MiB;
static_assert((size_t)NSLOT * 1024 * 2 <= 80 * MiB && (size_t)TA * 2048 * 2 <= 80 * MiB && WS_GATE + (size_t)NSLOT * 4 <= WS_W13, "ws map");
constexpr int CW_CNT = 64;
constexpr int CW_BAR = 1024;

constexpr int RING_OFF = 0, RING_BYTES = 131072;
constexpr int SCR_BYTES = 147456;
constexpr int MISC_OFF = SCR_BYTES;
constexpr int LDS_BYTES = SCR_BYTES + 1024;
#define GAS __attribute__((address_space(1)))
#define LAS __attribute__((address_space(3)))
typedef unsigned short bf16;
typedef unsigned v4u __attribute__((ext_vector_type(4)));
typedef float f32x4 __attribute__((ext_vector_type(4)));
typedef short bf16x8 __attribute__((ext_vector_type(8)));
typedef GAS unsigned gu32;
typedef GAS unsigned long long gu64;
#define RLX_AGENT __ATOMIC_RELAXED, __HIP_MEMORY_SCOPE_AGENT
#define LDS_WAIT() asm volatile("s_waitcnt lgkmcnt(0)" ::: "memory")
#define VM_WAIT() asm volatile("s_waitcnt vmcnt(0)" ::: "memory")
__device__ __forceinline__ unsigned long long rt() { return __builtin_amdgcn_s_memrealtime(); }
__device__ __forceinline__ unsigned f2bf(float f) { unsigned u = __builtin_bit_cast(unsigned, f); return (u + 0x7fffu + ((u >> 16) & 1u)) >> 16; }
__device__ __forceinline__ unsigned pk2(float lo, float hi) { return f2bf(lo) | (f2bf(hi) << 16); }

#define XB_TMO      128
#define XB_XCNT(j)  (256  + 64 * (j))
#define XB_XSUB(j)  (1280 + 64 * (j))
#define XB_XGEN(j)  (2304 + 64 * (j))
#define XB_TOP      3328
#define XB_TOPGEN   3392
#define XCD_BAR_WORDS 3456
#define XB_SPIN_CAP (1u << 18)

__device__ __forceinline__ unsigned xb_ld(unsigned* p)              { return __hip_atomic_load(p, __ATOMIC_RELAXED, __HIP_MEMORY_SCOPE_AGENT); }
__device__ __forceinline__ unsigned xb_add(unsigned* p, unsigned v) { return __hip_atomic_fetch_add(p, v, __ATOMIC_RELAXED, __HIP_MEMORY_SCOPE_AGENT); }
__device__ __forceinline__ unsigned xb_xcc_id() { return (unsigned)__builtin_amdgcn_s_getreg((3 << 11) | 20) & 0xFu; }
#define XB_SPIN(cond, bar) do { unsigned _sp = 0; while (cond) { __builtin_amdgcn_s_sleep(1); \
    if ((++_sp & 255u) == 0u) { if (xb_ld(&(bar)[XB_TMO])) break; if (_sp > XB_SPIN_CAP) { atomicAdd(&(bar)[XB_TMO], 1u); break; } } } } while (0)

struct XcdBarrier {
    unsigned* bar; unsigned x;
    volatile LAS unsigned* st;
};

__device__ __forceinline__ XcdBarrier xcd_barrier_post(unsigned* bar, volatile LAS unsigned* st) {
    XcdBarrier b; b.bar = bar; b.x = xb_xcc_id(); b.st = st;
    if (threadIdx.x == 0) (void)xb_add(&bar[XB_XCNT(b.x)], 1u);
    return b;
}
__device__ __forceinline__ void xcd_barrier_complete(unsigned* bar, unsigned x, unsigned& nloc, unsigned& nx) {
    const unsigned G = gridDim.x * gridDim.y * gridDim.z;
    unsigned sum, cnt, mine, sp = 0u;
    for (;;) {
        sum = 0u; cnt = 0u; mine = 0u;
#pragma unroll
        for (unsigned j = 0; j < 16; ++j) { const unsigned c = xb_ld(&bar[XB_XCNT(j)]); sum += c; cnt += (c > 0u) ? 1u : 0u; mine = (j == x) ? c : mine; }
        if (sum == G) break;
        __builtin_amdgcn_s_sleep(1);
        if ((++sp & 255u) == 0u) { if (xb_ld(&bar[XB_TMO])) break; if (sp > XB_SPIN_CAP) { atomicAdd(&bar[XB_TMO], 1u); break; } }
    }
    nloc = mine > 0u ? mine : 1u; nx = cnt > 0u ? cnt : 1u;
}

__device__ __forceinline__ void xcd_barrier(const XcdBarrier& b) {
    asm volatile("s_waitcnt vmcnt(0)" ::: "memory");
    __syncthreads();
    if (threadIdx.x == 0) {
        unsigned* bar = b.bar;
        __builtin_amdgcn_s_waitcnt(0);
        unsigned nloc = b.st[0], nx = b.st[1];
        if (nloc == 0u) { xcd_barrier_complete(bar, b.x, nloc, nx); b.st[0] = nloc; b.st[1] = nx; }
        const unsigned old = xb_add(&bar[XB_XSUB(b.x)], 1u);
        const unsigned gen = old / nloc;
        if (old + 1u == (gen + 1u) * nloc) {
            __builtin_amdgcn_fence(__ATOMIC_RELEASE, "agent");
            asm volatile("s_waitcnt vmcnt(0)" ::: "memory");
            const unsigned og = xb_add(&bar[XB_TOP], 1u);
            const unsigned tg = og / nx;
            if (og + 1u == (tg + 1u) * nx) xb_add(&bar[XB_TOPGEN], 1u);
            else XB_SPIN(xb_ld(&bar[XB_TOPGEN]) == tg, bar);
            __builtin_amdgcn_fence(__ATOMIC_ACQUIRE, "agent");
            xb_add(&bar[XB_XGEN(b.x)], 1u);
            asm volatile("s_waitcnt vmcnt(0)" ::: "memory");
        } else {
            XB_SPIN(xb_ld(&bar[XB_XGEN(b.x)]) == gen, bar);
            __builtin_amdgcn_fence(__ATOMIC_ACQUIRE, "agent");
            asm volatile("s_waitcnt vmcnt(0)" ::: "memory");
        }
    }
    __syncthreads();
}

typedef float f32x2v __attribute__((ext_vector_type(2)));
typedef unsigned u32x2v __attribute__((ext_vector_type(2)));
typedef int i32x4v __attribute__((ext_vector_type(4)));
typedef int i32x2v __attribute__((ext_vector_type(2)));
__device__ __forceinline__ float wave_sum(float v) {
#pragma unroll
    for (int o = 1; o < 64; o <<= 1) v += __shfl_xor(v, o);
    return v;
}
__device__ __forceinline__ float bf2f(unsigned short h) { return __builtin_bit_cast(float, (unsigned)h << 16); }
__device__ __forceinline__ float bflo(unsigned w) { return __builtin_bit_cast(float, w << 16); }
__device__ __forceinline__ float bfhi(unsigned w) { return __builtin_bit_cast(float, w & 0xffff0000u); }
__device__ __forceinline__ float sigmoid_f(float v) { return 1.0f / (1.0f + __expf(-v)); }
__device__ __forceinline__ float silu_ff(float v) { return v / (1.0f + __expf(-v)); }
__device__ __forceinline__ float gelu_tanh_f(float v) { const float y = 1.5957691216057308f * (v + 0.044715f * v * v * v); return v / (1.0f + __expf(-y)); }

__device__ __forceinline__ void p0_transpose_item(const float* W, int K, int N, bf16* WT, int row_off, int rmul, LAS float* scr, int item, int lane) {
    const int nblk = N / 32, kb = item / nblk, nb = item % nblk, k0 = 64 * kb, n0 = 32 * nb;
#pragma unroll 8
    for (int i = 0; i < 32; ++i) { const int kk = 2 * i + (lane >> 5); scr[kk * 33 + (lane & 31)] = W[(size_t)(k0 + kk) * N + n0 + (lane & 31)]; }
    LDS_WAIT(); asm volatile("" ::: "memory");
    const int c = lane & 7;
#pragma unroll
    for (int j = 0; j < 4; ++j) { const int n = (lane >> 3) + 8 * j; const LAS float* s = scr + (8 * c) * 33 + n;
        v4u o; o.x = pk2(s[0 * 33], s[1 * 33]); o.y = pk2(s[2 * 33], s[3 * 33]); o.z = pk2(s[4 * 33], s[5 * 33]); o.w = pk2(s[6 * 33], s[7 * 33]);
        *(v4u*)(WT + (size_t)(row_off + rmul * (n0 + n)) * K + k0 + 8 * c) = o; }
    LDS_WAIT(); asm volatile("" ::: "memory");
}

struct Ptrs {
    const float* in[29]; float* out; unsigned char* ws;
};

__device__ __forceinline__ void phase_p0a(const Ptrs& P, LAS unsigned char* lds, int tid, int lane, int wave, int vcu, int G) {
    {
        const float* c = P.in[1]; const float* c_ctx = P.in[3]; const float* w_ada = P.in[4]; const float* b_ada = P.in[5];
        float* MOD = (float*)(P.ws + WS_MOD);
        LAS float* red = (LAS float*)lds;
        const int cg = tid & 7, kg = tid >> 3;
        for (int cb = vcu; cb < 256; cb += G) {
            const int col = 24 * cb + 3 * cg;
            float acc[5][3];
#pragma unroll
            for (int r = 0; r < 5; ++r) { acc[r][0] = 0.f; acc[r][1] = 0.f; acc[r][2] = 0.f; }
#pragma unroll 4
            for (int kk = 0; kk < 16; ++kk) {
                const int k = kg * 16 + kk;
                float s[5];
#pragma unroll
                for (int r = 0; r < 4; ++r) s[r] = silu_ff(c[r * 1024 + k]);
                s[4] = silu_ff(c_ctx[k]);
                const float* wp = w_ada + (size_t)k * 6144 + col;
                const float w0 = wp[0], w1 = wp[1], w2 = wp[2];
#pragma unroll
                for (int r = 0; r < 5; ++r) { acc[r][0] += s[r] * w0; acc[r][1] += s[r] * w1; acc[r][2] += s[r] * w2; }
            }
#pragma unroll
            for (int r = 0; r < 5; ++r)
#pragma unroll
                for (int j = 0; j < 3; ++j) red[(kg * 8 + cg) * 15 + r * 3 + j] = acc[r][j];
            __syncthreads();
            if (tid < 120) {
                const int r = tid / 24, cc = tid % 24, cgp = cc / 3, j = cc % 3;
                float s = 0.f;
                for (int q = 0; q < 64; ++q) s += red[(q * 8 + cgp) * 15 + r * 3 + j];
                MOD[r * 6144 + 24 * cb + cc] = s + b_ada[24 * cb + cc];
            }
            __syncthreads();
        }
    }
    {
        float* RW = (float*)(P.ws + WS_RW); float* RB = (float*)(P.ws + WS_RB);
        const float* wg = P.in[21]; const float* bg = P.in[22]; const float* we = P.in[23]; const float* be = P.in[24];
        for (int i = vcu * 512 + tid; i < 1024 * 40; i += G * 512) { const int k = i / 40, n = i % 40; RW[i] = n < 4 ? wg[k * 4 + n] : (n < 36 ? we[k * 32 + n - 4] : 0.f); }
        if (vcu == 0 && tid < 40) RB[tid] = tid < 4 ? bg[tid] : (tid < 36 ? be[tid - 4] : 0.f);
    }
    {
        LAS float* scr = (LAS float*)(lds + wave * 16384);
        const int gw = vcu * NWAVES + wave, NGW = G * NWAVES;
        bf16* WIN = (bf16*)(P.ws + WS_WIN); bf16* WOUT = (bf16*)(P.ws + WS_WOUT); bf16* WG = (bf16*)(P.ws + WS_WG); bf16* W13 = (bf16*)(P.ws + WS_W13); bf16* W2 = (bf16*)(P.ws + WS_W2);
        constexpr int I_IN = 16 * 64, I_OUT = 16 * 32, I_G = 64, I_E = 32 * 512;
        constexpr int NITEMS = I_IN + I_OUT + I_G + 3 * I_E;
        for (int it = gw; it < NITEMS; it += NGW) {
            int r = it;
            if (r < I_IN) { p0_transpose_item(P.in[8], 1024, 2048, WIN, 0, 1, scr, r, lane); continue; } r -= I_IN;
            if (r < I_OUT) { p0_transpose_item(P.in[20], 1024, 1024, WOUT, 0, 1, scr, r, lane); continue; } r -= I_OUT;
            if (r < I_G) { const int which = r >> 5, mtx = (r >> 1) & 15, sub = r & 1;
                p0_transpose_item((which ? P.in[17] : P.in[15]) + mtx * 4096, 64, 64, WG, mtx * 128 + which * 64, 1, scr, sub, lane); continue; } r -= I_G;
            if (r < I_E) { const int e = r >> 9; p0_transpose_item(P.in[25] + (size_t)e * 1048576, 1024, 1024, W13, e * 2048, 2, scr, r & 511, lane); continue; } r -= I_E;
            if (r < I_E) { const int e = r >> 9; p0_transpose_item(P.in[26] + (size_t)e * 1048576, 1024, 1024, W13, e * 2048 + 1, 2, scr, r & 511, lane); continue; } r -= I_E;
            { const int e = r >> 9; p0_transpose_item(P.in[27] + (size_t)e * 1048576, 1024, 1024, W2, e * 1024, 1, scr, r & 511, lane); }
        }
    }
}

__device__ __forceinline__ void phase_p0b(const Ptrs& P, int lane, int wave, int vcu, int G) {
    const float* MOD = (const float*)(P.ws + WS_MOD); const float* g1n = P.in[6];
    bf16* XN = (bf16*)(P.ws + WS_RA);
    const int gw = vcu * NWAVES + wave, NGW = G * NWAVES;
    for (int m = gw; m < TA; m += NGW) {
        const float* src; int mr;
        if (m < T) { src = P.in[0] + (size_t)m * D; mr = m >> 12; } else { src = P.in[2] + (size_t)(m - T) * D; mr = 4; }
        const f32x4* xr = (const f32x4*)src + lane;
        f32x4 v[4]; float s = 0.f;
#pragma unroll
        for (int j = 0; j < 4; ++j) { v[j] = xr[64 * j]; s += (v[j].x * v[j].x + v[j].y * v[j].y) + (v[j].z * v[j].z + v[j].w * v[j].w); }
        const float rstd = 1.0f / sqrtf(wave_sum(s) * (1.f / D) + EPS);
        const f32x4* gp = (const f32x4*)g1n + lane; const f32x4* shp = (const f32x4*)(MOD + mr * 6144) + lane; const f32x4* scp = (const f32x4*)(MOD + mr * 6144 + 1024) + lane;
        unsigned long long* o8 = (unsigned long long*)(XN + (size_t)m * D) + lane;
#pragma unroll
        for (int j = 0; j < 4; ++j) { const f32x4 g = gp[64 * j], sh = shp[64 * j], sc = scp[64 * j];
            const f32x4 y = v[j] * rstd * g * (sc + 1.0f) + sh;
            o8[64 * j] = (unsigned long long)pk2(y.x, y.y) | ((unsigned long long)pk2(y.z, y.w) << 32); }
    }
}

constexpr int L_UIN = 0;
constexpr int L_UF = 17408;
constexpr int L_UB = 33792;
constexpr int L_AS = 43008;
constexpr int L_BS = 75776;
constexpr int L_SEG = 108544;
template <bool FINAL>
__device__ __forceinline__ void lru_item(const Ptrs& P, LAS unsigned char* lds, int b, int chunk, int h, int tid, int lane, int wave) {
    const bf16* ZL = (const bf16*)(P.ws + WS_RBB);
    const bf16* WG = (const bf16*)(P.ws + WS_WG);
    LAS float* uin = (LAS float*)(lds + L_UIN); LAS float* uf = (LAS float*)(lds + L_UF); LAS bf16* ub = (LAS bf16*)(lds + L_UB);
    LAS float* As = (LAS float*)(lds + L_AS); LAS float* Bs = (LAS float*)(lds + L_BS); LAS float* SEG = (LAS float*)(lds + L_SEG);
    const bool isctx = chunk < 4;
    const int seq_row0 = isctx ? (T + b * CTXL) : (b * SEQ), seq_len = isctx ? CTXL : SEQ, t0 = (isctx ? chunk : chunk - 4) * 64;
    {
        const int c2 = tid & 31, rq = tid >> 5;
        for (int r = rq; r < 67; r += 16) {
            const int tt = t0 + r - 2; unsigned w = 0u;
            if (tt >= 0 && tt < seq_len) w = *(const unsigned*)(ZL + (size_t)(seq_row0 + tt) * INC + 1024 + 64 * h + 2 * c2);
            uin[r * 64 + 2 * c2] = bflo(w); uin[r * 64 + 2 * c2 + 1] = bfhi(w);
        }
    }
    __syncthreads();
    {
        const int c = tid & 63, tq = tid >> 6; const float* cw = P.in[13]; const int ch = 64 * h + c;
        const float w0 = cw[ch], w1 = cw[512 + ch], w2 = cw[1024 + ch], w3 = cw[1536 + ch], bb = P.in[14][ch];
#pragma unroll
        for (int i = 0; i < 8; ++i) { const int t = tq * 8 + i;
            const float u = bb + w0 * uin[t * 64 + c] + w1 * uin[(t + 1) * 64 + c] + w2 * uin[(t + 2) * 64 + c] + w3 * uin[(t + 3) * 64 + c];
            uf[t * 64 + c] = u; ub[t * 72 + c] = (bf16)f2bf(u); }
    }
    __syncthreads();
    {
        const int d = wave >> 2, cgp = wave & 3, l15 = lane & 15, l4 = lane >> 4;
        bf16x8 bfr[2][2];
#pragma unroll
        for (int which = 0; which < 2; ++which)
#pragma unroll
            for (int ks = 0; ks < 2; ++ks) bfr[which][ks] = *(const bf16x8*)(WG + (size_t)(((d * 8 + h) * 128 + which * 64 + 16 * cgp + l15) * 64 + 32 * ks + 8 * l4));
        const int ch = 64 * h + 16 * cgp + l15;
        const float ba_ = P.in[16][d * 512 + ch], bx_ = P.in[18][d * 512 + ch], lam = P.in[19][d * 512 + ch];
        const float sp8 = -8.0f * log1pf(expf(-lam));
#pragma unroll
        for (int mt = 0; mt < 4; ++mt) {
            bf16x8 af[2];
#pragma unroll
            for (int ks = 0; ks < 2; ++ks) af[ks] = *(const LAS bf16x8*)(ub + (16 * mt + l15) * 72 + 32 * ks + 8 * l4);
            f32x4 ar = {0.f, 0.f, 0.f, 0.f}, ai = {0.f, 0.f, 0.f, 0.f};
            ar = __builtin_amdgcn_mfma_f32_16x16x32_bf16(af[0], bfr[0][0], ar, 0, 0, 0); ar = __builtin_amdgcn_mfma_f32_16x16x32_bf16(af[1], bfr[0][1], ar, 0, 0, 0);
            ai = __builtin_amdgcn_mfma_f32_16x16x32_bf16(af[0], bfr[1][0], ai, 0, 0, 0); ai = __builtin_amdgcn_mfma_f32_16x16x32_bf16(af[1], bfr[1][1], ai, 0, 0, 0);
#pragma unroll
            for (int rg = 0; rg < 4; ++rg) {
                const int t = 16 * mt + 4 * l4 + rg, cl = 16 * cgp + l15;
                const float r = sigmoid_f(ar[rg] + ba_), ig = sigmoid_f(ai[rg] + bx_);
                const float la = sp8 * r;
                const float a = __expf(la);
                const float x2 = 2.0f * la;
                float em = x2 * (1.0f + x2 * (0.5f + x2 * (0.16666667f + x2 * (0.041666668f + x2 * (0.0083333338f + x2 * (0.0013888889f + x2 * 0.0001984127f))))));
                const float mult = sqrtf(fmaxf(-em, 1e-12f));
                As[(d * 64 + t) * 64 + cl] = a; Bs[(d * 64 + t) * 64 + cl] = mult * ig * uf[t * 64 + cl];
            }
        }
    }
    __syncthreads();
    const int c = tid & 63, d = (tid >> 6) & 1, seg = tid >> 7;
    {
        float Pp = 1.f, Hh = 0.f;
#pragma unroll
        for (int i = 0; i < 16; ++i) { const int t = d ? (16 * seg + 15 - i) : (16 * seg + i); const float a = As[(d * 64 + t) * 64 + c], bq = Bs[(d * 64 + t) * 64 + c]; Hh = a * Hh + bq; Pp *= a; }
        SEG[((d * 4 + seg) * 64 + c) * 2] = Pp; SEG[((d * 4 + seg) * 64 + c) * 2 + 1] = Hh;
    }
    __syncthreads();
    if (!FINAL) {
        if (seg == 0) {
            float Pt = 1.f, Ht = 0.f;
#pragma unroll
            for (int q = 0; q < 4; ++q) { const int s = d ? 3 - q : q; const float ps = SEG[((d * 4 + s) * 64 + c) * 2], hs = SEG[((d * 4 + s) * 64 + c) * 2 + 1]; Ht = ps * Ht + hs; Pt *= ps; }
            float* AGG = (float*)(P.ws + WS_AGG);
            *(f32x2v*)(AGG + ((size_t)((b * NCH + chunk) * 2 + d) * 512 + 64 * h + c) * 2) = (f32x2v){Pt, Ht};
        }
    } else {
        const float* CARRY = (const float*)(P.ws + WS_CARRY);
        float hh = CARRY[(size_t)((b * 64 + (chunk - 4)) * 2 + d) * 512 + 64 * h + c];
        for (int q = 0; q < 4; ++q) { const int s = d ? 3 - q : q; if (s == seg) break; const float ps = SEG[((d * 4 + s) * 64 + c) * 2], hs = SEG[((d * 4 + s) * 64 + c) * 2 + 1]; hh = ps * hh + hs; }
#pragma unroll
        for (int i = 0; i < 16; ++i) { const int t = d ? (16 * seg + 15 - i) : (16 * seg + i); const float a = As[(d * 64 + t) * 64 + c], bq = Bs[(d * 64 + t) * 64 + c]; hh = a * hh + bq; Bs[(d * 64 + t) * 64 + c] = hh; }
        __syncthreads();
        bf16* MIX = (bf16*)(P.ws + WS_RC);
        const int c2 = tid & 31, tq = tid >> 5;
#pragma unroll
        for (int i = 0; i < 4; ++i) { const int t = tq + 16 * i; const size_t row = (size_t)(b * SEQ + t0 + t);
            const unsigned zg = *(const unsigned*)(ZL + row * INC + 1536 + 64 * h + 2 * c2);
            const float o0 = (Bs[t * 64 + 2 * c2] + Bs[(64 + t) * 64 + 2 * c2]) * gelu_tanh_f(bflo(zg));
            const float o1 = (Bs[t * 64 + 2 * c2 + 1] + Bs[(64 + t) * 64 + 2 * c2 + 1]) * gelu_tanh_f(bfhi(zg));
            *(unsigned*)(MIX + row * D + 512 + 64 * h + 2 * c2) = pk2(o0, o1); }
    }
    __syncthreads();
}

template <int T0> __device__ __forceinline__ void conv_rows8(const float (&uu)[64], const float (&w)[31], float cb, LAS float* cs, int c) {
#pragma unroll
    for (int tt = 0; tt < 8; ++tt) {
        float acc = cb;
#pragma unroll
        for (int j = 0; j < 31; ++j) { const int s = T0 + tt + j - 15; if (s >= 0 && s < 64) acc += w[j] * uu[s]; }
        cs[(T0 + tt) * 512 + c] = acc;
    }
}
__device__ __forceinline__ void conv_item(const Ptrs& P, LAS unsigned char* lds, int item, int tid, int lane, int wave) {
    const bf16* ZL = (const bf16*)(P.ws + WS_RBB); bf16* MIX = (bf16*)(P.ws + WS_RC);
    LAS float* cs = (LAS float*)lds;
    {
        const int c = tid;
        const bf16* base = ZL + (size_t)(item * 64) * INC + c;
        float uu[64];
#pragma unroll
        for (int t = 0; t < 64; ++t) { const float val = bf2f(base[(size_t)t * INC]), gt = bf2f(base[(size_t)t * INC + 512]); uu[t] = val * sigmoid_f(gt); }
        float w[31];
#pragma unroll
        for (int j = 0; j < 31; ++j) w[j] = P.in[9][j * 512 + c];
        const float cb = P.in[10][c];
        conv_rows8<0>(uu, w, cb, cs, c); conv_rows8<8>(uu, w, cb, cs, c); conv_rows8<16>(uu, w, cb, cs, c); conv_rows8<24>(uu, w, cb, cs, c);
        conv_rows8<32>(uu, w, cb, cs, c); conv_rows8<40>(uu, w, cb, cs, c); conv_rows8<48>(uu, w, cb, cs, c); conv_rows8<56>(uu, w, cb, cs, c);
    }
    __syncthreads();
    {
        const f32x4 g0 = *(const f32x4*)(P.in[11] + 8 * lane), g1 = *(const f32x4*)(P.in[11] + 8 * lane + 4);
        const f32x4 b0 = *(const f32x4*)(P.in[12] + 8 * lane), b1 = *(const f32x4*)(P.in[12] + 8 * lane + 4);
#pragma unroll 2
        for (int i = 0; i < 8; ++i) { const int t = wave * 8 + i;
            f32x4 v0 = *(const LAS f32x4*)(cs + t * 512 + 8 * lane), v1 = *(const LAS f32x4*)(cs + t * 512 + 8 * lane + 4);
            const float mu = wave_sum((v0.x + v0.y) + (v0.z + v0.w) + (v1.x + v1.y) + (v1.z + v1.w)) * (1.f / 512.f);
            v0 = v0 - mu; v1 = v1 - mu;
            const float var = wave_sum((v0.x * v0.x + v0.y * v0.y) + (v0.z * v0.z + v0.w * v0.w) + (v1.x * v1.x + v1.y * v1.y) + (v1.z * v1.z + v1.w * v1.w)) * (1.f / 512.f);
            const float rstd = 1.0f / sqrtf(var + EPS);
            const f32x4 y0 = v0 * rstd * g0 + b0, y1 = v1 * rstd * g1 + b1;
            v4u o; o.x = pk2(silu_ff(y0.x), silu_ff(y0.y)); o.y = pk2(silu_ff(y0.z), silu_ff(y0.w)); o.z = pk2(silu_ff(y1.x), silu_ff(y1.y)); o.w = pk2(silu_ff(y1.z), silu_ff(y1.w));
            *(v4u*)(MIX + (size_t)(item * 64 + t) * D + 8 * lane) = o; }
    }
    __syncthreads();
}

__device__ __forceinline__ void phase_p2a(const Ptrs& P, LAS unsigned char* lds, int tid, int lane, int wave, int vcu, int G) {
    for (int it = vcu; it < NB * NCH * 8; it += G) { const int h = it & 7, bc = it >> 3; lru_item<false>(P, lds, bc / NCH, bc % NCH, h, tid, lane, wave); }
    for (int it = vcu; it < NB * 64; it += G) conv_item(P, lds, it, tid, lane, wave);
}
__device__ __forceinline__ void phase_p2b(const Ptrs& P, int tid, int vcu, int G) {
    const float* AGG = (const float*)(P.ws + WS_AGG); float* CARRY = (float*)(P.ws + WS_CARRY);
    for (int idx = vcu * 512 + tid; idx < NB * 2 * 512; idx += G * 512) {
        const int b = idx >> 10, d = (idx >> 9) & 1, ch = idx & 511;
        float hh = 0.f;
        if (d == 0) {
#pragma unroll
            for (int q = 0; q < 4; ++q) { const f32x2v ab = *(const f32x2v*)(AGG + ((size_t)((b * NCH + q) * 2 + 0) * 512 + ch) * 2); hh = ab.x * hh + ab.y; }
#pragma unroll 8
            for (int lc = 0; lc < 64; ++lc) { const f32x2v ab = *(const f32x2v*)(AGG + ((size_t)((b * NCH + 4 + lc) * 2 + 0) * 512 + ch) * 2);
                CARRY[(size_t)((b * 64 + lc) * 2 + 0) * 512 + ch] = hh; hh = ab.x * hh + ab.y; }
        } else {
#pragma unroll
            for (int q = 3; q >= 0; --q) { const f32x2v ab = *(const f32x2v*)(AGG + ((size_t)((b * NCH + q) * 2 + 1) * 512 + ch) * 2); hh = ab.x * hh + ab.y; }
#pragma unroll 8
            for (int lc = 63; lc >= 0; --lc) { const f32x2v ab = *(const f32x2v*)(AGG + ((size_t)((b * NCH + 4 + lc) * 2 + 1) * 512 + ch) * 2);
                CARRY[(size_t)((b * 64 + lc) * 2 + 1) * 512 + ch] = hh; hh = ab.x * hh + ab.y; }
        }
    }
}
__device__ __forceinline__ void phase_p2c(const Ptrs& P, LAS unsigned char* lds, int tid, int lane, int wave, int vcu, int G) {
    for (int it = vcu; it < NB * 64 * 8; it += G) { const int h = it & 7, bc = it >> 3; lru_item<true>(P, lds, bc >> 6, 4 + (bc & 63), h, tid, lane, wave); }
}

constexpr int L_HL = 0, HL_PITCH = 2064;
constexpr int L_LG = 132096;
constexpr int L_LCNT = 142336;
constexpr int L_LBASE = 142464;
__device__ __forceinline__ void phase_p4a(const Ptrs& P, LAS unsigned char* lds, int tid, int lane, int wave, int vcu, int G) {
    const float* MOD = (const float*)(P.ws + WS_MOD); const float* g2n = P.in[7];
    const float* RW = (const float*)(P.ws + WS_RW); const float* RB = (const float*)(P.ws + WS_RB);
    bf16* H2 = (bf16*)(P.ws + WS_RC + 32 * MiB);
    unsigned* gcnt = (unsigned*)(P.ws + WS_CTL) + CW_CNT;
    LAS float* lg = (LAS float*)(lds + L_LG); LAS int* lcnt = (LAS int*)(lds + L_LCNT); LAS int* lbase = (LAS int*)(lds + L_LBASE);
    for (int it = vcu; it < T / 64; it += G) {
        if (tid < 32) lcnt[tid] = 0;
        for (int i = 0; i < 8; ++i) {
            const int tl = wave * 8 + i, tok = it * 64 + tl, mr = tok >> 12;
            const f32x4* xr = (const f32x4*)(P.out + (size_t)tok * D) + lane;
            f32x4 v[4]; float s = 0.f;
#pragma unroll
            for (int j = 0; j < 4; ++j) { v[j] = xr[64 * j]; s += (v[j].x * v[j].x + v[j].y * v[j].y) + (v[j].z * v[j].z + v[j].w * v[j].w); }
            const float rstd = 1.0f / sqrtf(wave_sum(s) * (1.f / D) + EPS);
            const f32x4* gp = (const f32x4*)g2n + lane; const f32x4* shp = (const f32x4*)(MOD + mr * 6144 + 3072) + lane; const f32x4* scp = (const f32x4*)(MOD + mr * 6144 + 4096) + lane;
            unsigned long long* o8 = (unsigned long long*)(H2 + (size_t)tok * D) + lane;
#pragma unroll
            for (int j = 0; j < 4; ++j) { const f32x4 g = gp[64 * j], sh = shp[64 * j], sc = scp[64 * j];
                const f32x4 y = v[j] * rstd * g * (sc + 1.0f) + sh;
                const unsigned long long pk = (unsigned long long)pk2(y.x, y.y) | ((unsigned long long)pk2(y.z, y.w) << 32);
                o8[64 * j] = pk;
                *(LAS unsigned long long*)(lds + L_HL + tl * HL_PITCH + (lane + 64 * j) * 8) = pk; }
        }
        __syncthreads();
        {
            const int t = tid & 63, ng = wave;
            const float* rw = RW + 5 * ng;
            float acc[5] = {0.f, 0.f, 0.f, 0.f, 0.f};
            for (int k8 = 0; k8 < 128; ++k8) {
                const v4u hv = *(const LAS v4u*)(lds + L_HL + t * HL_PITCH + k8 * 16);
                float hf[8] = {bflo(hv.x), bfhi(hv.x), bflo(hv.y), bfhi(hv.y), bflo(hv.z), bfhi(hv.z), bflo(hv.w), bfhi(hv.w)};
#pragma unroll
                for (int kk = 0; kk < 8; ++kk) { const float* wr_ = rw + (k8 * 8 + kk) * 40;
#pragma unroll
                    for (int q = 0; q < 5; ++q) acc[q] += hf[kk] * wr_[q]; }
            }
#pragma unroll
            for (int q = 0; q < 5; ++q) lg[t * 40 + 5 * ng + q] = acc[q] + RB[5 * ng + q];
        }
        __syncthreads();
        int e0 = 0, e1 = 0, rk0 = 0, rk1 = 0; float gt0 = 0.f, gt1 = 0.f;
        if (tid < 64) {
            const LAS float* l = lg + tid * 40;
            int grp = 0; float lm = l[0];
#pragma unroll
            for (int q = 1; q < 4; ++q) if (l[q] > lm) { lm = l[q]; grp = q; }
            float den = 0.f;
#pragma unroll
            for (int q = 0; q < 4; ++q) den += __expf(l[q] - lm);
            const float pgrp = 1.0f / den;
            const LAS float* le = l + 4 + grp * 8;
            int i1 = 0; float m1 = le[0];
#pragma unroll
            for (int q = 1; q < 8; ++q) if (le[q] > m1) { m1 = le[q]; i1 = q; }
            int i2 = -1; float m2 = -3.0e38f;
#pragma unroll
            for (int q = 0; q < 8; ++q) if (q != i1 && le[q] > m2) { m2 = le[q]; i2 = q; }
            const float ex = __expf(m2 - m1), inv = 1.0f / (1.0f + ex);
            gt0 = pgrp * inv; gt1 = pgrp * ex * inv;
            e0 = grp * 8 + i1; e1 = grp * 8 + i2;
            rk0 = atomicAdd((int*)(lcnt + e0), 1); rk1 = atomicAdd((int*)(lcnt + e1), 1);
        }
        __syncthreads();
        if (tid < 32) lbase[tid] = (int)__hip_atomic_fetch_add(gcnt + tid, (unsigned)lcnt[tid], __ATOMIC_RELAXED, __HIP_MEMORY_SCOPE_AGENT);
        __syncthreads();
        if (tid < 64) {
            const int tok = it * 64 + tid;
            *(i32x4v*)(P.ws + WS_ROUTE + (size_t)tok * 16) = (i32x4v){e0, lbase[e0] + rk0, e1, lbase[e1] + rk1};
            *(f32x2v*)(P.ws + WS_RG + (size_t)tok * 8) = (f32x2v){gt0, gt1};
        }
        __syncthreads();
    }
}
__device__ __forceinline__ void build_tiles(const Ptrs& P, volatile LAS unsigned* MISC, int tid) {
    if (tid == 0) {
        unsigned* gcnt = (unsigned*)(P.ws + WS_CTL) + CW_CNT;
        int run = 0;
        for (int e = 0; e < NE; ++e) {
            const int cnt = (int)__hip_atomic_load(gcnt + e, __ATOMIC_RELAXED, __HIP_MEMORY_SCOPE_AGENT);
            const int nt = (cnt + 255) >> 8;
            MISC[16 + e] = (unsigned)(run * 256);
            for (int q = 0; q < nt && run + q < 192; ++q) MISC[64 + run + q] = (unsigned)e;
            run += nt;
        }
        MISC[8] = (unsigned)(run < 192 ? run : 192);
    }
    __syncthreads();
}
__device__ __forceinline__ void phase_p4b(const Ptrs& P, volatile LAS unsigned* MISC, int lane, int wave, int vcu, int G) {
    const bf16* H2 = (const bf16*)(P.ws + WS_RC + 32 * MiB); bf16* XS = (bf16*)(P.ws + WS_RA);
    float* GATE = (float*)(P.ws + WS_GATE);
    const int gw = vcu * NWAVES + wave, NGW = G * NWAVES;
    for (int tok = gw; tok < T; tok += NGW) {
        const i32x4v r = *(const i32x4v*)(P.ws + WS_ROUTE + (size_t)tok * 16);
        const f32x2v g = *(const f32x2v*)(P.ws + WS_RG + (size_t)tok * 8);
        const int s0 = (int)MISC[16 + r.x] + r.y, s1 = (int)MISC[16 + r.z] + r.w;
        const v4u* src = (const v4u*)(H2 + (size_t)tok * D) + lane;
        const v4u a0 = src[0], a1 = src[64];
        v4u* d0 = (v4u*)(XS + (size_t)s0 * D) + lane; v4u* d1 = (v4u*)(XS + (size_t)s1 * D) + lane;
        d0[0] = a0; d0[64] = a1; d1[0] = a0; d1[64] = a1;
        if (lane == 0) { GATE[s0] = g.x; GATE[s1] = g.y; *(i32x2v*)(P.ws + WS_SLOT + (size_t)tok * 8) = (i32x2v){s0, s1}; }
    }
}
__device__ __forceinline__ void phase_p6(const Ptrs& P, int lane, int wave, int vcu, int G) {
    const float* MOD = (const float*)(P.ws + WS_MOD); const float* fg = P.in[28];
    const bf16* Y = (const bf16*)(P.ws + WS_RC);
    const int gw = vcu * NWAVES + wave, NGW = G * NWAVES;
    for (int tok = gw; tok < T; tok += NGW) {
        const i32x2v sl = *(const i32x2v*)(P.ws + WS_SLOT + (size_t)tok * 8);
        const int mr = tok >> 12;
        f32x4* xr = (f32x4*)(P.out + (size_t)tok * D) + lane;
        const u32x2v* y0 = (const u32x2v*)(Y + (size_t)sl.x * D) + lane; const u32x2v* y1 = (const u32x2v*)(Y + (size_t)sl.y * D) + lane;
        const f32x4* g2p = (const f32x4*)(MOD + mr * 6144 + 5120) + lane;
        f32x4 v[4]; float s = 0.f;
#pragma unroll
        for (int j = 0; j < 4; ++j) { const f32x4 xv = xr[64 * j], g2 = g2p[64 * j]; const u32x2v a = y0[64 * j], bq = y1[64 * j];
            f32x4 yy; yy.x = bflo(a.x) + bflo(bq.x); yy.y = bfhi(a.x) + bfhi(bq.x); yy.z = bflo(a.y) + bflo(bq.y); yy.w = bfhi(a.y) + bfhi(bq.y);
            v[j] = xv + g2 * yy; s += (v[j].x * v[j].x + v[j].y * v[j].y) + (v[j].z * v[j].z + v[j].w * v[j].w); }
        const float rstd = 1.0f / sqrtf(wave_sum(s) * (1.f / D) + EPS);
        const f32x4* fgp = (const f32x4*)fg + lane;
#pragma unroll
        for (int j = 0; j < 4; ++j) xr[64 * j] = v[j] * rstd * fgp[64 * j];
    }
}

struct Args { const float* in[29]; float* out; unsigned char* ws; int ph_lo, ph_hi, li, pad; };
__global__ void __launch_bounds__(NWAVES * 64, 2) fwd_kernel(Args args) {
    extern __shared__ __attribute__((aligned(16))) unsigned char lds_raw[];
    LAS unsigned char* lds = (LAS unsigned char*)lds_raw;
    volatile LAS unsigned* MISC = (volatile LAS unsigned*)(lds + MISC_OFF);
    const int tid = threadIdx.x, lane = tid & 63, wave = __builtin_amdgcn_readfirstlane(tid >> 6);
    const int G = gridDim.x; const int bx = blockIdx.x; const int vcu = (G % 8 == 0) ? (bx % 8) * (G / 8) + bx / 8 : bx;
    Ptrs P;
#pragma unroll
    for (int i = 0; i < 29; ++i) P.in[i] = args.in[i];
    P.out = args.out; P.ws = args.ws;
    for (int u = tid; u < (LDS_BYTES - MISC_OFF) / 4; u += NWAVES * 64) MISC[u] = 0u;
    __syncthreads();
    unsigned* ctl = (unsigned*)(P.ws + WS_CTL);
    XcdBarrier bar; bar.bar = ctl + CW_BAR; bar.x = 0; bar.st = nullptr;
    if (N_LAUNCHES == 1) bar = xcd_barrier_post(ctl + CW_BAR, MISC);
#define GRID_BAR() do { if (N_LAUNCHES == 1) xcd_barrier(bar); } while (0)
    const int lo = args.ph_lo, hi = args.ph_hi;
#define IN(k) (lo <= (k) && (k) < hi)
#define BOTH(k) (IN(k) && IN((k) + 1))

    if (IN(0)) { phase_p0a(P, lds, tid, lane, wave, vcu, G); if (BOTH(0)) GRID_BAR(); }
    if (IN(1)) { phase_p0b(P, lane, wave, vcu, G); if (BOTH(1)) GRID_BAR(); }
    if (IN(2)) {
        pg8::Gemm g{(const pg8::bf16_t*)(P.ws + WS_RA), (const pg8::bf16_t*)(P.ws + WS_WIN), TA, INC, D};
        pg8::OrderInProj S; S.so.init(T, INC, G, bx);
        pg8::EpiStoreBf16 E{(pg8::bf16_t*)(P.ws + WS_RBB), INC};
        pg8::gemm_phase<pg8::EpiStoreBf16, pg8::OrderInProj, true, true>(lds + RING_OFF, g, S, E);
        if (BOTH(2)) GRID_BAR();
    }
    if (IN(3)) { phase_p2a(P, lds, tid, lane, wave, vcu, G); if (BOTH(3)) GRID_BAR(); }
    if (IN(4)) { phase_p2b(P, tid, vcu, G); if (BOTH(4)) GRID_BAR(); }
    if (IN(5)) { phase_p2c(P, lds, tid, lane, wave, vcu, G); if (BOTH(5)) GRID_BAR(); }
    if (IN(6)) {
        pg8::Gemm g{(const pg8::bf16_t*)(P.ws + WS_RC), (const pg8::bf16_t*)(P.ws + WS_WOUT), T, D, D};
        pg8::StaticOrder S; S.init(T, D, G, bx);
        pg8::EpiResid E{P.in[0], (const float*)(P.ws + WS_MOD) + 2048, 6144, P.out};
        pg8::gemm_phase<pg8::EpiResid, pg8::StaticOrder, true, true>(lds + RING_OFF, g, S, E);
        if (BOTH(6)) GRID_BAR();
    }
    if (IN(7)) { phase_p4a(P, lds, tid, lane, wave, vcu, G); if (BOTH(7)) GRID_BAR(); }
    if (IN(8)) { build_tiles(P, MISC, tid); phase_p4b(P, MISC, lane, wave, vcu, G); if (BOTH(8)) GRID_BAR(); }
    if (IN(9)) {
        build_tiles(P, MISC, tid);
        pg8::Gemm g{(const pg8::bf16_t*)(P.ws + WS_RA), (const pg8::bf16_t*)(P.ws + WS_W13), NSLOT, 2048, D};
        pg8::OrderMoe S{G, bx, 8, (int)MISC[8] * 8, (const LAS int*)(lds + MISC_OFF + 256)};
        pg8::EpiSwiglu E{(pg8::bf16_t*)(P.ws + WS_RBB)};
        pg8::gemm_phase<pg8::EpiSwiglu, pg8::OrderMoe, true, true>(lds + RING_OFF, g, S, E);
        if (BOTH(9)) GRID_BAR();
    }
    if (IN(10)) {
        build_tiles(P, MISC, tid);
        pg8::Gemm g{(const pg8::bf16_t*)(P.ws + WS_RBB), (const pg8::bf16_t*)(P.ws + WS_W2), NSLOT, 1024, D};
        pg8::OrderMoe S{G, bx, 4, (int)MISC[8] * 4, (const LAS int*)(lds + MISC_OFF + 256)};
        pg8::EpiGateBf16 E{(pg8::bf16_t*)(P.ws + WS_RC), (const float*)(P.ws + WS_GATE)};
        pg8::gemm_phase<pg8::EpiGateBf16, pg8::OrderMoe, true, true>(lds + RING_OFF, g, S, E);
        if (BOTH(10)) GRID_BAR();
    }
    if (IN(11)) { phase_p6(P, lane, wave, vcu, G); }
#undef IN
#undef BOTH
}

extern "C" void kernel_launch(void* const* d_in, const int* in_sizes, int n_in, void* d_out, int out_size, void* d_ws, size_t ws_size, hipStream_t stream) {
    static int grid = 0;
    if (grid == 0) {
        if (n_in != 29 || in_sizes[0] != T * D || out_size != T * D || ws_size < WS_END) { fprintf(stderr, "kernel_launch: built for 29 inputs, x and out of %d floats, >= %zu bytes of workspace; got n_in %d, in0 %d, out %d, ws %zu; nothing launched\n", T * D, (size_t)WS_END, n_in, n_in > 0 ? in_sizes[0] : -1, out_size, ws_size); grid = -1; return; }
        int dev = 0, cus = 0, per_cu = 0;
        if (hipGetDevice(&dev) != hipSuccess || hipDeviceGetAttribute(&cus, hipDeviceAttributeMultiprocessorCount, dev) != hipSuccess) { fprintf(stderr, "kernel_launch: hipGetDevice / hipDeviceGetAttribute failed\n"); grid = -1; return; }
        if (hipFuncSetAttribute((const void*)fwd_kernel, hipFuncAttributeMaxDynamicSharedMemorySize, LDS_BYTES) != hipSuccess) { fprintf(stderr, "kernel_launch: hipFuncSetAttribute failed (%d bytes of dynamic LDS)\n", LDS_BYTES); grid = -1; return; }
        if (hipOccupancyMaxActiveBlocksPerMultiprocessor(&per_cu, (const void*)fwd_kernel, NWAVES * 64, LDS_BYTES) != hipSuccess || per_cu < 1)
            fprintf(stderr, "kernel_launch: note: the occupancy query reports %d workgroups per CU\n", per_cu);
        (void)hipGetLastError();
        grid = cus;
    }
    if (grid < 0) return;
    if (hipMemsetAsync((char*)d_ws + WS_CTL, 0, CTL_ZERO_BYTES, stream) != hipSuccess) { fprintf(stderr, "kernel_launch: hipMemsetAsync failed\n"); return; }
    Args a{};
    for (int i = 0; i < 29; ++i) a.in[i] = (const float*)d_in[i];
    a.out = (float*)d_out; a.ws = (unsigned char*)d_ws;
    for (int li = 0; li < N_LAUNCHES; ++li) {
        a.ph_lo = (N_LAUNCHES == 1) ? 0 : li; a.ph_hi = (N_LAUNCHES == 1) ? NPH : li + 1; a.li = li;
        hipLaunchKernelGGL(fwd_kernel, dim3(grid), dim3(NWAVES * 64), LDS_BYTES, stream, a);
        const hipError_t le = hipPeekAtLastError();
        if (le != hipSuccess) { fprintf(stderr, "kernel_launch: launch %d failed: %s\n", li, hipGetErrorName(le)); break; }
    }
}
```

```cpp
#include <hip/hip_runtime.h>
#include <cstdio>
#include <cstdint>
namespace pg8 {
#define PG8_LAS __attribute__((address_space(3)))
typedef unsigned short bf16_t;
typedef short bf16x8 __attribute__((ext_vector_type(8)));
typedef float f32x4 __attribute__((ext_vector_type(4)));
typedef unsigned u32x4 __attribute__((ext_vector_type(4)));
constexpr int BM = 256, BK = 64, HALF = 128, HTB = HALF * BK * 2  , STAGE_BYTES = 8 * HTB, NXCD = 8, WGM = 8;

__host__ __device__ __forceinline__ int lds_byte(int r, int c) { const int st = (r >> 4) * 2 + (c >> 5), rr = r & 15, cc = c & 31, ob = rr * 64 + cc * 2; return st * 1024 + (ob ^ (((ob >> 9) & 1) << 5)); }
__host__ __device__ __forceinline__ void stage_rc(int b, int& R, int& C) { const int st = b / 1024, sb = b % 1024, swz = sb ^ (((sb >> 9) & 1) << 5); R = (st >> 1) * 16 + swz / 64; C = (st & 1) * 32 + (swz % 64) / 2; }
__host__ __device__ __forceinline__ int perm32(int rho) { const int n = rho >> 4, i = rho & 15; return 8 * (i >> 2) + 4 * n + (i & 3); }

struct Unit { int pm, pn; };
struct Gemm { const bf16_t* A; const bf16_t* Bt; int M, N, K; };

struct StaticOrder {
    int nM, nN, nwg, G, c;
    __host__ __device__ void init(int M, int N, int G_, int c_) { nM = M / BM; nN = N / BM; nwg = nM * nN; G = G_; c = c_; }
    __host__ __device__ bool next(int i, Unit& u) const {
        const long L = (long)i * G + c; if (L >= nwg) return false;
        int wgid = (int)L; { const int q = nwg / NXCD, r = nwg % NXCD, xcd = wgid % NXCD, off = wgid / NXCD; wgid = (xcd < r ? xcd * (q + 1) : r * (q + 1) + (xcd - r) * q) + off; }
        const int nig = WGM * nN, gid = wgid / nig, fm = gid * WGM, gsz = (nM - fm) < WGM ? (nM - fm) : WGM;
        u.pm = fm + ((wgid % nig) % gsz); u.pn = (wgid % nig) / gsz; return true;
    }
    __device__ __forceinline__ void a_ready(const Unit&) const {}
    __device__ __forceinline__ void done(const Unit&) const {}
};

__device__ __forceinline__ unsigned cvt_pk_bf16(float lo, float hi) { unsigned r; asm volatile("v_cvt_pk_bf16_f32 %0, %1, %2" : "=v"(r) : "v"(lo), "v"(hi)); return r; }
typedef unsigned u32x2 __attribute__((ext_vector_type(2)));
__device__ __forceinline__ float silu_f(float v) { return v / (1.0f + __expf(-v)); }

struct EpiStoreBf16 {
    static constexpr bool PERM = true, AFTER_DRAIN = false;
    bf16_t* O; int ldc;
    __device__ __forceinline__ void operator()(const f32x4 (&acc)[2][2][4][2], const Unit& u, int wr, int wc, int fr, int fq) const {
        const int row0 = u.pm * BM + wr * 64 + fr, col0 = u.pn * BM + wc * 32 + 8 * fq;
#pragma unroll
        for (int ai = 0; ai < 2; ++ai)
#pragma unroll
            for (int m = 0; m < 4; ++m) { bf16_t* rowp = O + (size_t)(row0 + ai * HALF + m * 16) * ldc + col0;
#pragma unroll
                for (int bj = 0; bj < 2; ++bj) { const f32x4 v0 = acc[ai][bj][m][0], v1 = acc[ai][bj][m][1];
                    u32x4 w; w.x = cvt_pk_bf16(v0[0], v0[1]); w.y = cvt_pk_bf16(v0[2], v0[3]); w.z = cvt_pk_bf16(v1[0], v1[1]); w.w = cvt_pk_bf16(v1[2], v1[3]);
                    *(u32x4*)(rowp + bj * HALF) = w; } }
    }
};
struct EpiResid {
    static constexpr bool PERM = true, AFTER_DRAIN = false;
    const float* x; const float* g; int gp; float* out;
    __device__ __forceinline__ void operator()(const f32x4 (&acc)[2][2][4][2], const Unit& u, int wr, int wc, int fr, int fq) const {
        const int row0 = u.pm * BM + wr * 64 + fr, col0 = u.pn * BM + wc * 32 + 8 * fq;
        const float* gb = g + (size_t)((u.pm * BM) >> 12) * gp + col0;
        f32x4 gv[2][2];
#pragma unroll
        for (int bj = 0; bj < 2; ++bj) { gv[bj][0] = *(const f32x4*)(gb + bj * HALF); gv[bj][1] = *(const f32x4*)(gb + bj * HALF + 4); }
#pragma unroll
        for (int ai = 0; ai < 2; ++ai)
#pragma unroll
            for (int m = 0; m < 4; ++m) { const size_t off = (size_t)(row0 + ai * HALF + m * 16) * 1024 + col0;
#pragma unroll
                for (int bj = 0; bj < 2; ++bj) {
                    const f32x4 x0 = *(const f32x4*)(x + off + bj * HALF), x1 = *(const f32x4*)(x + off + bj * HALF + 4);
                    *(f32x4*)(out + off + bj * HALF) = x0 + gv[bj][0] * acc[ai][bj][m][0];
                    *(f32x4*)(out + off + bj * HALF + 4) = x1 + gv[bj][1] * acc[ai][bj][m][1]; } }
    }
};
struct EpiSwiglu {
    static constexpr bool PERM = true, AFTER_DRAIN = false;
    bf16_t* H;
    __device__ __forceinline__ void operator()(const f32x4 (&acc)[2][2][4][2], const Unit& u, int wr, int wc, int fr, int fq) const {
        const int row0 = u.pm * BM + wr * 64 + fr, col0 = (u.pn & 7) * 128 + wc * 16 + 4 * fq;
#pragma unroll
        for (int ai = 0; ai < 2; ++ai)
#pragma unroll
            for (int m = 0; m < 4; ++m) { bf16_t* rowp = H + (size_t)(row0 + ai * HALF + m * 16) * 1024 + col0;
#pragma unroll
                for (int bj = 0; bj < 2; ++bj) { const f32x4 v0 = acc[ai][bj][m][0], v1 = acc[ai][bj][m][1];
                    u32x2 w; w.x = cvt_pk_bf16(silu_f(v0[0]) * v0[1], silu_f(v0[2]) * v0[3]); w.y = cvt_pk_bf16(silu_f(v1[0]) * v1[1], silu_f(v1[2]) * v1[3]);
                    *(u32x2*)(rowp + bj * 64) = w; } }
    }
};
struct EpiGateBf16 {
    static constexpr bool PERM = true, AFTER_DRAIN = false;
    bf16_t* Y; const float* gate;
    __device__ __forceinline__ void operator()(const f32x4 (&acc)[2][2][4][2], const Unit& u, int wr, int wc, int fr, int fq) const {
        const int row0 = u.pm * BM + wr * 64 + fr, col0 = (u.pn & 3) * BM + wc * 32 + 8 * fq;
#pragma unroll
        for (int ai = 0; ai < 2; ++ai)
#pragma unroll
            for (int m = 0; m < 4; ++m) { const int row = row0 + ai * HALF + m * 16; const float gt = gate[row]; bf16_t* rowp = Y + (size_t)row * 1024 + col0;
#pragma unroll
                for (int bj = 0; bj < 2; ++bj) { const f32x4 v0 = acc[ai][bj][m][0] * gt, v1 = acc[ai][bj][m][1] * gt;
                    u32x4 w; w.x = cvt_pk_bf16(v0[0], v0[1]); w.y = cvt_pk_bf16(v0[2], v0[3]); w.z = cvt_pk_bf16(v1[0], v1[1]); w.w = cvt_pk_bf16(v1[2], v1[3]);
                    *(u32x4*)(rowp + bj * HALF) = w; } }
    }
};
struct OrderInProj {
    StaticOrder so;
    __device__ bool next(int i, Unit& u) const {
        const long L = (long)i * so.G + so.c;
        if (L < so.nwg) return so.next(i, u);
        const int j = (int)(L - so.nwg); if (j >= 8) return false;
        u.pm = 64 + (j >> 1); u.pn = 4 + (j & 1); return true;
    }
    __device__ __forceinline__ void a_ready(const Unit&) const {}
    __device__ __forceinline__ void done(const Unit&) const {}
};
struct OrderMoe {
    int G, c, ntn, nunits; const PG8_LAS int* tile_e;
    __device__ bool next(int i, Unit& u) const {
        const long L = (long)i * G + c; if (L >= nunits) return false;
        const int rt = (int)L / ntn, pn = (int)L % ntn;
        u.pm = rt; u.pn = tile_e[rt] * ntn + pn; return true;
    }
    __device__ __forceinline__ void a_ready(const Unit&) const {}
    __device__ __forceinline__ void done(const Unit&) const {}
};
template <class Epi, class Sched, bool ALIGN_EPI = false, bool SP2 = false>
__device__ __forceinline__ void gemm_phase(PG8_LAS unsigned char* lds, const Gemm g, const Sched& S, const Epi& E) {
    const int tid = threadIdx.x, wid = __builtin_amdgcn_readfirstlane(tid >> 6), lane = tid & 63, wr = wid >> 2, wc = wid & 3, fr = lane & 15, fq = lane >> 4;
    const int K = g.K, nt = K / BK;
    unsigned voffA[2], voffB[2];
#pragma unroll
    for (int i = 0; i < 2; ++i) { int R, C; stage_rc(tid * 16 + i * 8192, R, C); const int Rb = Epi::PERM ? ((R & ~31) + perm32(R & 31)) : R;
        voffA[i] = (unsigned)(R * K + C) * 2u; voffB[i] = (unsigned)(Rb * K + C) * 2u; }
    const size_t kstep = (size_t)(BK * 2);
    const size_t hstep = (size_t)HALF * K * 2;
    const size_t tstep = 2 * hstep;
    const unsigned ldsw = (unsigned)wid * 1024u;
    const int aoff = lds_byte(wr * 64 + fr, fq * 8), boff = lds_byte(wc * 32 + fr, fq * 8);
#define PG8_SA(b, h) (((b) * 2 + (h)) * HTB)
#define PG8_SB(b, h) ((4 + (b) * 2 + (h)) * HTB)
#define PG8_STAGE(bufoff, gbase, voff) do { _Pragma("unroll") for (int _i = 0; _i < 2; ++_i) \
        __builtin_amdgcn_global_load_lds((const unsigned*)((const char*)(gbase) + (voff)[_i]), (PG8_LAS unsigned*)(lds + (bufoff) + ldsw + _i * 8192), 16, 0, 0); } while (0)
#define PG8_LDA(dst, b, h) do { _Pragma("unroll") for (int m = 0; m < 4; ++m) _Pragma("unroll") for (int k = 0; k < 2; ++k) dst[m][k] = *(const PG8_LAS bf16x8*)(lds + PG8_SA(b, h) + aoff + m * 2048 + k * 1024); } while (0)
#define PG8_LDB(dst, b, h) do { _Pragma("unroll") for (int n = 0; n < 2; ++n) _Pragma("unroll") for (int k = 0; k < 2; ++k) dst[n][k] = *(const PG8_LAS bf16x8*)(lds + PG8_SB(b, h) + boff + n * 2048 + k * 1024); } while (0)
#define PG8_MMA(ai, bj, At, Bt) do { __builtin_amdgcn_s_setprio(1); _Pragma("unroll") for (int m = 0; m < 4; ++m) _Pragma("unroll") for (int n = 0; n < 2; ++n) _Pragma("unroll") for (int k = 0; k < 2; ++k) \
        acc[ai][bj][m][n] = __builtin_amdgcn_mfma_f32_16x16x32_bf16(Bt[n][k], At[m][k], acc[ai][bj][m][n], 0, 0, 0); __builtin_amdgcn_s_setprio(0); } while (0)
#define PG8_WAIT_V(n) asm volatile("s_waitcnt vmcnt(" #n ")" ::: "memory")
#define PG8_WAIT_L(n) asm volatile("s_waitcnt lgkmcnt(" #n ")" ::: "memory")
#define PG8_BAR __builtin_amdgcn_s_barrier()
#define PG8_SCHED __builtin_amdgcn_sched_barrier(0)
    Unit cur, nxt; int ui = 0;
    if (!S.next(0, cur)) return;
    f32x4 acc[2][2][4][2];
#pragma unroll
    for (int a = 0; a < 2; ++a)
#pragma unroll
        for (int b = 0; b < 2; ++b)
#pragma unroll
            for (int m = 0; m < 4; ++m)
#pragma unroll
                for (int n = 0; n < 2; ++n) acc[a][b][m][n] = (f32x4){0.f, 0.f, 0.f, 0.f};
    bf16x8 At[4][2], B0[2][2], B1[2][2];
    const char* cA = (const char*)g.A + (size_t)cur.pm * tstep; const char* cB = (const char*)g.Bt + (size_t)cur.pn * tstep;
    S.a_ready(cur);
    if constexpr (SP2) {
        PG8_STAGE(PG8_SB(0, 0), cB, voffB); PG8_STAGE(PG8_SB(0, 1), cB + hstep, voffB); PG8_STAGE(PG8_SA(0, 0), cA, voffA); PG8_STAGE(PG8_SA(0, 1), cA + hstep, voffA);
        if (wr == 1) PG8_BAR;
        PG8_WAIT_V(2); PG8_BAR;
        PG8_STAGE(PG8_SB(1, 0), cB + kstep, voffB); PG8_STAGE(PG8_SA(1, 0), cA + kstep, voffA); PG8_STAGE(PG8_SB(1, 1), cB + hstep + kstep, voffB);
        PG8_WAIT_V(6); PG8_BAR;
    } else {
        PG8_STAGE(PG8_SB(0, 0), cB, voffB); PG8_STAGE(PG8_SA(0, 0), cA, voffA); PG8_STAGE(PG8_SB(0, 1), cB + hstep, voffB); PG8_STAGE(PG8_SA(0, 1), cA + hstep, voffA);
        if (wr == 1) PG8_BAR;
        PG8_WAIT_V(4); PG8_BAR;
        PG8_STAGE(PG8_SB(1, 0), cB + kstep, voffB); PG8_STAGE(PG8_SA(1, 0), cA + kstep, voffA); PG8_STAGE(PG8_SB(1, 1), cB + hstep + kstep, voffB);
        PG8_WAIT_V(6); PG8_BAR;
    }
    for (;;) {
        const bool has_next = S.next(ui + 1, nxt);
        const char* nA = has_next ? (const char*)g.A + (size_t)nxt.pm * tstep : cA; const char* nB = has_next ? (const char*)g.Bt + (size_t)nxt.pn * tstep : cB;
        for (int t = 0; t < nt; t += 2) {
            const bool last = (t == nt - 2);
            const char* a1 = cA + (size_t)(t + 1) * kstep;
            const char* a2 = last ? nA : cA + (size_t)(t + 2) * kstep; const char* b2 = last ? nB : cB + (size_t)(t + 2) * kstep;
            const char* a3 = a2 + kstep; const char* b3 = b2 + kstep;
            if (last && has_next) S.a_ready(nxt);
            if constexpr (SP2) {
            PG8_LDB(B0, 0, 0); PG8_LDB(B1, 0, 1); PG8_SCHED; PG8_LDA(At, 0, 0); PG8_STAGE(PG8_SA(1, 1), a1 + hstep, voffA);
            PG8_WAIT_V(8); PG8_WAIT_L(0); PG8_BAR; PG8_MMA(0, 0, At, B0); PG8_MMA(0, 1, At, B1); PG8_BAR; PG8_SCHED;
            PG8_LDA(At, 0, 1); PG8_STAGE(PG8_SB(0, 0), b2, voffB); PG8_STAGE(PG8_SB(0, 1), b2 + hstep, voffB); PG8_STAGE(PG8_SA(0, 0), a2, voffA);
            PG8_WAIT_V(8); PG8_WAIT_L(0); PG8_BAR; PG8_MMA(1, 0, At, B0); PG8_MMA(1, 1, At, B1); PG8_BAR; PG8_SCHED;
            PG8_LDB(B0, 1, 0); PG8_LDB(B1, 1, 1); PG8_SCHED; PG8_LDA(At, 1, 0); PG8_STAGE(PG8_SA(0, 1), a2 + hstep, voffA);
            PG8_WAIT_V(8); PG8_WAIT_L(0); PG8_BAR; PG8_MMA(0, 0, At, B0); PG8_MMA(0, 1, At, B1); PG8_BAR; PG8_SCHED;
            PG8_LDA(At, 1, 1); PG8_STAGE(PG8_SB(1, 0), b3, voffB); PG8_STAGE(PG8_SB(1, 1), b3 + hstep, voffB); PG8_STAGE(PG8_SA(1, 0), a3, voffA);
            PG8_WAIT_V(8); PG8_WAIT_L(0); PG8_BAR; PG8_MMA(1, 0, At, B0); PG8_MMA(1, 1, At, B1); PG8_BAR; PG8_SCHED;
            } else {
            PG8_LDB(B0, 0, 0); PG8_SCHED; PG8_LDA(At, 0, 0); PG8_STAGE(PG8_SA(1, 1), a1 + hstep, voffA);
            PG8_WAIT_L(8); PG8_BAR; PG8_WAIT_L(0); PG8_MMA(0, 0, At, B0); PG8_BAR; PG8_SCHED;
            PG8_LDB(B1, 0, 1); PG8_STAGE(PG8_SB(0, 0), b2, voffB);
            PG8_BAR; PG8_WAIT_L(0); PG8_MMA(0, 1, At, B1); PG8_BAR;
            PG8_LDA(At, 0, 1); PG8_STAGE(PG8_SA(0, 0), a2, voffA);
            PG8_BAR; PG8_WAIT_L(0); PG8_MMA(1, 0, At, B0); PG8_BAR; PG8_SCHED;
            PG8_STAGE(PG8_SB(0, 1), b2 + hstep, voffB);
            PG8_WAIT_V(6); PG8_BAR; PG8_MMA(1, 1, At, B1); PG8_BAR;
            PG8_LDB(B0, 1, 0); PG8_SCHED; PG8_LDA(At, 1, 0); PG8_STAGE(PG8_SA(0, 1), a2 + hstep, voffA);
            PG8_WAIT_L(8); PG8_BAR; PG8_WAIT_L(0); PG8_MMA(0, 0, At, B0); PG8_BAR; PG8_SCHED;
            PG8_LDB(B1, 1, 1); PG8_STAGE(PG8_SB(1, 0), b3, voffB);
            PG8_BAR; PG8_WAIT_L(0); PG8_MMA(0, 1, At, B1); PG8_BAR;
            PG8_LDA(At, 1, 1); PG8_STAGE(PG8_SA(1, 0), a3, voffA);
            PG8_BAR; PG8_WAIT_L(0); PG8_MMA(1, 0, At, B0); PG8_BAR; PG8_SCHED;
            PG8_STAGE(PG8_SB(1, 1), b3 + hstep, voffB);
            PG8_WAIT_V(6); PG8_BAR; PG8_MMA(1, 1, At, B1); PG8_BAR;
            }
        }
        if constexpr (ALIGN_EPI) { if (wr == 0) PG8_BAR; }
        if constexpr (!Epi::AFTER_DRAIN) { E(acc, cur, wr, wc, fr, fq); S.done(cur); }
        if (!has_next) break;
#pragma unroll
        for (int a = 0; a < 2; ++a)
#pragma unroll
            for (int b = 0; b < 2; ++b)
#pragma unroll
                for (int m = 0; m < 4; ++m)
#pragma unroll
                    for (int n = 0; n < 2; ++n) acc[a][b][m][n] = (f32x4){0.f, 0.f, 0.f, 0.f};
        cur = nxt; cA = nA; cB = nB; ++ui;
        if constexpr (ALIGN_EPI) { if (wr == 1) PG8_BAR; }
    }
    PG8_WAIT_V(0);
    if constexpr (!ALIGN_EPI) { if (wr == 0) PG8_BAR; }
    PG8_BAR;
    if constexpr (Epi::AFTER_DRAIN) { E.fused(acc, cur, wr, wc, fr, fq, lds, wid, lane); S.done(cur); }
#undef PG8_SA
#undef PG8_SB
#undef PG8_STAGE
#undef PG8_LDA
#undef PG8_LDB
#undef PG8_MMA
#undef PG8_WAIT_V
#undef PG8_WAIT_L
#undef PG8_BAR
#undef PG8_SCHED
}
}

constexpr int NWAVES = 8;
#ifndef MK_N_LAUNCHES
#define MK_N_LAUNCHES 1
#endif
constexpr int NPH = 12;
constexpr int N_LAUNCHES = MK_N_LAUNCHES;

constexpr int NB = 4, SEQ = 4096, D = 1024, T = NB * SEQ, CTXL = 256, TC = NB * CTXL, TA = T + TC;
constexpr int CC = 512, LW = 512, INC = 2048, NE = 32, NSLOT = 2 * T + NE * 256;
constexpr int NCH = 68;
constexpr float EPS = 1e-6f;

constexpr size_t MiB = 1u << 20;
constexpr size_t WS_CTL = 0, CTL_ZERO_BYTES = 64 * 1024;
constexpr size_t WS_MOD = 1 * MiB;
constexpr size_t WS_RWH = WS_MOD + 128 * 1024;
constexpr size_t WS_RWL = WS_RWH + 96 * 1024;
constexpr size_t WS_RB = WS_RWL + 96 * 1024;
constexpr size_t WS_WG = 2 * MiB;
constexpr size_t WS_WIN = 3 * MiB;
constexpr size_t WS_WOUT = 7 * MiB;
constexpr size_t WS_AGG = 9 * MiB;
constexpr size_t WS_CARRY = 12 * MiB;
constexpr size_t WS_ROUTE = 13 * MiB;
constexpr size_t WS_RG = WS_ROUTE + 256 * 1024;
constexpr size_t WS_SLOT = WS_RG + 128 * 1024;
constexpr size_t WS_GATE = WS_SLOT + 128 * 1024;
constexpr size_t WS_W13 = 16 * MiB;
constexpr size_t WS_W2 = 144 * MiB;
constexpr size_t WS_RA = 208 * MiB;
constexpr size_t WS_RBB = 288 * MiB;
constexpr size_t WS_RC = 368 * MiB;
constexpr size_t WS_END = 448 * MiB;
static_assert((size_t)NSLOT * 1024 * 2 <= 80 * MiB && (size_t)TA * 2048 * 2 <= 80 * MiB && WS_GATE + (size_t)NSLOT * 4 <= WS_W13, "ws map");
constexpr int CW_CNT = 64;
constexpr int CW_BAR = 1024;

constexpr int RING_OFF = 0, RING_BYTES = 131072;
constexpr int SCR_BYTES = 147456;
constexpr int MISC_OFF = SCR_BYTES;
constexpr int LDS_BYTES = SCR_BYTES + 2048;
#define GAS __attribute__((address_space(1)))
#define LAS __attribute__((address_space(3)))
typedef unsigned short bf16;
typedef unsigned v4u __attribute__((ext_vector_type(4)));
typedef float f32x4 __attribute__((ext_vector_type(4)));
typedef short bf16x8 __attribute__((ext_vector_type(8)));
typedef GAS unsigned gu32;
typedef GAS unsigned long long gu64;
#define RLX_AGENT __ATOMIC_RELAXED, __HIP_MEMORY_SCOPE_AGENT
#define LDS_WAIT() asm volatile("s_waitcnt lgkmcnt(0)" ::: "memory")
#define VM_WAIT() asm volatile("s_waitcnt vmcnt(0)" ::: "memory")
__device__ __forceinline__ unsigned long long rt() { return __builtin_amdgcn_s_memrealtime(); }
__device__ __forceinline__ unsigned f2bf(float f) { unsigned u = __builtin_bit_cast(unsigned, f); return (u + 0x7fffu + ((u >> 16) & 1u)) >> 16; }
__device__ __forceinline__ unsigned pk2(float lo, float hi) { return f2bf(lo) | (f2bf(hi) << 16); }

#define XB_TMO      128
#define XB_XCNT(j)  (256  + 64 * (j))
#define XB_XSUB(j)  (1280 + 64 * (j))
#define XB_XGEN(j)  (2304 + 64 * (j))
#define XB_TOP      3328
#define XB_TOPGEN   3392
#define XCD_BAR_WORDS 3456
#define XB_SPIN_CAP (1u << 18)

__device__ __forceinline__ unsigned xb_ld(unsigned* p)              { return __hip_atomic_load(p, __ATOMIC_RELAXED, __HIP_MEMORY_SCOPE_AGENT); }
__device__ __forceinline__ unsigned xb_add(unsigned* p, unsigned v) { return __hip_atomic_fetch_add(p, v, __ATOMIC_RELAXED, __HIP_MEMORY_SCOPE_AGENT); }
__device__ __forceinline__ unsigned xb_xcc_id() { return (unsigned)__builtin_amdgcn_s_getreg((3 << 11) | 20) & 0xFu; }
#define XB_SPIN(cond, bar) do { unsigned _sp = 0; while (cond) { __builtin_amdgcn_s_sleep(1); \
    if ((++_sp & 255u) == 0u) { if (xb_ld(&(bar)[XB_TMO])) break; if (_sp > XB_SPIN_CAP) { atomicAdd(&(bar)[XB_TMO], 1u); break; } } } } while (0)

struct XcdBarrier {
    unsigned* bar; unsigned x;
    volatile LAS unsigned* st;
};

__device__ __forceinline__ XcdBarrier xcd_barrier_post(unsigned* bar, volatile LAS unsigned* st) {
    XcdBarrier b; b.bar = bar; b.x = xb_xcc_id(); b.st = st;
    if (threadIdx.x == 0) (void)xb_add(&bar[XB_XCNT(b.x)], 1u);
    return b;
}
__device__ __forceinline__ void xcd_barrier_complete(unsigned* bar, unsigned x, unsigned& nloc, unsigned& nx) {
    const unsigned G = gridDim.x * gridDim.y * gridDim.z;
    unsigned sum, cnt, mine, sp = 0u;
    for (;;) {
        sum = 0u; cnt = 0u; mine = 0u;
#pragma unroll
        for (unsigned j = 0; j < 16; ++j) { const unsigned c = xb_ld(&bar[XB_XCNT(j)]); sum += c; cnt += (c > 0u) ? 1u : 0u; mine = (j == x) ? c : mine; }
        if (sum == G) break;
        __builtin_amdgcn_s_sleep(1);
        if ((++sp & 255u) == 0u) { if (xb_ld(&bar[XB_TMO])) break; if (sp > XB_SPIN_CAP) { atomicAdd(&bar[XB_TMO], 1u); break; } }
    }
    nloc = mine > 0u ? mine : 1u; nx = cnt > 0u ? cnt : 1u;
}

__device__ __forceinline__ void xcd_barrier(const XcdBarrier& b) {
    asm volatile("s_waitcnt vmcnt(0)" ::: "memory");
    __syncthreads();
    if (threadIdx.x == 0) {
        unsigned* bar = b.bar;
        __builtin_amdgcn_s_waitcnt(0);
        unsigned nloc = b.st[0], nx = b.st[1];
        if (nloc == 0u) { xcd_barrier_complete(bar, b.x, nloc, nx); b.st[0] = nloc; b.st[1] = nx; }
        const unsigned old = xb_add(&bar[XB_XSUB(b.x)], 1u);
        const unsigned gen = old / nloc;
        if (old + 1u == (gen + 1u) * nloc) {
            __builtin_amdgcn_fence(__ATOMIC_RELEASE, "agent");
            asm volatile("s_waitcnt vmcnt(0)" ::: "memory");
            const unsigned og = xb_add(&bar[XB_TOP], 1u);
            const unsigned tg = og / nx;
            if (og + 1u == (tg + 1u) * nx) xb_add(&bar[XB_TOPGEN], 1u);
            else XB_SPIN(xb_ld(&bar[XB_TOPGEN]) == tg, bar);
            __builtin_amdgcn_fence(__ATOMIC_ACQUIRE, "agent");
            xb_add(&bar[XB_XGEN(b.x)], 1u);
            asm volatile("s_waitcnt vmcnt(0)" ::: "memory");
        } else {
            XB_SPIN(xb_ld(&bar[XB_XGEN(b.x)]) == gen, bar);
            __builtin_amdgcn_fence(__ATOMIC_ACQUIRE, "agent");
            asm volatile("s_waitcnt vmcnt(0)" ::: "memory");
        }
    }
    __syncthreads();
}

typedef float f32x2v __attribute__((ext_vector_type(2)));
typedef unsigned u32x2v __attribute__((ext_vector_type(2)));
typedef int i32x4v __attribute__((ext_vector_type(4)));
typedef int i32x2v __attribute__((ext_vector_type(2)));
__device__ __forceinline__ float wave_sum(float v) {
#pragma unroll
    for (int o = 1; o < 64; o <<= 1) v += __shfl_xor(v, o);
    return v;
}
__device__ __forceinline__ float bf2f(unsigned short h) { return __builtin_bit_cast(float, (unsigned)h << 16); }
__device__ __forceinline__ float bflo(unsigned w) { return __builtin_bit_cast(float, w << 16); }
__device__ __forceinline__ float bfhi(unsigned w) { return __builtin_bit_cast(float, w & 0xffff0000u); }
__device__ __forceinline__ float sigmoid_f(float v) { return 1.0f / (1.0f + __expf(-v)); }
__device__ __forceinline__ float silu_ff(float v) { return v / (1.0f + __expf(-v)); }
__device__ __forceinline__ float gelu_tanh_f(float v) { const float y = 1.5957691216057308f * (v + 0.044715f * v * v * v); return v / (1.0f + __expf(-y)); }

__device__ __forceinline__ void p0_transpose_item(const float* W, int K, int N, bf16* WT, int row_off, int rmul, LAS float* scr, int item, int lane) {
    const int nblk = N / 64, kb = item / nblk, nb = item % nblk, k0 = 64 * kb, n0 = 64 * nb;
    const int r4 = lane >> 4, q = lane & 15;
    f32x4 v[16];
#pragma unroll
    for (int i = 0; i < 16; ++i) v[i] = *(const f32x4*)(W + (size_t)(k0 + 4 * i + r4) * N + n0 + 4 * q);
#pragma unroll
    for (int i = 0; i < 16; ++i) { LAS float* d = scr + (4 * i + r4) * 65 + 4 * q; d[0] = v[i].x; d[1] = v[i].y; d[2] = v[i].z; d[3] = v[i].w; }
    LDS_WAIT(); asm volatile("" ::: "memory");
    const int c = lane & 7;
#pragma unroll
    for (int j = 0; j < 8; ++j) { const int n = (lane >> 3) + 8 * j; const LAS float* s = scr + (8 * c) * 65 + n;
        v4u o; o.x = pk2(s[0 * 65], s[1 * 65]); o.y = pk2(s[2 * 65], s[3 * 65]); o.z = pk2(s[4 * 65], s[5 * 65]); o.w = pk2(s[6 * 65], s[7 * 65]);
        *(v4u*)(WT + (size_t)(row_off + rmul * (n0 + n)) * K + k0 + 8 * c) = o; }
    LDS_WAIT(); asm volatile("" ::: "memory");
}

struct Ptrs {
    const float* in[29]; float* out; unsigned char* ws;
};

__device__ __forceinline__ void phase_p0a(const Ptrs& P, LAS unsigned char* lds, int tid, int lane, int wave, int vcu, int G) {
    {
        const float* c = P.in[1]; const float* c_ctx = P.in[3]; const float* w_ada = P.in[4]; const float* b_ada = P.in[5];
        float* MOD = (float*)(P.ws + WS_MOD);
        LAS float* red = (LAS float*)lds;
        const int r4 = lane >> 4, q = lane & 15;
        for (int cb = vcu; cb < 96; cb += G) {
            f32x4 acc[5];
#pragma unroll
            for (int r = 0; r < 5; ++r) acc[r] = (f32x4){0.f, 0.f, 0.f, 0.f};
#pragma unroll 8
            for (int i = 0; i < 32; ++i) {
                const int k = wave * 128 + 4 * i + r4;
                const f32x4 w = *(const f32x4*)(w_ada + (size_t)k * 6144 + 64 * cb + 4 * q);
#pragma unroll
                for (int r = 0; r < 5; ++r) { const float sv = silu_ff(r < 4 ? c[r * 1024 + k] : c_ctx[k]); acc[r] += w * sv; }
            }
#pragma unroll
            for (int r = 0; r < 5; ++r) {
#pragma unroll
                for (int e = 0; e < 4; ++e) { float t = acc[r][e]; t += __shfl_xor(t, 16); t += __shfl_xor(t, 32); acc[r][e] = t; }
                if (r4 == 0) *(LAS f32x4*)(red + (wave * 5 + r) * 64 + 4 * q) = acc[r];
            }
            __syncthreads();
            if (tid < 320) { const int r = tid >> 6, cc = tid & 63; float sm = 0.f;
#pragma unroll
                for (int w8 = 0; w8 < 8; ++w8) sm += red[(w8 * 5 + r) * 64 + cc];
                MOD[r * 6144 + 64 * cb + cc] = sm + b_ada[64 * cb + cc]; }
            __syncthreads();
        }
    }
    {
        bf16* RWH = (bf16*)(P.ws + WS_RWH); bf16* RWL = (bf16*)(P.ws + WS_RWL); float* RB = (float*)(P.ws + WS_RB);
        const float* wg = P.in[21]; const float* bg = P.in[22]; const float* we = P.in[23]; const float* be = P.in[24];
        for (int i = vcu * 512 + tid; i < 48 * 1024; i += G * 512) { const int n = i >> 10, k = i & 1023;
            const float w = n < 4 ? wg[k * 4 + n] : (n < 36 ? we[k * 32 + n - 4] : 0.f);
            const unsigned hi = f2bf(w); const float lo = w - __builtin_bit_cast(float, hi << 16);
            RWH[i] = (bf16)hi; RWL[i] = (bf16)f2bf(lo); }
        if (vcu == 0 && tid < 48) RB[tid] = tid < 4 ? bg[tid] : (tid < 36 ? be[tid - 4] : 0.f);
    }
    {
        LAS float* scr = (LAS float*)(lds + wave * 16640);
        const int gw = vcu * NWAVES + wave, NGW = G * NWAVES;
        bf16* WIN = (bf16*)(P.ws + WS_WIN); bf16* WOUT = (bf16*)(P.ws + WS_WOUT); bf16* WG = (bf16*)(P.ws + WS_WG); bf16* W13 = (bf16*)(P.ws + WS_W13); bf16* W2 = (bf16*)(P.ws + WS_W2);
        constexpr int I_IN = 16 * 32, I_OUT = 16 * 16, I_G = 32, I_E = 32 * 256;
        constexpr int NITEMS = I_IN + I_OUT + I_G + 3 * I_E;
        for (int it = gw; it < NITEMS; it += NGW) {
            int r = it;
            if (r < I_E) { const int e = r >> 8; p0_transpose_item(P.in[25] + (size_t)e * 1048576, 1024, 1024, W13, e * 2048, 2, scr, r & 255, lane); continue; } r -= I_E;
            if (r < I_E) { const int e = r >> 8; p0_transpose_item(P.in[26] + (size_t)e * 1048576, 1024, 1024, W13, e * 2048 + 1, 2, scr, r & 255, lane); continue; } r -= I_E;
            if (r < I_E) { const int e = r >> 8; p0_transpose_item(P.in[27] + (size_t)e * 1048576, 1024, 1024, W2, e * 1024, 1, scr, r & 255, lane); continue; } r -= I_E;
            if (r < I_IN) { p0_transpose_item(P.in[8], 1024, 2048, WIN, 0, 1, scr, r, lane); continue; } r -= I_IN;
            if (r < I_OUT) { p0_transpose_item(P.in[20], 1024, 1024, WOUT, 0, 1, scr, r, lane); continue; } r -= I_OUT;
            { const int which = r >> 4, mtx = r & 15;
                p0_transpose_item((which ? P.in[17] : P.in[15]) + mtx * 4096, 64, 64, WG, mtx * 128 + which * 64, 1, scr, 0, lane); }
        }
    }
}

__device__ __forceinline__ void phase_p0b(const Ptrs& P, int lane, int wave, int vcu, int G) {
    const float* MOD = (const float*)(P.ws + WS_MOD); const float* g1n = P.in[6];
    bf16* XN = (bf16*)(P.ws + WS_RA);
    const int gw = vcu * NWAVES + wave, NGW = G * NWAVES;
    for (int m = gw; m < TA; m += NGW) {
        const float* src; int mr;
        if (m < T) { src = P.in[0] + (size_t)m * D; mr = m >> 12; } else { src = P.in[2] + (size_t)(m - T) * D; mr = 4; }
        const f32x4* xr = (const f32x4*)src + lane;
        f32x4 v[4]; float s = 0.f;
#pragma unroll
        for (int j = 0; j < 4; ++j) { v[j] = xr[64 * j]; s += (v[j].x * v[j].x + v[j].y * v[j].y) + (v[j].z * v[j].z + v[j].w * v[j].w); }
        const float rstd = 1.0f / sqrtf(wave_sum(s) * (1.f / D) + EPS);
        const f32x4* gp = (const f32x4*)g1n + lane; const f32x4* shp = (const f32x4*)(MOD + mr * 6144) + lane; const f32x4* scp = (const f32x4*)(MOD + mr * 6144 + 1024) + lane;
        unsigned long long* o8 = (unsigned long long*)(XN + (size_t)m * D) + lane;
#pragma unroll
        for (int j = 0; j < 4; ++j) { const f32x4 g = gp[64 * j], sh = shp[64 * j], sc = scp[64 * j];
            const f32x4 y = v[j] * rstd * g * (sc + 1.0f) + sh;
            o8[64 * j] = (unsigned long long)pk2(y.x, y.y) | ((unsigned long long)pk2(y.z, y.w) << 32); }
    }
}

constexpr int L_UIN = 0;
constexpr int L_UF = 17408;
constexpr int L_UB = 33792;
constexpr int L_AS = 43008;
constexpr int L_BS = 75776;
constexpr int L_SEG = 108544;
template <bool FINAL>
__device__ __forceinline__ void lru_item(const Ptrs& P, LAS unsigned char* lds, int b, int chunk, int h, int tid, int lane, int wave) {
    const bf16* ZL = (const bf16*)(P.ws + WS_RBB);
    const bf16* WG = (const bf16*)(P.ws + WS_WG);
    LAS float* uin = (LAS float*)(lds + L_UIN); LAS float* uf = (LAS float*)(lds + L_UF); LAS bf16* ub = (LAS bf16*)(lds + L_UB);
    LAS float* As = (LAS float*)(lds + L_AS); LAS float* Bs = (LAS float*)(lds + L_BS); LAS float* SEG = (LAS float*)(lds + L_SEG);
    const bool isctx = chunk < 4;
    const int seq_row0 = isctx ? (T + b * CTXL) : (b * SEQ), seq_len = isctx ? CTXL : SEQ, t0 = (isctx ? chunk : chunk - 4) * 64;
    {
        const int c2 = tid & 31, rq = tid >> 5;
        for (int r = rq; r < 67; r += 16) {
            const int tt = t0 + r - 2; unsigned w = 0u;
            if (tt >= 0 && tt < seq_len) w = *(const unsigned*)(ZL + (size_t)(seq_row0 + tt) * INC + 1024 + 64 * h + 2 * c2);
            uin[r * 64 + 2 * c2] = bflo(w); uin[r * 64 + 2 * c2 + 1] = bfhi(w);
        }
    }
    __syncthreads();
    {
        const int c = tid & 63, tq = tid >> 6; const float* cw = P.in[13]; const int ch = 64 * h + c;
        const float w0 = cw[ch], w1 = cw[512 + ch], w2 = cw[1024 + ch], w3 = cw[1536 + ch], bb = P.in[14][ch];
#pragma unroll
        for (int i = 0; i < 8; ++i) { const int t = tq * 8 + i;
            const float u = bb + w0 * uin[t * 64 + c] + w1 * uin[(t + 1) * 64 + c] + w2 * uin[(t + 2) * 64 + c] + w3 * uin[(t + 3) * 64 + c];
            uf[t * 64 + c] = u; ub[t * 72 + c] = (bf16)f2bf(u); }
    }
    __syncthreads();
    {
        const int d = wave >> 2, cgp = wave & 3, l15 = lane & 15, l4 = lane >> 4;
        bf16x8 bfr[2][2];
#pragma unroll
        for (int which = 0; which < 2; ++which)
#pragma unroll
            for (int ks = 0; ks < 2; ++ks) bfr[which][ks] = *(const bf16x8*)(WG + (size_t)(((d * 8 + h) * 128 + which * 64 + 16 * cgp + l15) * 64 + 32 * ks + 8 * l4));
        const int ch = 64 * h + 16 * cgp + l15;
        const float ba_ = P.in[16][d * 512 + ch], bx_ = P.in[18][d * 512 + ch], lam = P.in[19][d * 512 + ch];
        const float sp8 = -8.0f * log1pf(expf(-lam));
#pragma unroll
        for (int mt = 0; mt < 4; ++mt) {
            bf16x8 af[2];
#pragma unroll
            for (int ks = 0; ks < 2; ++ks) af[ks] = *(const LAS bf16x8*)(ub + (16 * mt + l15) * 72 + 32 * ks + 8 * l4);
            f32x4 ar = {0.f, 0.f, 0.f, 0.f}, ai = {0.f, 0.f, 0.f, 0.f};
            ar = __builtin_amdgcn_mfma_f32_16x16x32_bf16(af[0], bfr[0][0], ar, 0, 0, 0); ar = __builtin_amdgcn_mfma_f32_16x16x32_bf16(af[1], bfr[0][1], ar, 0, 0, 0);
            ai = __builtin_amdgcn_mfma_f32_16x16x32_bf16(af[0], bfr[1][0], ai, 0, 0, 0); ai = __builtin_amdgcn_mfma_f32_16x16x32_bf16(af[1], bfr[1][1], ai, 0, 0, 0);
#pragma unroll
            for (int rg = 0; rg < 4; ++rg) {
                const int t = 16 * mt + 4 * l4 + rg, cl = 16 * cgp + l15;
                const float r = sigmoid_f(ar[rg] + ba_), ig = sigmoid_f(ai[rg] + bx_);
                const float la = sp8 * r;
                const float a = __expf(la);
                const float x2 = 2.0f * la;
                float em = x2 * (1.0f + x2 * (0.5f + x2 * (0.16666667f + x2 * (0.041666668f + x2 * (0.0083333338f + x2 * (0.0013888889f + x2 * 0.0001984127f))))));
                const float mult = sqrtf(fmaxf(-em, 1e-12f));
                As[(d * 64 + t) * 64 + cl] = a; Bs[(d * 64 + t) * 64 + cl] = mult * ig * uf[t * 64 + cl];
            }
        }
    }
    __syncthreads();
    const int c = tid & 63, d = (tid >> 6) & 1, seg = tid >> 7;
    {
        float Pp = 1.f, Hh = 0.f;
#pragma unroll
        for (int i = 0; i < 16; ++i) { const int t = d ? (16 * seg + 15 - i) : (16 * seg + i); const float a = As[(d * 64 + t) * 64 + c], bq = Bs[(d * 64 + t) * 64 + c]; Hh = a * Hh + bq; Pp *= a; }
        SEG[((d * 4 + seg) * 64 + c) * 2] = Pp; SEG[((d * 4 + seg) * 64 + c) * 2 + 1] = Hh;
    }
    __syncthreads();
    if (!FINAL) {
        if (seg == 0) {
            float Pt = 1.f, Ht = 0.f;
#pragma unroll
            for (int q = 0; q < 4; ++q) { const int s = d ? 3 - q : q; const float ps = SEG[((d * 4 + s) * 64 + c) * 2], hs = SEG[((d * 4 + s) * 64 + c) * 2 + 1]; Ht = ps * Ht + hs; Pt *= ps; }
            float* AGG = (float*)(P.ws + WS_AGG);
            *(f32x2v*)(AGG + ((size_t)((b * NCH + chunk) * 2 + d) * 512 + 64 * h + c) * 2) = (f32x2v){Pt, Ht};
        }
    } else {
        const float* CARRY = (const float*)(P.ws + WS_CARRY);
        float hh = CARRY[(size_t)((b * 64 + (chunk - 4)) * 2 + d) * 512 + 64 * h + c];
        for (int q = 0; q < 4; ++q) { const int s = d ? 3 - q : q; if (s == seg) break; const float ps = SEG[((d * 4 + s) * 64 + c) * 2], hs = SEG[((d * 4 + s) * 64 + c) * 2 + 1]; hh = ps * hh + hs; }
#pragma unroll
        for (int i = 0; i < 16; ++i) { const int t = d ? (16 * seg + 15 - i) : (16 * seg + i); const float a = As[(d * 64 + t) * 64 + c], bq = Bs[(d * 64 + t) * 64 + c]; hh = a * hh + bq; Bs[(d * 64 + t) * 64 + c] = hh; }
        __syncthreads();
        bf16* MIX = (bf16*)(P.ws + WS_RC);
        const int c2 = tid & 31, tq = tid >> 5;
#pragma unroll
        for (int i = 0; i < 4; ++i) { const int t = tq + 16 * i; const size_t row = (size_t)(b * SEQ + t0 + t);
            const unsigned zg = *(const unsigned*)(ZL + row * INC + 1536 + 64 * h + 2 * c2);
            const float o0 = (Bs[t * 64 + 2 * c2] + Bs[(64 + t) * 64 + 2 * c2]) * gelu_tanh_f(bflo(zg));
            const float o1 = (Bs[t * 64 + 2 * c2 + 1] + Bs[(64 + t) * 64 + 2 * c2 + 1]) * gelu_tanh_f(bfhi(zg));
            *(unsigned*)(MIX + row * D + 512 + 64 * h + 2 * c2) = pk2(o0, o1); }
    }
    __syncthreads();
}

template <int T0> __device__ __forceinline__ void conv_rows8(const float (&uu)[64], const float (&w)[31], float cb, LAS float* cs, int c) {
#pragma unroll
    for (int tt = 0; tt < 8; ++tt) {
        float acc = cb;
#pragma unroll
        for (int j = 0; j < 31; ++j) { const int s = T0 + tt + j - 15; if (s >= 0 && s < 64) acc += w[j] * uu[s]; }
        cs[(T0 + tt) * 512 + c] = acc;
    }
}
__device__ __forceinline__ void conv_item(const Ptrs& P, LAS unsigned char* lds, int item, int tid, int lane, int wave) {
    const bf16* ZL = (const bf16*)(P.ws + WS_RBB); bf16* MIX = (bf16*)(P.ws + WS_RC);
    LAS float* cs = (LAS float*)lds;
    {
        const int c = tid;
        const bf16* base = ZL + (size_t)(item * 64) * INC + c;
        float uu[64];
#pragma unroll
        for (int t = 0; t < 64; ++t) { const float val = bf2f(base[(size_t)t * INC]), gt = bf2f(base[(size_t)t * INC + 512]); uu[t] = val * sigmoid_f(gt); }
        float w[31];
#pragma unroll
        for (int j = 0; j < 31; ++j) w[j] = P.in[9][j * 512 + c];
        const float cb = P.in[10][c];
        conv_rows8<0>(uu, w, cb, cs, c); conv_rows8<8>(uu, w, cb, cs, c); conv_rows8<16>(uu, w, cb, cs, c); conv_rows8<24>(uu, w, cb, cs, c);
        conv_rows8<32>(uu, w, cb, cs, c); conv_rows8<40>(uu, w, cb, cs, c); conv_rows8<48>(uu, w, cb, cs, c); conv_rows8<56>(uu, w, cb, cs, c);
    }
    __syncthreads();
    {
        const f32x4 g0 = *(const f32x4*)(P.in[11] + 8 * lane), g1 = *(const f32x4*)(P.in[11] + 8 * lane + 4);
        const f32x4 b0 = *(const f32x4*)(P.in[12] + 8 * lane), b1 = *(const f32x4*)(P.in[12] + 8 * lane + 4);
#pragma unroll 2
        for (int i = 0; i < 8; ++i) { const int t = wave * 8 + i;
            f32x4 v0 = *(const LAS f32x4*)(cs + t * 512 + 8 * lane), v1 = *(const LAS f32x4*)(cs + t * 512 + 8 * lane + 4);
            const float mu = wave_sum((v0.x + v0.y) + (v0.z + v0.w) + (v1.x + v1.y) + (v1.z + v1.w)) * (1.f / 512.f);
            v0 = v0 - mu; v1 = v1 - mu;
            const float var = wave_sum((v0.x * v0.x + v0.y * v0.y) + (v0.z * v0.z + v0.w * v0.w) + (v1.x * v1.x + v1.y * v1.y) + (v1.z * v1.z + v1.w * v1.w)) * (1.f / 512.f);
            const float rstd = 1.0f / sqrtf(var + EPS);
            const f32x4 y0 = v0 * rstd * g0 + b0, y1 = v1 * rstd * g1 + b1;
            v4u o; o.x = pk2(silu_ff(y0.x), silu_ff(y0.y)); o.y = pk2(silu_ff(y0.z), silu_ff(y0.w)); o.z = pk2(silu_ff(y1.x), silu_ff(y1.y)); o.w = pk2(silu_ff(y1.z), silu_ff(y1.w));
            *(v4u*)(MIX + (size_t)(item * 64 + t) * D + 8 * lane) = o; }
    }
    __syncthreads();
}

__device__ __forceinline__ void phase_p2a(const Ptrs& P, LAS unsigned char* lds, int tid, int lane, int wave, int vcu, int G) {
    for (int it = vcu; it < NB * NCH * 8; it += G) { const int h = it & 7, bc = it >> 3; lru_item<false>(P, lds, bc / NCH, bc % NCH, h, tid, lane, wave); }
    for (int it = vcu; it < NB * 64; it += G) conv_item(P, lds, it, tid, lane, wave);
}
__device__ __forceinline__ void phase_p2b(const Ptrs& P, int tid, int vcu, int G) {
    const float* AGG = (const float*)(P.ws + WS_AGG); float* CARRY = (float*)(P.ws + WS_CARRY);
    for (int idx = vcu * 512 + tid; idx < NB * 2 * 512; idx += G * 512) {
        const int b = idx >> 10, d = (idx >> 9) & 1, ch = idx & 511;
        float hh = 0.f;
        if (d == 0) {
#pragma unroll
            for (int q = 0; q < 4; ++q) { const f32x2v ab = *(const f32x2v*)(AGG + ((size_t)((b * NCH + q) * 2 + 0) * 512 + ch) * 2); hh = ab.x * hh + ab.y; }
#pragma unroll 8
            for (int lc = 0; lc < 64; ++lc) { const f32x2v ab = *(const f32x2v*)(AGG + ((size_t)((b * NCH + 4 + lc) * 2 + 0) * 512 + ch) * 2);
                CARRY[(size_t)((b * 64 + lc) * 2 + 0) * 512 + ch] = hh; hh = ab.x * hh + ab.y; }
        } else {
#pragma unroll
            for (int q = 3; q >= 0; --q) { const f32x2v ab = *(const f32x2v*)(AGG + ((size_t)((b * NCH + q) * 2 + 1) * 512 + ch) * 2); hh = ab.x * hh + ab.y; }
#pragma unroll 8
            for (int lc = 63; lc >= 0; --lc) { const f32x2v ab = *(const f32x2v*)(AGG + ((size_t)((b * NCH + 4 + lc) * 2 + 1) * 512 + ch) * 2);
                CARRY[(size_t)((b * 64 + lc) * 2 + 1) * 512 + ch] = hh; hh = ab.x * hh + ab.y; }
        }
    }
}
__device__ __forceinline__ void phase_p2c(const Ptrs& P, LAS unsigned char* lds, int tid, int lane, int wave, int vcu, int G) {
    for (int it = vcu; it < NB * 64 * 8; it += G) { const int h = it & 7, bc = it >> 3; lru_item<true>(P, lds, bc >> 6, 4 + (bc & 63), h, tid, lane, wave); }
}

constexpr int L_AH = 0, L_AL = 66048, HL_PITCH = 2064;
constexpr int L_PART = 0;
constexpr int L_LG = 132096;
constexpr int L_LCNT = 138240;
constexpr int L_LBASE = 138368;
__device__ __forceinline__ void phase_p4a(const Ptrs& P, LAS unsigned char* lds, int tid, int lane, int wave, int vcu, int G) {
    const float* MOD = (const float*)(P.ws + WS_MOD); const float* g2n = P.in[7];
    const bf16* RWH = (const bf16*)(P.ws + WS_RWH); const bf16* RWL = (const bf16*)(P.ws + WS_RWL); const float* RB = (const float*)(P.ws + WS_RB);
    bf16* H2 = (bf16*)(P.ws + WS_RC + 32 * MiB);
    unsigned* gcnt = (unsigned*)(P.ws + WS_CTL) + CW_CNT;
    LAS float* lg = (LAS float*)(lds + L_LG); LAS int* lcnt = (LAS int*)(lds + L_LCNT); LAS int* lbase = (LAS int*)(lds + L_LBASE); LAS float* part = (LAS float*)(lds + L_PART);
    const int l15 = lane & 15, l4 = lane >> 4;
    for (int it = vcu; it < T / 32; it += G) {
        if (tid < 32) lcnt[tid] = 0;
        for (int i = 0; i < 4; ++i) {
            const int tl = wave * 4 + i, tok = it * 32 + tl, mr = tok >> 12;
            const f32x4* xr = (const f32x4*)(P.out + (size_t)tok * D) + lane;
            f32x4 v[4]; float s = 0.f;
#pragma unroll
            for (int j = 0; j < 4; ++j) { v[j] = xr[64 * j]; s += (v[j].x * v[j].x + v[j].y * v[j].y) + (v[j].z * v[j].z + v[j].w * v[j].w); }
            const float rstd = 1.0f / sqrtf(wave_sum(s) * (1.f / D) + EPS);
            const f32x4* gp = (const f32x4*)g2n + lane; const f32x4* shp = (const f32x4*)(MOD + mr * 6144 + 3072) + lane; const f32x4* scp = (const f32x4*)(MOD + mr * 6144 + 4096) + lane;
            unsigned long long* o8 = (unsigned long long*)(H2 + (size_t)tok * D) + lane;
#pragma unroll
            for (int j = 0; j < 4; ++j) { const f32x4 g = gp[64 * j], sh = shp[64 * j], sc = scp[64 * j];
                const f32x4 y = v[j] * rstd * g * (sc + 1.0f) + sh;
                const unsigned h0 = f2bf(y.x), h1 = f2bf(y.y), h2_ = f2bf(y.z), h3 = f2bf(y.w);
                const unsigned long long pk = (unsigned long long)(h0 | (h1 << 16)) | ((unsigned long long)(h2_ | (h3 << 16)) << 32);
                const unsigned long long pl = (unsigned long long)pk2(y.x - __builtin_bit_cast(float, h0 << 16), y.y - __builtin_bit_cast(float, h1 << 16)) |
                                              ((unsigned long long)pk2(y.z - __builtin_bit_cast(float, h2_ << 16), y.w - __builtin_bit_cast(float, h3 << 16)) << 32);
                o8[64 * j] = pk;
                *(LAS unsigned long long*)(lds + L_AH + tl * HL_PITCH + (lane + 64 * j) * 8) = pk;
                *(LAS unsigned long long*)(lds + L_AL + tl * HL_PITCH + (lane + 64 * j) * 8) = pl; }
        }
        __syncthreads();
        {
            f32x4 acc[2][3];
#pragma unroll
            for (int mt = 0; mt < 2; ++mt)
#pragma unroll
                for (int nt = 0; nt < 3; ++nt) acc[mt][nt] = (f32x4){0.f, 0.f, 0.f, 0.f};
#pragma unroll
            for (int kq = 0; kq < 4; ++kq) {
                const int kof = 32 * (4 * wave + kq) + 8 * l4;
                bf16x8 ah[2], al[2], bh[3], bl[3];
#pragma unroll
                for (int nt = 0; nt < 3; ++nt) { bh[nt] = *(const bf16x8*)(RWH + (size_t)(16 * nt + l15) * 1024 + kof); bl[nt] = *(const bf16x8*)(RWL + (size_t)(16 * nt + l15) * 1024 + kof); }
#pragma unroll
                for (int mt = 0; mt < 2; ++mt) { ah[mt] = *(const LAS bf16x8*)(lds + L_AH + (16 * mt + l15) * HL_PITCH + kof * 2); al[mt] = *(const LAS bf16x8*)(lds + L_AL + (16 * mt + l15) * HL_PITCH + kof * 2); }
#pragma unroll
                for (int mt = 0; mt < 2; ++mt)
#pragma unroll
                    for (int nt = 0; nt < 3; ++nt) {
                        acc[mt][nt] = __builtin_amdgcn_mfma_f32_16x16x32_bf16(al[mt], bh[nt], acc[mt][nt], 0, 0, 0);
                        acc[mt][nt] = __builtin_amdgcn_mfma_f32_16x16x32_bf16(ah[mt], bl[nt], acc[mt][nt], 0, 0, 0);
                        acc[mt][nt] = __builtin_amdgcn_mfma_f32_16x16x32_bf16(ah[mt], bh[nt], acc[mt][nt], 0, 0, 0); }
            }
            __syncthreads();
#pragma unroll
            for (int mt = 0; mt < 2; ++mt)
#pragma unroll
                for (int nt = 0; nt < 3; ++nt)
#pragma unroll
                    for (int rg = 0; rg < 4; ++rg) part[(wave * 32 + 16 * mt + 4 * l4 + rg) * 48 + 16 * nt + l15] = acc[mt][nt][rg];
        }
        __syncthreads();
        for (int o = tid; o < 32 * 48; o += 512) { float sm = 0.f;
#pragma unroll
            for (int w8 = 0; w8 < 8; ++w8) sm += part[w8 * 1536 + o];
            lg[o] = sm + RB[o % 48]; }
        __syncthreads();
        int e0 = 0, e1 = 0, rk0 = 0, rk1 = 0; float gt0 = 0.f, gt1 = 0.f;
        if (tid < 32) {
            const LAS float* l = lg + tid * 48;
            int grp = 0; float lm = l[0];
#pragma unroll
            for (int q = 1; q < 4; ++q) if (l[q] > lm) { lm = l[q]; grp = q; }
            float den = 0.f;
#pragma unroll
            for (int q = 0; q < 4; ++q) den += __expf(l[q] - lm);
            const float pgrp = 1.0f / den;
            const LAS float* le = l + 4 + grp * 8;
            int i1 = 0; float m1 = le[0];
#pragma unroll
            for (int q = 1; q < 8; ++q) if (le[q] > m1) { m1 = le[q]; i1 = q; }
            int i2 = -1; float m2 = -3.0e38f;
#pragma unroll
            for (int q = 0; q < 8; ++q) if (q != i1 && le[q] > m2) { m2 = le[q]; i2 = q; }
            const float ex = __expf(m2 - m1), inv = 1.0f / (1.0f + ex);
            gt0 = pgrp * inv; gt1 = pgrp * ex * inv;
            e0 = grp * 8 + i1; e1 = grp * 8 + i2;
            rk0 = atomicAdd((int*)(lcnt + e0), 1); rk1 = atomicAdd((int*)(lcnt + e1), 1);
        }
        __syncthreads();
        if (tid < 32) lbase[tid] = (int)__hip_atomic_fetch_add(gcnt + tid, (unsigned)lcnt[tid], __ATOMIC_RELAXED, __HIP_MEMORY_SCOPE_AGENT);
        __syncthreads();
        if (tid < 32) {
            const int tok = it * 32 + tid;
            *(i32x4v*)(P.ws + WS_ROUTE + (size_t)tok * 16) = (i32x4v){e0, lbase[e0] + rk0, e1, lbase[e1] + rk1};
            *(f32x2v*)(P.ws + WS_RG + (size_t)tok * 8) = (f32x2v){gt0, gt1};
        }
        __syncthreads();
    }
}
__device__ __forceinline__ void build_tiles(const Ptrs& P, volatile LAS unsigned* MISC, int tid) {
    if (tid == 0) {
        unsigned* gcnt = (unsigned*)(P.ws + WS_CTL) + CW_CNT;
        int run = 0;
        for (int e = 0; e < NE; ++e) {
            const int cnt = (int)__hip_atomic_load(gcnt + e, __ATOMIC_RELAXED, __HIP_MEMORY_SCOPE_AGENT);
            const int nt = (cnt + 255) >> 8;
            MISC[16 + e] = (unsigned)(run * 256);
            for (int q = 0; q < nt && run + q < 192; ++q) MISC[64 + run + q] = (unsigned)e;
            run += nt;
        }
        MISC[8] = (unsigned)(run < 192 ? run : 192);
    }
    __syncthreads();
}
__device__ __forceinline__ void phase_p4b(const Ptrs& P, volatile LAS unsigned* MISC, int lane, int wave, int vcu, int G) {
    const bf16* H2 = (const bf16*)(P.ws + WS_RC + 32 * MiB); bf16* XS = (bf16*)(P.ws + WS_RA);
    float* GATE = (float*)(P.ws + WS_GATE);
    const int gw = vcu * NWAVES + wave, NGW = G * NWAVES;
    for (int tok = gw; tok < T; tok += NGW) {
        const i32x4v r = *(const i32x4v*)(P.ws + WS_ROUTE + (size_t)tok * 16);
        const f32x2v g = *(const f32x2v*)(P.ws + WS_RG + (size_t)tok * 8);
        const int s0 = (int)MISC[16 + r.x] + r.y, s1 = (int)MISC[16 + r.z] + r.w;
        const v4u* src = (const v4u*)(H2 + (size_t)tok * D) + lane;
        const v4u a0 = src[0], a1 = src[64];
        v4u* d0 = (v4u*)(XS + (size_t)s0 * D) + lane; v4u* d1 = (v4u*)(XS + (size_t)s1 * D) + lane;
        d0[0] = a0; d0[64] = a1; d1[0] = a0; d1[64] = a1;
        if (lane == 0) { GATE[s0] = g.x; GATE[s1] = g.y; *(i32x2v*)(P.ws + WS_SLOT + (size_t)tok * 8) = (i32x2v){s0, s1}; }
    }
}
__device__ __forceinline__ void phase_p6(const Ptrs& P, int lane, int wave, int vcu, int G) {
    const float* MOD = (const float*)(P.ws + WS_MOD); const float* fg = P.in[28];
    const bf16* Y = (const bf16*)(P.ws + WS_RC);
    const int gw = vcu * NWAVES + wave, NGW = G * NWAVES;
    for (int tok = gw; tok < T; tok += NGW) {
        const i32x2v sl = *(const i32x2v*)(P.ws + WS_SLOT + (size_t)tok * 8);
        const int mr = tok >> 12;
        f32x4* xr = (f32x4*)(P.out + (size_t)tok * D) + lane;
        const u32x2v* y0 = (const u32x2v*)(Y + (size_t)sl.x * D) + lane; const u32x2v* y1 = (const u32x2v*)(Y + (size_t)sl.y * D) + lane;
        const f32x4* g2p = (const f32x4*)(MOD + mr * 6144 + 5120) + lane;
        f32x4 v[4]; float s = 0.f;
#pragma unroll
        for (int j = 0; j < 4; ++j) { const f32x4 xv = xr[64 * j], g2 = g2p[64 * j]; const u32x2v a = y0[64 * j], bq = y1[64 * j];
            f32x4 yy; yy.x = bflo(a.x) + bflo(bq.x); yy.y = bfhi(a.x) + bfhi(bq.x); yy.z = bflo(a.y) + bflo(bq.y); yy.w = bfhi(a.y) + bfhi(bq.y);
            v[j] = xv + g2 * yy; s += (v[j].x * v[j].x + v[j].y * v[j].y) + (v[j].z * v[j].z + v[j].w * v[j].w); }
        const float rstd = 1.0f / sqrtf(wave_sum(s) * (1.f / D) + EPS);
        const f32x4* fgp = (const f32x4*)fg + lane;
#pragma unroll
        for (int j = 0; j < 4; ++j) xr[64 * j] = v[j] * rstd * fgp[64 * j];
    }
}

struct Args { const float* in[29]; float* out; unsigned char* ws; int ph_lo, ph_hi, li, pad; };
__global__ void __launch_bounds__(NWAVES * 64, 2) fwd_kernel(Args args) {
    extern __shared__ __attribute__((aligned(16))) unsigned char lds_raw[];
    LAS unsigned char* lds = (LAS unsigned char*)lds_raw;
    volatile LAS unsigned* MISC = (volatile LAS unsigned*)(lds + MISC_OFF);
    const int tid = threadIdx.x, lane = tid & 63, wave = __builtin_amdgcn_readfirstlane(tid >> 6);
    const int G = gridDim.x; const int bx = blockIdx.x; const int vcu = (G % 8 == 0) ? (bx % 8) * (G / 8) + bx / 8 : bx;
    Ptrs P;
#pragma unroll
    for (int i = 0; i < 29; ++i) P.in[i] = args.in[i];
    P.out = args.out; P.ws = args.ws;
    for (int u = tid; u < (LDS_BYTES - MISC_OFF) / 4; u += NWAVES * 64) MISC[u] = 0u;
    __syncthreads();
    unsigned* ctl = (unsigned*)(P.ws + WS_CTL);
    XcdBarrier bar; bar.bar = ctl + CW_BAR; bar.x = 0; bar.st = nullptr;
    if (N_LAUNCHES == 1) bar = xcd_barrier_post(ctl + CW_BAR, MISC);
#define GRID_BAR() do { if (N_LAUNCHES == 1) xcd_barrier(bar); } while (0)
    const int lo = args.ph_lo, hi = args.ph_hi;
#define IN(k) (lo <= (k) && (k) < hi)
#ifdef PROBE_LO
#define STAMP(k) do { if (bx == 0 && tid == 0) MISC[256 + (k)] = (unsigned)__builtin_amdgcn_s_memrealtime(); } while (0)
#else
#define STAMP(k) do {} while (0)
#endif
    STAMP(0);
#define BOTH(k) (IN(k) && IN((k) + 1))

    if (IN(0)) { phase_p0a(P, lds, tid, lane, wave, vcu, G); if (BOTH(0)) GRID_BAR(); STAMP(1); }
    if (IN(1)) { phase_p0b(P, lane, wave, vcu, G); if (BOTH(1)) GRID_BAR(); STAMP(2); }
    if (IN(2)) {
        pg8::Gemm g{(const pg8::bf16_t*)(P.ws + WS_RA), (const pg8::bf16_t*)(P.ws + WS_WIN), TA, INC, D};
        pg8::OrderInProj S; S.so.init(T, INC, G, bx);
        pg8::EpiStoreBf16 E{(pg8::bf16_t*)(P.ws + WS_RBB), INC};
        pg8::gemm_phase<pg8::EpiStoreBf16, pg8::OrderInProj, true, true>(lds + RING_OFF, g, S, E);
        if (BOTH(2)) GRID_BAR(); STAMP(3);
    }
    if (IN(3)) { phase_p2a(P, lds, tid, lane, wave, vcu, G); if (BOTH(3)) GRID_BAR(); STAMP(4); }
    if (IN(4)) { phase_p2b(P, tid, vcu, G); if (BOTH(4)) GRID_BAR(); STAMP(5); }
    if (IN(5)) { phase_p2c(P, lds, tid, lane, wave, vcu, G); if (BOTH(5)) GRID_BAR(); STAMP(6); }
    if (IN(6)) {
        pg8::Gemm g{(const pg8::bf16_t*)(P.ws + WS_RC), (const pg8::bf16_t*)(P.ws + WS_WOUT), T, D, D};
        pg8::StaticOrder S; S.init(T, D, G, bx);
        pg8::EpiResid E{P.in[0], (const float*)(P.ws + WS_MOD) + 2048, 6144, P.out};
        pg8::gemm_phase<pg8::EpiResid, pg8::StaticOrder, true, true>(lds + RING_OFF, g, S, E);
        if (BOTH(6)) GRID_BAR(); STAMP(7);
    }
    if (IN(7)) { phase_p4a(P, lds, tid, lane, wave, vcu, G); if (BOTH(7)) GRID_BAR(); STAMP(8); }
    if (IN(8)) { build_tiles(P, MISC, tid); phase_p4b(P, MISC, lane, wave, vcu, G); if (BOTH(8)) GRID_BAR(); STAMP(9); }
    if (IN(9)) {
        build_tiles(P, MISC, tid);
        pg8::Gemm g{(const pg8::bf16_t*)(P.ws + WS_RA), (const pg8::bf16_t*)(P.ws + WS_W13), NSLOT, 2048, D};
        pg8::OrderMoe S{G, bx, 8, (int)MISC[8] * 8, (const LAS int*)(lds + MISC_OFF + 256)};
        pg8::EpiSwiglu E{(pg8::bf16_t*)(P.ws + WS_RBB)};
        pg8::gemm_phase<pg8::EpiSwiglu, pg8::OrderMoe, true, true>(lds + RING_OFF, g, S, E);
        if (BOTH(9)) GRID_BAR(); STAMP(10);
    }
    if (IN(10)) {
        build_tiles(P, MISC, tid);
        pg8::Gemm g{(const pg8::bf16_t*)(P.ws + WS_RBB), (const pg8::bf16_t*)(P.ws + WS_W2), NSLOT, 1024, D};
        pg8::OrderMoe S{G, bx, 4, (int)MISC[8] * 4, (const LAS int*)(lds + MISC_OFF + 256)};
        pg8::EpiGateBf16 E{(pg8::bf16_t*)(P.ws + WS_RC), (const float*)(P.ws + WS_GATE)};
        pg8::gemm_phase<pg8::EpiGateBf16, pg8::OrderMoe, true, true>(lds + RING_OFF, g, S, E);
        if (BOTH(10)) GRID_BAR(); STAMP(11);
    }
    if (IN(11)) { phase_p6(P, lane, wave, vcu, G); }
#ifdef PROBE_LO
    if (bx == 0 && tid == 0) {
        const unsigned dt = (MISC[256 + PROBE_HI] - MISC[256 + PROBE_LO]) * PROBE_MULT;
        const unsigned t0 = (unsigned)__builtin_amdgcn_s_memrealtime();
        while ((unsigned)__builtin_amdgcn_s_memrealtime() - t0 < dt) __builtin_amdgcn_s_sleep(32);
    }
#endif
#undef IN
#undef BOTH
}

extern "C" void kernel_launch(void* const* d_in, const int* in_sizes, int n_in, void* d_out, int out_size, void* d_ws, size_t ws_size, hipStream_t stream) {
    static int grid = 0;
    if (grid == 0) {
        if (n_in != 29 || in_sizes[0] != T * D || out_size != T * D || ws_size < WS_END) { fprintf(stderr, "kernel_launch: built for 29 inputs, x and out of %d floats, >= %zu bytes of workspace; got n_in %d, in0 %d, out %d, ws %zu; nothing launched\n", T * D, (size_t)WS_END, n_in, n_in > 0 ? in_sizes[0] : -1, out_size, ws_size); grid = -1; return; }
        int dev = 0, cus = 0, per_cu = 0;
        if (hipGetDevice(&dev) != hipSuccess || hipDeviceGetAttribute(&cus, hipDeviceAttributeMultiprocessorCount, dev) != hipSuccess) { fprintf(stderr, "kernel_launch: hipGetDevice / hipDeviceGetAttribute failed\n"); grid = -1; return; }
        if (hipFuncSetAttribute((const void*)fwd_kernel, hipFuncAttributeMaxDynamicSharedMemorySize, LDS_BYTES) != hipSuccess) { fprintf(stderr, "kernel_launch: hipFuncSetAttribute failed (%d bytes of dynamic LDS)\n", LDS_BYTES); grid = -1; return; }
        if (hipOccupancyMaxActiveBlocksPerMultiprocessor(&per_cu, (const void*)fwd_kernel, NWAVES * 64, LDS_BYTES) != hipSuccess || per_cu < 1)
            fprintf(stderr, "kernel_launch: note: the occupancy query reports %d workgroups per CU\n", per_cu);
        (void)hipGetLastError();
        grid = cus;
    }
    if (grid < 0) return;
    if (hipMemsetAsync((char*)d_ws + WS_CTL, 0, CTL_ZERO_BYTES, stream) != hipSuccess) { fprintf(stderr, "kernel_launch: hipMemsetAsync failed\n"); return; }
    Args a{};
    for (int i = 0; i < 29; ++i) a.in[i] = (const float*)d_in[i];
    a.out = (float*)d_out; a.ws = (unsigned char*)d_ws;
    for (int li = 0; li < N_LAUNCHES; ++li) {
        a.ph_lo = (N_LAUNCHES == 1) ? 0 : li; a.ph_hi = (N_LAUNCHES == 1) ? NPH : li + 1; a.li = li;
        hipLaunchKernelGGL(fwd_kernel, dim3(grid), dim3(NWAVES * 64), LDS_BYTES, stream, a);
        const hipError_t le = hipPeekAtLastError();
        if (le != hipSuccess) { fprintf(stderr, "kernel_launch: launch %d failed: %s\n", li, hipGetErrorName(le)); break; }
    }
}
```

```cpp
#include <hip/hip_runtime.h>
#include <cstdio>
#include <cstdint>
namespace pg8 {
#define PG8_LAS __attribute__((address_space(3)))
typedef unsigned short bf16_t;
typedef short bf16x8 __attribute__((ext_vector_type(8)));
typedef float f32x4 __attribute__((ext_vector_type(4)));
typedef unsigned u32x4 __attribute__((ext_vector_type(4)));
constexpr int BM = 256, BK = 64, HALF = 128, HTB = HALF * BK * 2  , STAGE_BYTES = 8 * HTB, NXCD = 8, WGM = 8;

__host__ __device__ __forceinline__ int lds_byte(int r, int c) { const int st = (r >> 4) * 2 + (c >> 5), rr = r & 15, cc = c & 31, ob = rr * 64 + cc * 2; return st * 1024 + (ob ^ (((ob >> 9) & 1) << 5)); }
__host__ __device__ __forceinline__ void stage_rc(int b, int& R, int& C) { const int st = b / 1024, sb = b % 1024, swz = sb ^ (((sb >> 9) & 1) << 5); R = (st >> 1) * 16 + swz / 64; C = (st & 1) * 32 + (swz % 64) / 2; }
__host__ __device__ __forceinline__ int perm32(int rho) { const int n = rho >> 4, i = rho & 15; return 8 * (i >> 2) + 4 * n + (i & 3); }

struct Unit { int pm, pn; };
struct Gemm { const bf16_t* A; const bf16_t* Bt; int M, N, K; };

struct StaticOrder {
    int nM, nN, nwg, G, c;
    __host__ __device__ void init(int M, int N, int G_, int c_) { nM = M / BM; nN = N / BM; nwg = nM * nN; G = G_; c = c_; }
    __host__ __device__ bool next(int i, Unit& u) const {
        const long L = (long)i * G + c; if (L >= nwg) return false;
        int wgid = (int)L; { const int q = nwg / NXCD, r = nwg % NXCD, xcd = wgid % NXCD, off = wgid / NXCD; wgid = (xcd < r ? xcd * (q + 1) : r * (q + 1) + (xcd - r) * q) + off; }
        const int nig = WGM * nN, gid = wgid / nig, fm = gid * WGM, gsz = (nM - fm) < WGM ? (nM - fm) : WGM;
        u.pm = fm + ((wgid % nig) % gsz); u.pn = (wgid % nig) / gsz; return true;
    }
    __device__ __forceinline__ void a_ready(const Unit&) const {}
    __device__ __forceinline__ void done(const Unit&) const {}
};

__device__ __forceinline__ unsigned cvt_pk_bf16(float lo, float hi) { unsigned r; asm volatile("v_cvt_pk_bf16_f32 %0, %1, %2" : "=v"(r) : "v"(lo), "v"(hi)); return r; }
typedef unsigned u32x2 __attribute__((ext_vector_type(2)));
__device__ __forceinline__ float silu_f(float v) { return v / (1.0f + __expf(-v)); }

struct EpiStoreBf16 {
    static constexpr bool PERM = true, AFTER_DRAIN = false;
    bf16_t* O; int ldc;
    __device__ __forceinline__ void operator()(const f32x4 (&acc)[2][2][4][2], const Unit& u, int wr, int wc, int fr, int fq) const {
        const int row0 = u.pm * BM + wr * 64 + fr, col0 = u.pn * BM + wc * 32 + 8 * fq;
#pragma unroll
        for (int ai = 0; ai < 2; ++ai)
#pragma unroll
            for (int m = 0; m < 4; ++m) { bf16_t* rowp = O + (size_t)(row0 + ai * HALF + m * 16) * ldc + col0;
#pragma unroll
                for (int bj = 0; bj < 2; ++bj) { const f32x4 v0 = acc[ai][bj][m][0], v1 = acc[ai][bj][m][1];
                    u32x4 w; w.x = cvt_pk_bf16(v0[0], v0[1]); w.y = cvt_pk_bf16(v0[2], v0[3]); w.z = cvt_pk_bf16(v1[0], v1[1]); w.w = cvt_pk_bf16(v1[2], v1[3]);
                    *(u32x4*)(rowp + bj * HALF) = w; } }
    }
};
struct EpiResid {
    static constexpr bool PERM = true, AFTER_DRAIN = false;
    const float* x; const float* g; int gp; float* out;
    __device__ __forceinline__ void operator()(const f32x4 (&acc)[2][2][4][2], const Unit& u, int wr, int wc, int fr, int fq) const {
        const int row0 = u.pm * BM + wr * 64 + fr, col0 = u.pn * BM + wc * 32 + 8 * fq;
        const float* gb = g + (size_t)((u.pm * BM) >> 12) * gp + col0;
        f32x4 gv[2][2];
#pragma unroll
        for (int bj = 0; bj < 2; ++bj) { gv[bj][0] = *(const f32x4*)(gb + bj * HALF); gv[bj][1] = *(const f32x4*)(gb + bj * HALF + 4); }
#pragma unroll
        for (int ai = 0; ai < 2; ++ai)
#pragma unroll
            for (int m = 0; m < 4; ++m) { const size_t off = (size_t)(row0 + ai * HALF + m * 16) * 1024 + col0;
#pragma unroll
                for (int bj = 0; bj < 2; ++bj) {
                    const f32x4 x0 = *(const f32x4*)(x + off + bj * HALF), x1 = *(const f32x4*)(x + off + bj * HALF + 4);
                    *(f32x4*)(out + off + bj * HALF) = x0 + gv[bj][0] * acc[ai][bj][m][0];
                    *(f32x4*)(out + off + bj * HALF + 4) = x1 + gv[bj][1] * acc[ai][bj][m][1]; } }
    }
};
struct EpiSwiglu {
    static constexpr bool PERM = true, AFTER_DRAIN = false;
    bf16_t* H;
    __device__ __forceinline__ void operator()(const f32x4 (&acc)[2][2][4][2], const Unit& u, int wr, int wc, int fr, int fq) const {
        const int row0 = u.pm * BM + wr * 64 + fr, col0 = (u.pn & 7) * 128 + wc * 16 + 4 * fq;
#pragma unroll
        for (int ai = 0; ai < 2; ++ai)
#pragma unroll
            for (int m = 0; m < 4; ++m) { bf16_t* rowp = H + (size_t)(row0 + ai * HALF + m * 16) * 1024 + col0;
#pragma unroll
                for (int bj = 0; bj < 2; ++bj) { const f32x4 v0 = acc[ai][bj][m][0], v1 = acc[ai][bj][m][1];
                    u32x2 w; w.x = cvt_pk_bf16(silu_f(v0[0]) * v0[1], silu_f(v0[2]) * v0[3]); w.y = cvt_pk_bf16(silu_f(v1[0]) * v1[1], silu_f(v1[2]) * v1[3]);
                    *(u32x2*)(rowp + bj * 64) = w; } }
    }
};
struct EpiGateBf16 {
    static constexpr bool PERM = true, AFTER_DRAIN = false;
    bf16_t* Y; const float* gate;
    __device__ __forceinline__ void operator()(const f32x4 (&acc)[2][2][4][2], const Unit& u, int wr, int wc, int fr, int fq) const {
        const int row0 = u.pm * BM + wr * 64 + fr, col0 = (u.pn & 3) * BM + wc * 32 + 8 * fq;
#pragma unroll
        for (int ai = 0; ai < 2; ++ai)
#pragma unroll
            for (int m = 0; m < 4; ++m) { const int row = row0 + ai * HALF + m * 16; const float gt = gate[row]; bf16_t* rowp = Y + (size_t)row * 1024 + col0;
#pragma unroll
                for (int bj = 0; bj < 2; ++bj) { const f32x4 v0 = acc[ai][bj][m][0] * gt, v1 = acc[ai][bj][m][1] * gt;
                    u32x4 w; w.x = cvt_pk_bf16(v0[0], v0[1]); w.y = cvt_pk_bf16(v0[2], v0[3]); w.z = cvt_pk_bf16(v1[0], v1[1]); w.w = cvt_pk_bf16(v1[2], v1[3]);
                    *(u32x4*)(rowp + bj * HALF) = w; } }
    }
};
struct OrderInProj {
    StaticOrder so;
    __device__ bool next(int i, Unit& u) const {
        const long L = (long)i * so.G + so.c;
        if (L < so.nwg) return so.next(i, u);
        const int j = (int)(L - so.nwg); if (j >= 8) return false;
        u.pm = 64 + (j >> 1); u.pn = 4 + (j & 1); return true;
    }
    __device__ __forceinline__ void a_ready(const Unit&) const {}
    __device__ __forceinline__ void done(const Unit&) const {}
};
struct OrderMoe {
    int G, c, ntn, nunits; const PG8_LAS int* tile_e;
    __device__ bool next(int i, Unit& u) const {
        const long L = (long)i * G + c; if (L >= nunits) return false;
        const int rt = (int)L / ntn, pn = (int)L % ntn;
        u.pm = rt; u.pn = tile_e[rt] * ntn + pn; return true;
    }
    __device__ __forceinline__ void a_ready(const Unit&) const {}
    __device__ __forceinline__ void done(const Unit&) const {}
};
template <class Epi, class Sched, bool ALIGN_EPI = false, bool SP2 = false>
__device__ __forceinline__ void gemm_phase(PG8_LAS unsigned char* lds, const Gemm g, const Sched& S, const Epi& E) {
    const int tid = threadIdx.x, wid = __builtin_amdgcn_readfirstlane(tid >> 6), lane = tid & 63, wr = wid >> 2, wc = wid & 3, fr = lane & 15, fq = lane >> 4;
    const int K = g.K, nt = K / BK;
    unsigned voffA[2], voffB[2];
#pragma unroll
    for (int i = 0; i < 2; ++i) { int R, C; stage_rc(tid * 16 + i * 8192, R, C); const int Rb = Epi::PERM ? ((R & ~31) + perm32(R & 31)) : R;
        voffA[i] = (unsigned)(R * K + C) * 2u; voffB[i] = (unsigned)(Rb * K + C) * 2u; }
    const size_t kstep = (size_t)(BK * 2);
    const size_t hstep = (size_t)HALF * K * 2;
    const size_t tstep = 2 * hstep;
    const unsigned ldsw = (unsigned)wid * 1024u;
    const int aoff = lds_byte(wr * 64 + fr, fq * 8), boff = lds_byte(wc * 32 + fr, fq * 8);
#define PG8_SA(b, h) (((b) * 2 + (h)) * HTB)
#define PG8_SB(b, h) ((4 + (b) * 2 + (h)) * HTB)
#define PG8_STAGE(bufoff, gbase, voff) do { _Pragma("unroll") for (int _i = 0; _i < 2; ++_i) \
        __builtin_amdgcn_global_load_lds((const unsigned*)((const char*)(gbase) + (voff)[_i]), (PG8_LAS unsigned*)(lds + (bufoff) + ldsw + _i * 8192), 16, 0, 0); } while (0)
#define PG8_LDA(dst, b, h) do { _Pragma("unroll") for (int m = 0; m < 4; ++m) _Pragma("unroll") for (int k = 0; k < 2; ++k) dst[m][k] = *(const PG8_LAS bf16x8*)(lds + PG8_SA(b, h) + aoff + m * 2048 + k * 1024); } while (0)
#define PG8_LDB(dst, b, h) do { _Pragma("unroll") for (int n = 0; n < 2; ++n) _Pragma("unroll") for (int k = 0; k < 2; ++k) dst[n][k] = *(const PG8_LAS bf16x8*)(lds + PG8_SB(b, h) + boff + n * 2048 + k * 1024); } while (0)
#define PG8_MMA(ai, bj, At, Bt) do { __builtin_amdgcn_s_setprio(1); _Pragma("unroll") for (int m = 0; m < 4; ++m) _Pragma("unroll") for (int n = 0; n < 2; ++n) _Pragma("unroll") for (int k = 0; k < 2; ++k) \
        acc[ai][bj][m][n] = __builtin_amdgcn_mfma_f32_16x16x32_bf16(Bt[n][k], At[m][k], acc[ai][bj][m][n], 0, 0, 0); __builtin_amdgcn_s_setprio(0); } while (0)
#define PG8_WAIT_V(n) asm volatile("s_waitcnt vmcnt(" #n ")" ::: "memory")
#define PG8_WAIT_L(n) asm volatile("s_waitcnt lgkmcnt(" #n ")" ::: "memory")
#define PG8_BAR __builtin_amdgcn_s_barrier()
#define PG8_SCHED __builtin_amdgcn_sched_barrier(0)
    Unit cur, nxt; int ui = 0;
    if (!S.next(0, cur)) return;
    f32x4 acc[2][2][4][2];
#pragma unroll
    for (int a = 0; a < 2; ++a)
#pragma unroll
        for (int b = 0; b < 2; ++b)
#pragma unroll
            for (int m = 0; m < 4; ++m)
#pragma unroll
                for (int n = 0; n < 2; ++n) acc[a][b][m][n] = (f32x4){0.f, 0.f, 0.f, 0.f};
    bf16x8 At[4][2], B0[2][2], B1[2][2];
    const char* cA = (const char*)g.A + (size_t)cur.pm * tstep; const char* cB = (const char*)g.Bt + (size_t)cur.pn * tstep;
    S.a_ready(cur);
    if constexpr (SP2) {
        PG8_STAGE(PG8_SB(0, 0), cB, voffB); PG8_STAGE(PG8_SB(0, 1), cB + hstep, voffB); PG8_STAGE(PG8_SA(0, 0), cA, voffA); PG8_STAGE(PG8_SA(0, 1), cA + hstep, voffA);
        if (wr == 1) PG8_BAR;
        PG8_WAIT_V(2); PG8_BAR;
        PG8_STAGE(PG8_SB(1, 0), cB + kstep, voffB); PG8_STAGE(PG8_SA(1, 0), cA + kstep, voffA); PG8_STAGE(PG8_SB(1, 1), cB + hstep + kstep, voffB);
        PG8_WAIT_V(6); PG8_BAR;
    } else {
        PG8_STAGE(PG8_SB(0, 0), cB, voffB); PG8_STAGE(PG8_SA(0, 0), cA, voffA); PG8_STAGE(PG8_SB(0, 1), cB + hstep, voffB); PG8_STAGE(PG8_SA(0, 1), cA + hstep, voffA);
        if (wr == 1) PG8_BAR;
        PG8_WAIT_V(4); PG8_BAR;
        PG8_STAGE(PG8_SB(1, 0), cB + kstep, voffB); PG8_STAGE(PG8_SA(1, 0), cA + kstep, voffA); PG8_STAGE(PG8_SB(1, 1), cB + hstep + kstep, voffB);
        PG8_WAIT_V(6); PG8_BAR;
    }
    for (;;) {
        const bool has_next = S.next(ui + 1, nxt);
        const char* nA = has_next ? (const char*)g.A + (size_t)nxt.pm * tstep : cA; const char* nB = has_next ? (const char*)g.Bt + (size_t)nxt.pn * tstep : cB;
        for (int t = 0; t < nt; t += 2) {
            const bool last = (t == nt - 2);
            const char* a1 = cA + (size_t)(t + 1) * kstep;
            const char* a2 = last ? nA : cA + (size_t)(t + 2) * kstep; const char* b2 = last ? nB : cB + (size_t)(t + 2) * kstep;
            const char* a3 = a2 + kstep; const char* b3 = b2 + kstep;
            if (last && has_next) S.a_ready(nxt);
            if constexpr (SP2) {
            PG8_LDB(B0, 0, 0); PG8_LDB(B1, 0, 1); PG8_SCHED; PG8_LDA(At, 0, 0); PG8_STAGE(PG8_SA(1, 1), a1 + hstep, voffA);
            PG8_WAIT_V(8); PG8_WAIT_L(0); PG8_BAR; PG8_MMA(0, 0, At, B0); PG8_MMA(0, 1, At, B1); PG8_BAR; PG8_SCHED;
            PG8_LDA(At, 0, 1); PG8_STAGE(PG8_SB(0, 0), b2, voffB); PG8_STAGE(PG8_SB(0, 1), b2 + hstep, voffB); PG8_STAGE(PG8_SA(0, 0), a2, voffA);
            PG8_WAIT_V(8); PG8_WAIT_L(0); PG8_BAR; PG8_MMA(1, 0, At, B0); PG8_MMA(1, 1, At, B1); PG8_BAR; PG8_SCHED;
            PG8_LDB(B0, 1, 0); PG8_LDB(B1, 1, 1); PG8_SCHED; PG8_LDA(At, 1, 0); PG8_STAGE(PG8_SA(0, 1), a2 + hstep, voffA);
            PG8_WAIT_V(8); PG8_WAIT_L(0); PG8_BAR; PG8_MMA(0, 0, At, B0); PG8_MMA(0, 1, At, B1); PG8_BAR; PG8_SCHED;
            PG8_LDA(At, 1, 1); PG8_STAGE(PG8_SB(1, 0), b3, voffB); PG8_STAGE(PG8_SB(1, 1), b3 + hstep, voffB); PG8_STAGE(PG8_SA(1, 0), a3, voffA);
            PG8_WAIT_V(8); PG8_WAIT_L(0); PG8_BAR; PG8_MMA(1, 0, At, B0); PG8_MMA(1, 1, At, B1); PG8_BAR; PG8_SCHED;
            } else {
            PG8_LDB(B0, 0, 0); PG8_SCHED; PG8_LDA(At, 0, 0); PG8_STAGE(PG8_SA(1, 1), a1 + hstep, voffA);
            PG8_WAIT_L(8); PG8_BAR; PG8_WAIT_L(0); PG8_MMA(0, 0, At, B0); PG8_BAR; PG8_SCHED;
            PG8_LDB(B1, 0, 1); PG8_STAGE(PG8_SB(0, 0), b2, voffB);
            PG8_BAR; PG8_WAIT_L(0); PG8_MMA(0, 1, At, B1); PG8_BAR;
            PG8_LDA(At, 0, 1); PG8_STAGE(PG8_SA(0, 0), a2, voffA);
            PG8_BAR; PG8_WAIT_L(0); PG8_MMA(1, 0, At, B0); PG8_BAR; PG8_SCHED;
            PG8_STAGE(PG8_SB(0, 1), b2 + hstep, voffB);
            PG8_WAIT_V(6); PG8_BAR; PG8_MMA(1, 1, At, B1); PG8_BAR;
            PG8_LDB(B0, 1, 0); PG8_SCHED; PG8_LDA(At, 1, 0); PG8_STAGE(PG8_SA(0, 1), a2 + hstep, voffA);
            PG8_WAIT_L(8); PG8_BAR; PG8_WAIT_L(0); PG8_MMA(0, 0, At, B0); PG8_BAR; PG8_SCHED;
            PG8_LDB(B1, 1, 1); PG8_STAGE(PG8_SB(1, 0), b3, voffB);
            PG8_BAR; PG8_WAIT_L(0); PG8_MMA(0, 1, At, B1); PG8_BAR;
            PG8_LDA(At, 1, 1); PG8_STAGE(PG8_SA(1, 0), a3, voffA);
            PG8_BAR; PG8_WAIT_L(0); PG8_MMA(1, 0, At, B0); PG8_BAR; PG8_SCHED;
            PG8_STAGE(PG8_SB(1, 1), b3 + hstep, voffB);
            PG8_WAIT_V(6); PG8_BAR; PG8_MMA(1, 1, At, B1); PG8_BAR;
            }
        }
        if constexpr (ALIGN_EPI) { if (wr == 0) PG8_BAR; }
        if constexpr (!Epi::AFTER_DRAIN) { E(acc, cur, wr, wc, fr, fq); S.done(cur); }
        if (!has_next) break;
#pragma unroll
        for (int a = 0; a < 2; ++a)
#pragma unroll
            for (int b = 0; b < 2; ++b)
#pragma unroll
                for (int m = 0; m < 4; ++m)
#pragma unroll
                    for (int n = 0; n < 2; ++n) acc[a][b][m][n] = (f32x4){0.f, 0.f, 0.f, 0.f};
        cur = nxt; cA = nA; cB = nB; ++ui;
        if constexpr (ALIGN_EPI) { if (wr == 1) PG8_BAR; }
    }
    PG8_WAIT_V(0);
    if constexpr (!ALIGN_EPI) { if (wr == 0) PG8_BAR; }
    PG8_BAR;
    if constexpr (Epi::AFTER_DRAIN) { E.fused(acc, cur, wr, wc, fr, fq, lds, wid, lane); S.done(cur); }
#undef PG8_SA
#undef PG8_SB
#undef PG8_STAGE
#undef PG8_LDA
#undef PG8_LDB
#undef PG8_MMA
#undef PG8_WAIT_V
#undef PG8_WAIT_L
#undef PG8_BAR
#undef PG8_SCHED
}
}

constexpr int NWAVES = 8;
#ifndef MK_N_LAUNCHES
#define MK_N_LAUNCHES 1
#endif
constexpr int NPH = 12;
constexpr int N_LAUNCHES = MK_N_LAUNCHES;

constexpr int NB = 4, SEQ = 4096, D = 1024, T = NB * SEQ, CTXL = 256, TC = NB * CTXL, TA = T + TC;
constexpr int CC = 512, LW = 512, INC = 2048, NE = 32, NSLOT = 2 * T + NE * 256;
constexpr int NCH = 272;
constexpr float EPS = 1e-6f;

constexpr size_t MiB = 1u << 20;
constexpr size_t WS_CTL = 0, CTL_ZERO_BYTES = 64 * 1024;
constexpr size_t WS_MOD = 1 * MiB;
constexpr size_t WS_RWH = WS_MOD + 128 * 1024;
constexpr size_t WS_RWL = WS_RWH + 96 * 1024;
constexpr size_t WS_RB = WS_RWL + 96 * 1024;
constexpr size_t WS_WG = 2 * MiB;
constexpr size_t WS_WIN = 3 * MiB;
constexpr size_t WS_WOUT = 7 * MiB;
constexpr size_t WS_AGG = 464 * MiB;
constexpr size_t WS_CARRY = 474 * MiB;
constexpr size_t WS_ROUTE = 13 * MiB;
constexpr size_t WS_RG = WS_ROUTE + 256 * 1024;
constexpr size_t WS_SLOT = WS_RG + 128 * 1024;
constexpr size_t WS_GATE = WS_SLOT + 128 * 1024;
constexpr size_t WS_W13 = 16 * MiB;
constexpr size_t WS_W2 = 144 * MiB;
constexpr size_t WS_RA = 208 * MiB;
constexpr size_t WS_RBB = 288 * MiB;
constexpr size_t WS_RC = 368 * MiB;
constexpr size_t WS_END = 480 * MiB;
static_assert((size_t)NSLOT * 1024 * 2 <= 80 * MiB && (size_t)TA * 2048 * 2 <= 80 * MiB && WS_GATE + (size_t)NSLOT * 4 <= WS_W13, "ws map");
constexpr int CW_CNT = 64;
constexpr int CW_BAR = 1024;

constexpr int RING_OFF = 0, RING_BYTES = 131072;
constexpr int SCR_BYTES = 147456;
constexpr int MISC_OFF = SCR_BYTES;
constexpr int LDS_BYTES = SCR_BYTES + 2048;
#define GAS __attribute__((address_space(1)))
#define LAS __attribute__((address_space(3)))
typedef unsigned short bf16;
typedef unsigned v4u __attribute__((ext_vector_type(4)));
typedef float f32x4 __attribute__((ext_vector_type(4)));
typedef short bf16x8 __attribute__((ext_vector_type(8)));
typedef GAS unsigned gu32;
typedef GAS unsigned long long gu64;
#define RLX_AGENT __ATOMIC_RELAXED, __HIP_MEMORY_SCOPE_AGENT
#define LDS_WAIT() asm volatile("s_waitcnt lgkmcnt(0)" ::: "memory")
#define VM_WAIT() asm volatile("s_waitcnt vmcnt(0)" ::: "memory")
__device__ __forceinline__ unsigned long long rt() { return __builtin_amdgcn_s_memrealtime(); }
__device__ __forceinline__ unsigned f2bf(float f) { unsigned u = __builtin_bit_cast(unsigned, f); return (u + 0x7fffu + ((u >> 16) & 1u)) >> 16; }
__device__ __forceinline__ unsigned pk2(float lo, float hi) { return f2bf(lo) | (f2bf(hi) << 16); }

#define XB_TMO      128
#define XB_XCNT(j)  (256  + 64 * (j))
#define XB_XSUB(j)  (1280 + 64 * (j))
#define XB_XGEN(j)  (2304 + 64 * (j))
#define XB_TOP      3328
#define XB_TOPGEN   3392
#define XCD_BAR_WORDS 3456
#define XB_SPIN_CAP (1u << 18)

__device__ __forceinline__ unsigned xb_ld(unsigned* p)              { return __hip_atomic_load(p, __ATOMIC_RELAXED, __HIP_MEMORY_SCOPE_AGENT); }
__device__ __forceinline__ unsigned xb_add(unsigned* p, unsigned v) { return __hip_atomic_fetch_add(p, v, __ATOMIC_RELAXED, __HIP_MEMORY_SCOPE_AGENT); }
__device__ __forceinline__ unsigned xb_xcc_id() { return (unsigned)__builtin_amdgcn_s_getreg((3 << 11) | 20) & 0xFu; }
#define XB_SPIN(cond, bar) do { unsigned _sp = 0; while (cond) { __builtin_amdgcn_s_sleep(1); \
    if ((++_sp & 255u) == 0u) { if (xb_ld(&(bar)[XB_TMO])) break; if (_sp > XB_SPIN_CAP) { atomicAdd(&(bar)[XB_TMO], 1u); break; } } } } while (0)

struct XcdBarrier {
    unsigned* bar; unsigned x;
    volatile LAS unsigned* st;
};

__device__ __forceinline__ XcdBarrier xcd_barrier_post(unsigned* bar, volatile LAS unsigned* st) {
    XcdBarrier b; b.bar = bar; b.x = xb_xcc_id(); b.st = st;
    if (threadIdx.x == 0) (void)xb_add(&bar[XB_XCNT(b.x)], 1u);
    return b;
}
__device__ __forceinline__ void xcd_barrier_complete(unsigned* bar, unsigned x, unsigned& nloc, unsigned& nx) {
    const unsigned G = gridDim.x * gridDim.y * gridDim.z;
    unsigned sum, cnt, mine, sp = 0u;
    for (;;) {
        sum = 0u; cnt = 0u; mine = 0u;
#pragma unroll
        for (unsigned j = 0; j < 16; ++j) { const unsigned c = xb_ld(&bar[XB_XCNT(j)]); sum += c; cnt += (c > 0u) ? 1u : 0u; mine = (j == x) ? c : mine; }
        if (sum == G) break;
        __builtin_amdgcn_s_sleep(1);
        if ((++sp & 255u) == 0u) { if (xb_ld(&bar[XB_TMO])) break; if (sp > XB_SPIN_CAP) { atomicAdd(&bar[XB_TMO], 1u); break; } }
    }
    nloc = mine > 0u ? mine : 1u; nx = cnt > 0u ? cnt : 1u;
}

__device__ __forceinline__ void xcd_barrier(const XcdBarrier& b) {
    asm volatile("s_waitcnt vmcnt(0)" ::: "memory");
    __syncthreads();
    if (threadIdx.x == 0) {
        unsigned* bar = b.bar;
        __builtin_amdgcn_s_waitcnt(0);
        unsigned nloc = b.st[0], nx = b.st[1];
        if (nloc == 0u) { xcd_barrier_complete(bar, b.x, nloc, nx); b.st[0] = nloc; b.st[1] = nx; }
        const unsigned old = xb_add(&bar[XB_XSUB(b.x)], 1u);
        const unsigned gen = old / nloc;
        if (old + 1u == (gen + 1u) * nloc) {
            __builtin_amdgcn_fence(__ATOMIC_RELEASE, "agent");
            asm volatile("s_waitcnt vmcnt(0)" ::: "memory");
            const unsigned og = xb_add(&bar[XB_TOP], 1u);
            const unsigned tg = og / nx;
            if (og + 1u == (tg + 1u) * nx) xb_add(&bar[XB_TOPGEN], 1u);
            else XB_SPIN(xb_ld(&bar[XB_TOPGEN]) == tg, bar);
            __builtin_amdgcn_fence(__ATOMIC_ACQUIRE, "agent");
            xb_add(&bar[XB_XGEN(b.x)], 1u);
            asm volatile("s_waitcnt vmcnt(0)" ::: "memory");
        } else {
            XB_SPIN(xb_ld(&bar[XB_XGEN(b.x)]) == gen, bar);
            __builtin_amdgcn_fence(__ATOMIC_ACQUIRE, "agent");
            asm volatile("s_waitcnt vmcnt(0)" ::: "memory");
        }
    }
    __syncthreads();
}

typedef float f32x2v __attribute__((ext_vector_type(2)));
typedef unsigned u32x2v __attribute__((ext_vector_type(2)));
typedef int i32x4v __attribute__((ext_vector_type(4)));
typedef int i32x2v __attribute__((ext_vector_type(2)));
__device__ __forceinline__ float wave_sum(float v) {
#pragma unroll
    for (int o = 1; o < 64; o <<= 1) v += __shfl_xor(v, o);
    return v;
}
__device__ __forceinline__ float bf2f(unsigned short h) { return __builtin_bit_cast(float, (unsigned)h << 16); }
__device__ __forceinline__ float bflo(unsigned w) { return __builtin_bit_cast(float, w << 16); }
__device__ __forceinline__ float bfhi(unsigned w) { return __builtin_bit_cast(float, w & 0xffff0000u); }
__device__ __forceinline__ float sigmoid_f(float v) { return 1.0f / (1.0f + __expf(-v)); }
__device__ __forceinline__ float silu_ff(float v) { return v / (1.0f + __expf(-v)); }
__device__ __forceinline__ float gelu_tanh_f(float v) { const float y = 1.5957691216057308f * (v + 0.044715f * v * v * v); return v / (1.0f + __expf(-y)); }

__device__ __forceinline__ void p0_transpose_item(const float* W, int K, int N, bf16* WT, int row_off, int rmul, LAS float* scr, int item, int lane) {
    const int nblk = N / 64, kb = item / nblk, nb = item % nblk, k0 = 64 * kb, n0 = 64 * nb;
    const int r4 = lane >> 4, q = lane & 15;
    f32x4 v[16];
#pragma unroll
    for (int i = 0; i < 16; ++i) v[i] = *(const f32x4*)(W + (size_t)(k0 + 4 * i + r4) * N + n0 + 4 * q);
#pragma unroll
    for (int i = 0; i < 16; ++i) { LAS float* d = scr + (4 * i + r4) * 65 + 4 * q; d[0] = v[i].x; d[1] = v[i].y; d[2] = v[i].z; d[3] = v[i].w; }
    LDS_WAIT(); asm volatile("" ::: "memory");
    const int c = lane & 7;
#pragma unroll
    for (int j = 0; j < 8; ++j) { const int n = (lane >> 3) + 8 * j; const LAS float* s = scr + (8 * c) * 65 + n;
        v4u o; o.x = pk2(s[0 * 65], s[1 * 65]); o.y = pk2(s[2 * 65], s[3 * 65]); o.z = pk2(s[4 * 65], s[5 * 65]); o.w = pk2(s[6 * 65], s[7 * 65]);
        *(v4u*)(WT + (size_t)(row_off + rmul * (n0 + n)) * K + k0 + 8 * c) = o; }
    LDS_WAIT(); asm volatile("" ::: "memory");
}

struct Ptrs {
    const float* in[29]; float* out; unsigned char* ws;
};

__device__ __forceinline__ void phase_p0a(const Ptrs& P, LAS unsigned char* lds, int tid, int lane, int wave, int vcu, int G) {
    {
        const float* c = P.in[1]; const float* c_ctx = P.in[3]; const float* w_ada = P.in[4]; const float* b_ada = P.in[5];
        float* MOD = (float*)(P.ws + WS_MOD);
        LAS float* red = (LAS float*)lds;
        const int r4 = lane >> 4, q = lane & 15;
        for (int cb = vcu; cb < 96; cb += G) {
            f32x4 acc[5];
#pragma unroll
            for (int r = 0; r < 5; ++r) acc[r] = (f32x4){0.f, 0.f, 0.f, 0.f};
#pragma unroll 8
            for (int i = 0; i < 32; ++i) {
                const int k = wave * 128 + 4 * i + r4;
                const f32x4 w = *(const f32x4*)(w_ada + (size_t)k * 6144 + 64 * cb + 4 * q);
#pragma unroll
                for (int r = 0; r < 5; ++r) { const float sv = silu_ff(r < 4 ? c[r * 1024 + k] : c_ctx[k]); acc[r] += w * sv; }
            }
#pragma unroll
            for (int r = 0; r < 5; ++r) {
#pragma unroll
                for (int e = 0; e < 4; ++e) { float t = acc[r][e]; t += __shfl_xor(t, 16); t += __shfl_xor(t, 32); acc[r][e] = t; }
                if (r4 == 0) *(LAS f32x4*)(red + (wave * 5 + r) * 64 + 4 * q) = acc[r];
            }
            __syncthreads();
            if (tid < 320) { const int r = tid >> 6, cc = tid & 63; float sm = 0.f;
#pragma unroll
                for (int w8 = 0; w8 < 8; ++w8) sm += red[(w8 * 5 + r) * 64 + cc];
                MOD[r * 6144 + 64 * cb + cc] = sm + b_ada[64 * cb + cc]; }
            __syncthreads();
        }
    }
    {
        bf16* RWH = (bf16*)(P.ws + WS_RWH); bf16* RWL = (bf16*)(P.ws + WS_RWL); float* RB = (float*)(P.ws + WS_RB);
        const float* wg = P.in[21]; const float* bg = P.in[22]; const float* we = P.in[23]; const float* be = P.in[24];
        for (int i = vcu * 512 + tid; i < 48 * 1024; i += G * 512) { const int n = i >> 10, k = i & 1023;
            const float w = n < 4 ? wg[k * 4 + n] : (n < 36 ? we[k * 32 + n - 4] : 0.f);
            const unsigned hi = f2bf(w); const float lo = w - __builtin_bit_cast(float, hi << 16);
            RWH[i] = (bf16)hi; RWL[i] = (bf16)f2bf(lo); }
        if (vcu == 0 && tid < 48) RB[tid] = tid < 4 ? bg[tid] : (tid < 36 ? be[tid - 4] : 0.f);
    }
    {
        LAS float* scr = (LAS float*)(lds + wave * 16640);
        const int gw = vcu * NWAVES + wave, NGW = G * NWAVES;
        bf16* WIN = (bf16*)(P.ws + WS_WIN); bf16* WOUT = (bf16*)(P.ws + WS_WOUT); bf16* WG = (bf16*)(P.ws + WS_WG); bf16* W13 = (bf16*)(P.ws + WS_W13); bf16* W2 = (bf16*)(P.ws + WS_W2);
        constexpr int I_IN = 16 * 32, I_OUT = 16 * 16, I_G = 32, I_E = 32 * 256;
        constexpr int NITEMS = I_IN + I_OUT + I_G + 3 * I_E;
        for (int it = gw; it < NITEMS; it += NGW) {
            int r = it;
            if (r < I_E) { const int e = r >> 8; p0_transpose_item(P.in[25] + (size_t)e * 1048576, 1024, 1024, W13, e * 2048, 2, scr, r & 255, lane); continue; } r -= I_E;
            if (r < I_E) { const int e = r >> 8; p0_transpose_item(P.in[26] + (size_t)e * 1048576, 1024, 1024, W13, e * 2048 + 1, 2, scr, r & 255, lane); continue; } r -= I_E;
            if (r < I_E) { const int e = r >> 8; p0_transpose_item(P.in[27] + (size_t)e * 1048576, 1024, 1024, W2, e * 1024, 1, scr, r & 255, lane); continue; } r -= I_E;
            if (r < I_IN) { p0_transpose_item(P.in[8], 1024, 2048, WIN, 0, 1, scr, r, lane); continue; } r -= I_IN;
            if (r < I_OUT) { p0_transpose_item(P.in[20], 1024, 1024, WOUT, 0, 1, scr, r, lane); continue; } r -= I_OUT;
            { const int which = r >> 4, mtx = r & 15;
                p0_transpose_item((which ? P.in[17] : P.in[15]) + mtx * 4096, 64, 64, WG, mtx * 128 + which * 64, 1, scr, 0, lane); }
        }
    }
}

__device__ __forceinline__ void phase_p0b(const Ptrs& P, int lane, int wave, int vcu, int G) {
    const float* MOD = (const float*)(P.ws + WS_MOD); const float* g1n = P.in[6];
    bf16* XN = (bf16*)(P.ws + WS_RA);
    const int gw = vcu * NWAVES + wave, NGW = G * NWAVES;
    for (int m = gw; m < TA; m += NGW) {
        const float* src; int mr;
        if (m < T) { src = P.in[0] + (size_t)m * D; mr = m >> 12; } else { src = P.in[2] + (size_t)(m - T) * D; mr = 4; }
        const f32x4* xr = (const f32x4*)src + lane;
        f32x4 v[4]; float s = 0.f;
#pragma unroll
        for (int j = 0; j < 4; ++j) { v[j] = xr[64 * j]; s += (v[j].x * v[j].x + v[j].y * v[j].y) + (v[j].z * v[j].z + v[j].w * v[j].w); }
        const float rstd = 1.0f / sqrtf(wave_sum(s) * (1.f / D) + EPS);
        const f32x4* gp = (const f32x4*)g1n + lane; const f32x4* shp = (const f32x4*)(MOD + mr * 6144) + lane; const f32x4* scp = (const f32x4*)(MOD + mr * 6144 + 1024) + lane;
        unsigned long long* o8 = (unsigned long long*)(XN + (size_t)m * D) + lane;
#pragma unroll
        for (int j = 0; j < 4; ++j) { const f32x4 g = gp[64 * j], sh = shp[64 * j], sc = scp[64 * j];
            const f32x4 y = v[j] * rstd * g * (sc + 1.0f) + sh;
            o8[64 * j] = (unsigned long long)pk2(y.x, y.y) | ((unsigned long long)pk2(y.z, y.w) << 32); }
    }
}

constexpr int WL_UB = 0;
constexpr int WL_UF = 2304;
constexpr int WL_AB = 6400;
constexpr int WL_BYTES = 14592;
template <bool FINAL>
__device__ __forceinline__ void lru_wave_items(const Ptrs& P, LAS unsigned char* wl, int gw, int NGW, int lane) {
    const bf16* ZL = (const bf16*)(P.ws + WS_RBB);
    const bf16* WG = (const bf16*)(P.ws + WS_WG);
    LAS bf16* ub = (LAS bf16*)(wl + WL_UB); LAS float* uf = (LAS float*)(wl + WL_UF); LAS float* ab = (LAS float*)(wl + WL_AB);
    const int h = gw & 7, l15 = lane & 15, q = lane >> 4;
    float cba[2][4], cbx[2][4], csp[2][4];
#pragma unroll
    for (int d = 0; d < 2; ++d)
#pragma unroll
        for (int nt = 0; nt < 4; ++nt) { const int ch = d * 512 + 64 * h + 16 * nt + l15; cba[d][nt] = P.in[16][ch]; cbx[d][nt] = P.in[18][ch]; csp[d][nt] = -8.0f * log1pf(expf(-P.in[19][ch])); }
    const int chl = 64 * h + lane;
    const float w0 = P.in[13][chl], w1 = P.in[13][512 + chl], w2 = P.in[13][1024 + chl], w3 = P.in[13][1536 + chl], cb = P.in[14][chl];
    const int nitems = FINAL ? NB * 256 * 8 : NB * NCH * 8;
    for (int it = gw; it < nitems; it += NGW) {
        const int bc = it >> 3;
        int b, chunk;
        if (FINAL) { b = bc >> 8; chunk = 16 + (bc & 255); } else { b = bc / NCH; chunk = bc % NCH; }
        const bool isctx = chunk < 16;
        const int seq_row0 = isctx ? (T + b * CTXL) : (b * SEQ), seq_len = isctx ? CTXL : SEQ, t0 = (isctx ? chunk : chunk - 16) * 16;
        float x[19];
#pragma unroll
        for (int r = 0; r < 19; ++r) { const int tt = t0 + r - 2; x[r] = (tt >= 0 && tt < seq_len) ? bf2f(ZL[(size_t)(seq_row0 + tt) * INC + 1024 + chl]) : 0.f; }
        unsigned short zg[16]; float hs[16]; float cin[2];
        if (FINAL) {
#pragma unroll
            for (int t = 0; t < 16; ++t) zg[t] = ZL[(size_t)(seq_row0 + t0 + t) * INC + 1536 + chl];
            const float* CARRY = (const float*)(P.ws + WS_CARRY);
            cin[0] = CARRY[(size_t)((b * 256 + (chunk - 16)) * 2 + 0) * 512 + chl]; cin[1] = CARRY[(size_t)((b * 256 + (chunk - 16)) * 2 + 1) * 512 + chl];
        }
#pragma unroll
        for (int t = 0; t < 16; ++t) { const float u = cb + w0 * x[t] + w1 * x[t + 1] + w2 * x[t + 2] + w3 * x[t + 3]; ub[t * 72 + lane] = (bf16)f2bf(u); uf[t * 64 + lane] = u; }
        asm volatile("" ::: "memory");
        bf16x8 af[2];
#pragma unroll
        for (int ks = 0; ks < 2; ++ks) af[ks] = *(const LAS bf16x8*)(ub + l15 * 72 + 32 * ks + 8 * q);
#pragma unroll
        for (int d = 0; d < 2; ++d) {
            f32x4 ar[4], ai[4];
#pragma unroll
            for (int nt = 0; nt < 4; ++nt) {
                const bf16* wr = WG + (size_t)(((d * 8 + h) * 128 + 16 * nt + l15) * 64 + 8 * q);
                const bf16x8 br0 = *(const bf16x8*)(wr), br1 = *(const bf16x8*)(wr + 32), bi0 = *(const bf16x8*)(wr + 64 * 64), bi1 = *(const bf16x8*)(wr + 64 * 64 + 32);
                f32x4 z = {0.f, 0.f, 0.f, 0.f};
                ar[nt] = __builtin_amdgcn_mfma_f32_16x16x32_bf16(af[0], br0, z, 0, 0, 0); ar[nt] = __builtin_amdgcn_mfma_f32_16x16x32_bf16(af[1], br1, ar[nt], 0, 0, 0);
                ai[nt] = __builtin_amdgcn_mfma_f32_16x16x32_bf16(af[0], bi0, z, 0, 0, 0); ai[nt] = __builtin_amdgcn_mfma_f32_16x16x32_bf16(af[1], bi1, ai[nt], 0, 0, 0);
            }
#pragma unroll
            for (int nt = 0; nt < 4; ++nt)
#pragma unroll
                for (int rg = 0; rg < 4; ++rg) {
                    const int t = 4 * q + rg, cl = 16 * nt + l15;
                    const float r = sigmoid_f(ar[nt][rg] + cba[d][nt]), ig = sigmoid_f(ai[nt][rg] + cbx[d][nt]);
                    const float la = csp[d][nt] * r;
                    const float a = __expf(la);
                    const float x2 = 2.0f * la;
                    const float em = x2 * (1.0f + x2 * (0.5f + x2 * (0.16666667f + x2 * (0.041666668f + x2 * (0.0083333338f + x2 * (0.0013888889f + x2 * 0.0001984127f))))));
                    const float mult = sqrtf(fmaxf(-em, 1e-12f));
                    ab[t * 64 + cl] = a; ab[(16 + t) * 64 + cl] = mult * ig * uf[t * 64 + cl];
                }
            asm volatile("" ::: "memory");
            if (!FINAL) {
                float Pp = 1.f, Hh = 0.f;
#pragma unroll
                for (int i = 0; i < 16; ++i) { const int t = d ? 15 - i : i; const float a = ab[t * 64 + lane], bq = ab[(16 + t) * 64 + lane]; Hh = a * Hh + bq; Pp *= a; }
                float* AGG = (float*)(P.ws + WS_AGG);
                *(f32x2v*)(AGG + ((size_t)((b * NCH + chunk) * 2 + d) * 512 + chl) * 2) = (f32x2v){Pp, Hh};
            } else {
                float hh = cin[d];
#pragma unroll
                for (int i = 0; i < 16; ++i) { const int t = d ? 15 - i : i; const float a = ab[t * 64 + lane], bq = ab[(16 + t) * 64 + lane]; hh = a * hh + bq; if (d == 0) hs[t] = hh; else hs[t] += hh; }
            }
            asm volatile("" ::: "memory");
        }
        if (FINAL) {
            bf16* MIX = (bf16*)(P.ws + WS_RC);
#pragma unroll
            for (int t = 0; t < 16; ++t) MIX[(size_t)(b * SEQ + t0 + t) * D + 512 + chl] = (bf16)f2bf(hs[t] * gelu_tanh_f(bf2f(zg[t])));
        }
    }
}

template <int T0> __device__ __forceinline__ void conv_rows8(const float (&uu)[64], const float (&w)[31], float cb, float* dst) {
#pragma unroll
    for (int tt = 0; tt < 8; ++tt) {
        float acc = cb;
#pragma unroll
        for (int j = 0; j < 31; ++j) { const int s = T0 + tt + j - 15; if (s >= 0 && s < 64) acc += w[j] * uu[s]; }
        dst[(size_t)(T0 + tt) * 512] = acc;
    }
}
__device__ __forceinline__ void conv_wave_items(const Ptrs& P, int gw, int NGW, int lane) {
    const bf16* ZL = (const bf16*)(P.ws + WS_RBB); float* CV = (float*)(P.ws + WS_RA);
    for (int it = gw; it < NB * 64 * 8; it += NGW) {
        const int s = it >> 3, c = 64 * (it & 7) + lane;
        const bf16* base = ZL + (size_t)(s * 64) * INC + c;
        float uu[64];
#pragma unroll
        for (int t = 0; t < 64; ++t) { const float val = bf2f(base[(size_t)t * INC]), gt = bf2f(base[(size_t)t * INC + 512]); uu[t] = val * sigmoid_f(gt); }
        float w[31];
#pragma unroll
        for (int j = 0; j < 31; ++j) w[j] = P.in[9][j * 512 + c];
        const float cb = P.in[10][c];
        float* dst = CV + (size_t)(s * 64) * 512 + c;
        conv_rows8<0>(uu, w, cb, dst); conv_rows8<8>(uu, w, cb, dst); conv_rows8<16>(uu, w, cb, dst); conv_rows8<24>(uu, w, cb, dst);
        conv_rows8<32>(uu, w, cb, dst); conv_rows8<40>(uu, w, cb, dst); conv_rows8<48>(uu, w, cb, dst); conv_rows8<56>(uu, w, cb, dst);
    }
}
__device__ __forceinline__ void convln_wave_items(const Ptrs& P, int gw, int NGW, int lane) {
    const float* CV = (const float*)(P.ws + WS_RA); bf16* MIX = (bf16*)(P.ws + WS_RC);
    const f32x4 g0 = *(const f32x4*)(P.in[11] + 8 * lane), g1 = *(const f32x4*)(P.in[11] + 8 * lane + 4);
    const f32x4 b0 = *(const f32x4*)(P.in[12] + 8 * lane), b1 = *(const f32x4*)(P.in[12] + 8 * lane + 4);
    for (int tok = gw; tok < T; tok += NGW) {
        f32x4 v0 = *(const f32x4*)(CV + (size_t)tok * 512 + 8 * lane), v1 = *(const f32x4*)(CV + (size_t)tok * 512 + 8 * lane + 4);
        const float mu = wave_sum((v0.x + v0.y) + (v0.z + v0.w) + (v1.x + v1.y) + (v1.z + v1.w)) * (1.f / 512.f);
        v0 = v0 - mu; v1 = v1 - mu;
        const float var = wave_sum((v0.x * v0.x + v0.y * v0.y) + (v0.z * v0.z + v0.w * v0.w) + (v1.x * v1.x + v1.y * v1.y) + (v1.z * v1.z + v1.w * v1.w)) * (1.f / 512.f);
        const float rstd = 1.0f / sqrtf(var + EPS);
        const f32x4 y0 = v0 * rstd * g0 + b0, y1 = v1 * rstd * g1 + b1;
        v4u o; o.x = pk2(silu_ff(y0.x), silu_ff(y0.y)); o.y = pk2(silu_ff(y0.z), silu_ff(y0.w)); o.z = pk2(silu_ff(y1.x), silu_ff(y1.y)); o.w = pk2(silu_ff(y1.z), silu_ff(y1.w));
        *(v4u*)(MIX + (size_t)tok * D + 8 * lane) = o;
    }
}

__device__ __forceinline__ void phase_p2a(const Ptrs& P, LAS unsigned char* lds, int tid, int lane, int wave, int vcu, int G) {
    const int gw = vcu * NWAVES + wave, NGW = G * NWAVES;
    lru_wave_items<false>(P, lds + wave * WL_BYTES, gw, NGW, lane);
    conv_wave_items(P, gw, NGW, lane);
}
__device__ __forceinline__ void phase_p2b(const Ptrs& P, LAS unsigned char* lds, int tid, int vcu, int G) {
    const float* AGG = (const float*)(P.ws + WS_AGG); float* CARRY = (float*)(P.ws + WS_CARRY);
    LAS float* SEGP = (LAS float*)lds;
    for (int item = vcu; item < NB * 2 * 16; item += G) {
        const int b = item >> 5, d = (item >> 4) & 1, cl = tid & 31, ch = 32 * (item & 15) + cl, seg = tid >> 5;
        float A[17], Bv[17];
#pragma unroll
        for (int i = 0; i < 17; ++i) { const int j = 17 * seg + i; const int chunk = d ? (j < 16 ? 15 - j : 287 - j) : j;
            const f32x2v abv = *(const f32x2v*)(AGG + ((size_t)((b * NCH + chunk) * 2 + d) * 512 + ch) * 2); A[i] = abv.x; Bv[i] = abv.y; }
        float Pp = 1.f, Hh = 0.f;
#pragma unroll
        for (int i = 0; i < 17; ++i) { Hh = A[i] * Hh + Bv[i]; Pp *= A[i]; }
        SEGP[(seg * 32 + cl) * 2] = Pp; SEGP[(seg * 32 + cl) * 2 + 1] = Hh;
        __syncthreads();
        float hh = 0.f;
        for (int sg = 0; sg < seg; ++sg) hh = SEGP[(sg * 32 + cl) * 2] * hh + SEGP[(sg * 32 + cl) * 2 + 1];
#pragma unroll
        for (int i = 0; i < 17; ++i) { const int j = 17 * seg + i; const int chunk = d ? (j < 16 ? 15 - j : 287 - j) : j;
            if (chunk >= 16) CARRY[(size_t)((b * 256 + chunk - 16) * 2 + d) * 512 + ch] = hh;
            hh = A[i] * hh + Bv[i]; }
        __syncthreads();
    }
}
__device__ __forceinline__ void phase_p2c(const Ptrs& P, LAS unsigned char* lds, int tid, int lane, int wave, int vcu, int G) {
    const int gw = vcu * NWAVES + wave, NGW = G * NWAVES;
    lru_wave_items<true>(P, lds + wave * WL_BYTES, gw, NGW, lane);
    convln_wave_items(P, gw, NGW, lane);
}

constexpr int L_AH = 0, L_AL = 66048, HL_PITCH = 2064;
constexpr int L_PART = 0;
constexpr int L_LG = 132096;
constexpr int L_LCNT = 138240;
constexpr int L_LBASE = 138368;
__device__ __forceinline__ void phase_p4a(const Ptrs& P, LAS unsigned char* lds, int tid, int lane, int wave, int vcu, int G) {
    const float* MOD = (const float*)(P.ws + WS_MOD); const float* g2n = P.in[7];
    const bf16* RWH = (const bf16*)(P.ws + WS_RWH); const bf16* RWL = (const bf16*)(P.ws + WS_RWL); const float* RB = (const float*)(P.ws + WS_RB);
    bf16* H2 = (bf16*)(P.ws + WS_RC + 32 * MiB);
    unsigned* gcnt = (unsigned*)(P.ws + WS_CTL) + CW_CNT;
    LAS float* lg = (LAS float*)(lds + L_LG); LAS int* lcnt = (LAS int*)(lds + L_LCNT); LAS int* lbase = (LAS int*)(lds + L_LBASE); LAS float* part = (LAS float*)(lds + L_PART);
    const int l15 = lane & 15, l4 = lane >> 4;
    for (int it = vcu; it < T / 32; it += G) {
        if (tid < 32) lcnt[tid] = 0;
        for (int i = 0; i < 4; ++i) {
            const int tl = wave * 4 + i, tok = it * 32 + tl, mr = tok >> 12;
            const f32x4* xr = (const f32x4*)(P.out + (size_t)tok * D) + lane;
            f32x4 v[4]; float s = 0.f;
#pragma unroll
            for (int j = 0; j < 4; ++j) { v[j] = xr[64 * j]; s += (v[j].x * v[j].x + v[j].y * v[j].y) + (v[j].z * v[j].z + v[j].w * v[j].w); }
            const float rstd = 1.0f / sqrtf(wave_sum(s) * (1.f / D) + EPS);
            const f32x4* gp = (const f32x4*)g2n + lane; const f32x4* shp = (const f32x4*)(MOD + mr * 6144 + 3072) + lane; const f32x4* scp = (const f32x4*)(MOD + mr * 6144 + 4096) + lane;
            unsigned long long* o8 = (unsigned long long*)(H2 + (size_t)tok * D) + lane;
#pragma unroll
            for (int j = 0; j < 4; ++j) { const f32x4 g = gp[64 * j], sh = shp[64 * j], sc = scp[64 * j];
                const f32x4 y = v[j] * rstd * g * (sc + 1.0f) + sh;
                const unsigned h0 = f2bf(y.x), h1 = f2bf(y.y), h2_ = f2bf(y.z), h3 = f2bf(y.w);
                const unsigned long long pk = (unsigned long long)(h0 | (h1 << 16)) | ((unsigned long long)(h2_ | (h3 << 16)) << 32);
                const unsigned long long pl = (unsigned long long)pk2(y.x - __builtin_bit_cast(float, h0 << 16), y.y - __builtin_bit_cast(float, h1 << 16)) |
                                              ((unsigned long long)pk2(y.z - __builtin_bit_cast(float, h2_ << 16), y.w - __builtin_bit_cast(float, h3 << 16)) << 32);
                o8[64 * j] = pk;
                *(LAS unsigned long long*)(lds + L_AH + tl * HL_PITCH + (lane + 64 * j) * 8) = pk;
                *(LAS unsigned long long*)(lds + L_AL + tl * HL_PITCH + (lane + 64 * j) * 8) = pl; }
        }
        __syncthreads();
        {
            f32x4 acc[2][3];
#pragma unroll
            for (int mt = 0; mt < 2; ++mt)
#pragma unroll
                for (int nt = 0; nt < 3; ++nt) acc[mt][nt] = (f32x4){0.f, 0.f, 0.f, 0.f};
#pragma unroll
            for (int kq = 0; kq < 4; ++kq) {
                const int kof = 32 * (4 * wave + kq) + 8 * l4;
                bf16x8 ah[2], al[2], bh[3], bl[3];
#pragma unroll
                for (int nt = 0; nt < 3; ++nt) { bh[nt] = *(const bf16x8*)(RWH + (size_t)(16 * nt + l15) * 1024 + kof); bl[nt] = *(const bf16x8*)(RWL + (size_t)(16 * nt + l15) * 1024 + kof); }
#pragma unroll
                for (int mt = 0; mt < 2; ++mt) { ah[mt] = *(const LAS bf16x8*)(lds + L_AH + (16 * mt + l15) * HL_PITCH + kof * 2); al[mt] = *(const LAS bf16x8*)(lds + L_AL + (16 * mt + l15) * HL_PITCH + kof * 2); }
#pragma unroll
                for (int mt = 0; mt < 2; ++mt)
#pragma unroll
                    for (int nt = 0; nt < 3; ++nt) {
                        acc[mt][nt] = __builtin_amdgcn_mfma_f32_16x16x32_bf16(al[mt], bh[nt], acc[mt][nt], 0, 0, 0);
                        acc[mt][nt] = __builtin_amdgcn_mfma_f32_16x16x32_bf16(ah[mt], bl[nt], acc[mt][nt], 0, 0, 0);
                        acc[mt][nt] = __builtin_amdgcn_mfma_f32_16x16x32_bf16(ah[mt], bh[nt], acc[mt][nt], 0, 0, 0); }
            }
            __syncthreads();
#pragma unroll
            for (int mt = 0; mt < 2; ++mt)
#pragma unroll
                for (int nt = 0; nt < 3; ++nt)
#pragma unroll
                    for (int rg = 0; rg < 4; ++rg) part[(wave * 32 + 16 * mt + 4 * l4 + rg) * 48 + 16 * nt + l15] = acc[mt][nt][rg];
        }
        __syncthreads();
        for (int o = tid; o < 32 * 48; o += 512) { float sm = 0.f;
#pragma unroll
            for (int w8 = 0; w8 < 8; ++w8) sm += part[w8 * 1536 + o];
            lg[o] = sm + RB[o % 48]; }
        __syncthreads();
        int e0 = 0, e1 = 0, rk0 = 0, rk1 = 0; float gt0 = 0.f, gt1 = 0.f;
        if (tid < 32) {
            const LAS float* l = lg + tid * 48;
            int grp = 0; float lm = l[0];
#pragma unroll
            for (int q = 1; q < 4; ++q) if (l[q] > lm) { lm = l[q]; grp = q; }
            float den = 0.f;
#pragma unroll
            for (int q = 0; q < 4; ++q) den += __expf(l[q] - lm);
            const float pgrp = 1.0f / den;
            const LAS float* le = l + 4 + grp * 8;
            int i1 = 0; float m1 = le[0];
#pragma unroll
            for (int q = 1; q < 8; ++q) if (le[q] > m1) { m1 = le[q]; i1 = q; }
            int i2 = -1; float m2 = -3.0e38f;
#pragma unroll
            for (int q = 0; q < 8; ++q) if (q != i1 && le[q] > m2) { m2 = le[q]; i2 = q; }
            const float ex = __expf(m2 - m1), inv = 1.0f / (1.0f + ex);
            gt0 = pgrp * inv; gt1 = pgrp * ex * inv;
            e0 = grp * 8 + i1; e1 = grp * 8 + i2;
            rk0 = atomicAdd((int*)(lcnt + e0), 1); rk1 = atomicAdd((int*)(lcnt + e1), 1);
        }
        __syncthreads();
        if (tid < 32) lbase[tid] = (int)__hip_atomic_fetch_add(gcnt + tid, (unsigned)lcnt[tid], __ATOMIC_RELAXED, __HIP_MEMORY_SCOPE_AGENT);
        __syncthreads();
        if (tid < 32) {
            const int tok = it * 32 + tid;
            *(i32x4v*)(P.ws + WS_ROUTE + (size_t)tok * 16) = (i32x4v){e0, lbase[e0] + rk0, e1, lbase[e1] + rk1};
            *(f32x2v*)(P.ws + WS_RG + (size_t)tok * 8) = (f32x2v){gt0, gt1};
        }
        __syncthreads();
    }
}
__device__ __forceinline__ void build_tiles(const Ptrs& P, volatile LAS unsigned* MISC, int tid) {
    if (tid == 0) {
        unsigned* gcnt = (unsigned*)(P.ws + WS_CTL) + CW_CNT;
        int run = 0;
        for (int e = 0; e < NE; ++e) {
            const int cnt = (int)__hip_atomic_load(gcnt + e, __ATOMIC_RELAXED, __HIP_MEMORY_SCOPE_AGENT);
            const int nt = (cnt + 255) >> 8;
            MISC[16 + e] = (unsigned)(run * 256);
            for (int q = 0; q < nt && run + q < 192; ++q) MISC[64 + run + q] = (unsigned)e;
            run += nt;
        }
        MISC[8] = (unsigned)(run < 192 ? run : 192);
    }
    __syncthreads();
}
__device__ __forceinline__ void phase_p4b(const Ptrs& P, volatile LAS unsigned* MISC, int lane, int wave, int vcu, int G) {
    const bf16* H2 = (const bf16*)(P.ws + WS_RC + 32 * MiB); bf16* XS = (bf16*)(P.ws + WS_RA);
    float* GATE = (float*)(P.ws + WS_GATE);
    const int gw = vcu * NWAVES + wave, NGW = G * NWAVES;
    for (int tok = gw; tok < T; tok += NGW) {
        const i32x4v r = *(const i32x4v*)(P.ws + WS_ROUTE + (size_t)tok * 16);
        const f32x2v g = *(const f32x2v*)(P.ws + WS_RG + (size_t)tok * 8);
        const int s0 = (int)MISC[16 + r.x] + r.y, s1 = (int)MISC[16 + r.z] + r.w;
        const v4u* src = (const v4u*)(H2 + (size_t)tok * D) + lane;
        const v4u a0 = src[0], a1 = src[64];
        v4u* d0 = (v4u*)(XS + (size_t)s0 * D) + lane; v4u* d1 = (v4u*)(XS + (size_t)s1 * D) + lane;
        d0[0] = a0; d0[64] = a1; d1[0] = a0; d1[64] = a1;
        if (lane == 0) { GATE[s0] = g.x; GATE[s1] = g.y; *(i32x2v*)(P.ws + WS_SLOT + (size_t)tok * 8) = (i32x2v){s0, s1}; }
    }
}
__device__ __forceinline__ void phase_p6(const Ptrs& P, int lane, int wave, int vcu, int G) {
    const float* MOD = (const float*)(P.ws + WS_MOD); const float* fg = P.in[28];
    const bf16* Y = (const bf16*)(P.ws + WS_RC);
    const int gw = vcu * NWAVES + wave, NGW = G * NWAVES;
    for (int tok = gw; tok < T; tok += NGW) {
        const i32x2v sl = *(const i32x2v*)(P.ws + WS_SLOT + (size_t)tok * 8);
        const int mr = tok >> 12;
        f32x4* xr = (f32x4*)(P.out + (size_t)tok * D) + lane;
        const u32x2v* y0 = (const u32x2v*)(Y + (size_t)sl.x * D) + lane; const u32x2v* y1 = (const u32x2v*)(Y + (size_t)sl.y * D) + lane;
        const f32x4* g2p = (const f32x4*)(MOD + mr * 6144 + 5120) + lane;
        f32x4 v[4]; float s = 0.f;
#pragma unroll
        for (int j = 0; j < 4; ++j) { const f32x4 xv = xr[64 * j], g2 = g2p[64 * j]; const u32x2v a = y0[64 * j], bq = y1[64 * j];
            f32x4 yy; yy.x = bflo(a.x) + bflo(bq.x); yy.y = bfhi(a.x) + bfhi(bq.x); yy.z = bflo(a.y) + bflo(bq.y); yy.w = bfhi(a.y) + bfhi(bq.y);
            v[j] = xv + g2 * yy; s += (v[j].x * v[j].x + v[j].y * v[j].y) + (v[j].z * v[j].z + v[j].w * v[j].w); }
        const float rstd = 1.0f / sqrtf(wave_sum(s) * (1.f / D) + EPS);
        const f32x4* fgp = (const f32x4*)fg + lane;
#pragma unroll
        for (int j = 0; j < 4; ++j) xr[64 * j] = v[j] * rstd * fgp[64 * j];
    }
}

struct Args { const float* in[29]; float* out; unsigned char* ws; int ph_lo, ph_hi, li, pad; };
__global__ void __launch_bounds__(NWAVES * 64, 2) fwd_kernel(Args args) {
    extern __shared__ __attribute__((aligned(16))) unsigned char lds_raw[];
    LAS unsigned char* lds = (LAS unsigned char*)lds_raw;
    volatile LAS unsigned* MISC = (volatile LAS unsigned*)(lds + MISC_OFF);
    const int tid = threadIdx.x, lane = tid & 63, wave = __builtin_amdgcn_readfirstlane(tid >> 6);
    const int G = gridDim.x; const int bx = blockIdx.x; const int vcu = (G % 8 == 0) ? (bx % 8) * (G / 8) + bx / 8 : bx;
    Ptrs P;
#pragma unroll
    for (int i = 0; i < 29; ++i) P.in[i] = args.in[i];
    P.out = args.out; P.ws = args.ws;
    for (int u = tid; u < (LDS_BYTES - MISC_OFF) / 4; u += NWAVES * 64) MISC[u] = 0u;
    __syncthreads();
    unsigned* ctl = (unsigned*)(P.ws + WS_CTL);
    XcdBarrier bar; bar.bar = ctl + CW_BAR; bar.x = 0; bar.st = nullptr;
    if (N_LAUNCHES == 1) bar = xcd_barrier_post(ctl + CW_BAR, MISC);
#define GRID_BAR() do { if (N_LAUNCHES == 1) xcd_barrier(bar); } while (0)
    const int lo = args.ph_lo, hi = args.ph_hi;
#define IN(k) (lo <= (k) && (k) < hi)
#ifdef PROBE_LO
#define STAMP(k) do { if (bx == 0 && tid == 0) MISC[256 + (k)] = (unsigned)__builtin_amdgcn_s_memrealtime(); } while (0)
#else
#define STAMP(k) do {} while (0)
#endif
    STAMP(0);
#define BOTH(k) (IN(k) && IN((k) + 1))

    if (IN(0)) { phase_p0a(P, lds, tid, lane, wave, vcu, G); if (BOTH(0)) GRID_BAR(); STAMP(1); }
    if (IN(1)) { phase_p0b(P, lane, wave, vcu, G); if (BOTH(1)) GRID_BAR(); STAMP(2); }
    if (IN(2)) {
        pg8::Gemm g{(const pg8::bf16_t*)(P.ws + WS_RA), (const pg8::bf16_t*)(P.ws + WS_WIN), TA, INC, D};
        pg8::OrderInProj S; S.so.init(T, INC, G, bx);
        pg8::EpiStoreBf16 E{(pg8::bf16_t*)(P.ws + WS_RBB), INC};
        pg8::gemm_phase<pg8::EpiStoreBf16, pg8::OrderInProj, true, true>(lds + RING_OFF, g, S, E);
        if (BOTH(2)) GRID_BAR(); STAMP(3);
    }
    if (IN(3)) { phase_p2a(P, lds, tid, lane, wave, vcu, G); if (BOTH(3)) GRID_BAR(); STAMP(4); }
    if (IN(4)) { phase_p2b(P, lds, tid, vcu, G); if (BOTH(4)) GRID_BAR(); STAMP(5); }
    if (IN(5)) { phase_p2c(P, lds, tid, lane, wave, vcu, G); if (BOTH(5)) GRID_BAR(); STAMP(6); }
    if (IN(6)) {
        pg8::Gemm g{(const pg8::bf16_t*)(P.ws + WS_RC), (const pg8::bf16_t*)(P.ws + WS_WOUT), T, D, D};
        pg8::StaticOrder S; S.init(T, D, G, bx);
        pg8::EpiResid E{P.in[0], (const float*)(P.ws + WS_MOD) + 2048, 6144, P.out};
        pg8::gemm_phase<pg8::EpiResid, pg8::StaticOrder, true, true>(lds + RING_OFF, g, S, E);
        if (BOTH(6)) GRID_BAR(); STAMP(7);
    }
    if (IN(7)) { phase_p4a(P, lds, tid, lane, wave, vcu, G); if (BOTH(7)) GRID_BAR(); STAMP(8); }
    if (IN(8)) { build_tiles(P, MISC, tid); phase_p4b(P, MISC, lane, wave, vcu, G); if (BOTH(8)) GRID_BAR(); STAMP(9); }
    if (IN(9)) {
        build_tiles(P, MISC, tid);
        pg8::Gemm g{(const pg8::bf16_t*)(P.ws + WS_RA), (const pg8::bf16_t*)(P.ws + WS_W13), NSLOT, 2048, D};
        pg8::OrderMoe S{G, bx, 8, (int)MISC[8] * 8, (const LAS int*)(lds + MISC_OFF + 256)};
        pg8::EpiSwiglu E{(pg8::bf16_t*)(P.ws + WS_RBB)};
        pg8::gemm_phase<pg8::EpiSwiglu, pg8::OrderMoe, true, true>(lds + RING_OFF, g, S, E);
        if (BOTH(9)) GRID_BAR(); STAMP(10);
    }
    if (IN(10)) {
        build_tiles(P, MISC, tid);
        pg8::Gemm g{(const pg8::bf16_t*)(P.ws + WS_RBB), (const pg8::bf16_t*)(P.ws + WS_W2), NSLOT, 1024, D};
        pg8::OrderMoe S{G, bx, 4, (int)MISC[8] * 4, (const LAS int*)(lds + MISC_OFF + 256)};
        pg8::EpiGateBf16 E{(pg8::bf16_t*)(P.ws + WS_RC), (const float*)(P.ws + WS_GATE)};
        pg8::gemm_phase<pg8::EpiGateBf16, pg8::OrderMoe, true, true>(lds + RING_OFF, g, S, E);
        if (BOTH(10)) GRID_BAR(); STAMP(11);
    }
    if (IN(11)) { phase_p6(P, lane, wave, vcu, G); }
#ifdef PROBE_LO
    if (bx == 0 && tid == 0) {
        const unsigned dt = (MISC[256 + PROBE_HI] - MISC[256 + PROBE_LO]) * PROBE_MULT;
        const unsigned t0 = (unsigned)__builtin_amdgcn_s_memrealtime();
        while ((unsigned)__builtin_amdgcn_s_memrealtime() - t0 < dt) __builtin_amdgcn_s_sleep(32);
    }
#endif
#undef IN
#undef BOTH
}

extern "C" void kernel_launch(void* const* d_in, const int* in_sizes, int n_in, void* d_out, int out_size, void* d_ws, size_t ws_size, hipStream_t stream) {
    static int grid = 0;
    if (grid == 0) {
        if (n_in != 29 || in_sizes[0] != T * D || out_size != T * D || ws_size < WS_END) { fprintf(stderr, "kernel_launch: built for 29 inputs, x and out of %d floats, >= %zu bytes of workspace; got n_in %d, in0 %d, out %d, ws %zu; nothing launched\n", T * D, (size_t)WS_END, n_in, n_in > 0 ? in_sizes[0] : -1, out_size, ws_size); grid = -1; return; }
        int dev = 0, cus = 0, per_cu = 0;
        if (hipGetDevice(&dev) != hipSuccess || hipDeviceGetAttribute(&cus, hipDeviceAttributeMultiprocessorCount, dev) != hipSuccess) { fprintf(stderr, "kernel_launch: hipGetDevice / hipDeviceGetAttribute failed\n"); grid = -1; return; }
        if (hipFuncSetAttribute((const void*)fwd_kernel, hipFuncAttributeMaxDynamicSharedMemorySize, LDS_BYTES) != hipSuccess) { fprintf(stderr, "kernel_launch: hipFuncSetAttribute failed (%d bytes of dynamic LDS)\n", LDS_BYTES); grid = -1; return; }
        if (hipOccupancyMaxActiveBlocksPerMultiprocessor(&per_cu, (const void*)fwd_kernel, NWAVES * 64, LDS_BYTES) != hipSuccess || per_cu < 1)
            fprintf(stderr, "kernel_launch: note: the occupancy query reports %d workgroups per CU\n", per_cu);
        (void)hipGetLastError();
        grid = cus;
    }
    if (grid < 0) return;
    if (hipMemsetAsync((char*)d_ws + WS_CTL, 0, CTL_ZERO_BYTES, stream) != hipSuccess) { fprintf(stderr, "kernel_launch: hipMemsetAsync failed\n"); return; }
    Args a{};
    for (int i = 0; i < 29; ++i) a.in[i] = (const float*)d_in[i];
    a.out = (float*)d_out; a.ws = (unsigned char*)d_ws;
    for (int li = 0; li < N_LAUNCHES; ++li) {
        a.ph_lo = (N_LAUNCHES == 1) ? 0 : li; a.ph_hi = (N_LAUNCHES == 1) ? NPH : li + 1; a.li = li;
        hipLaunchKernelGGL(fwd_kernel, dim3(grid), dim3(NWAVES * 64), LDS_BYTES, stream, a);
        const hipError_t le = hipPeekAtLastError();
        if (le != hipSuccess) { fprintf(stderr, "kernel_launch: launch %d failed: %s\n", li, hipGetErrorName(le)); break; }
    }
}
```

```cpp
#include <hip/hip_runtime.h>
#include <cstdio>
#include <cstdint>
namespace pg8 {
#define PG8_LAS __attribute__((address_space(3)))
typedef unsigned short bf16_t;
typedef short bf16x8 __attribute__((ext_vector_type(8)));
typedef float f32x4 __attribute__((ext_vector_type(4)));
typedef unsigned u32x4 __attribute__((ext_vector_type(4)));
constexpr int BM = 256, BK = 64, HALF = 128, HTB = HALF * BK * 2  , STAGE_BYTES = 8 * HTB, NXCD = 8, WGM = 8;

__host__ __device__ __forceinline__ int lds_byte(int r, int c) { const int st = (r >> 4) * 2 + (c >> 5), rr = r & 15, cc = c & 31, ob = rr * 64 + cc * 2; return st * 1024 + (ob ^ (((ob >> 9) & 1) << 5)); }
__host__ __device__ __forceinline__ void stage_rc(int b, int& R, int& C) { const int st = b / 1024, sb = b % 1024, swz = sb ^ (((sb >> 9) & 1) << 5); R = (st >> 1) * 16 + swz / 64; C = (st & 1) * 32 + (swz % 64) / 2; }
__host__ __device__ __forceinline__ int perm32(int rho) { const int n = rho >> 4, i = rho & 15; return 8 * (i >> 2) + 4 * n + (i & 3); }

struct Unit { int pm, pn; };
struct Gemm { const bf16_t* A; const bf16_t* Bt; int M, N, K; };

struct StaticOrder {
    int nM, nN, nwg, G, c;
    __host__ __device__ void init(int M, int N, int G_, int c_) { nM = M / BM; nN = N / BM; nwg = nM * nN; G = G_; c = c_; }
    __host__ __device__ bool next(int i, Unit& u) const {
        const long L = (long)i * G + c; if (L >= nwg) return false;
        int wgid = (int)L; { const int q = nwg / NXCD, r = nwg % NXCD, xcd = wgid % NXCD, off = wgid / NXCD; wgid = (xcd < r ? xcd * (q + 1) : r * (q + 1) + (xcd - r) * q) + off; }
        const int nig = WGM * nN, gid = wgid / nig, fm = gid * WGM, gsz = (nM - fm) < WGM ? (nM - fm) : WGM;
        u.pm = fm + ((wgid % nig) % gsz); u.pn = (wgid % nig) / gsz; return true;
    }
    __device__ __forceinline__ void a_ready(const Unit&) const {}
    __device__ __forceinline__ void done(const Unit&) const {}
};

__device__ __forceinline__ unsigned cvt_pk_bf16(float lo, float hi) { unsigned r; asm volatile("v_cvt_pk_bf16_f32 %0, %1, %2" : "=v"(r) : "v"(lo), "v"(hi)); return r; }
typedef unsigned u32x2 __attribute__((ext_vector_type(2)));
__device__ __forceinline__ float silu_f(float v) { return v * __builtin_amdgcn_rcpf(1.0f + __expf(-v)); }

struct EpiStoreBf16 {
    static constexpr bool PERM = true, AFTER_DRAIN = false;
    bf16_t* O; int ldc;
    __device__ __forceinline__ void operator()(const f32x4 (&acc)[2][2][4][2], const Unit& u, int wr, int wc, int fr, int fq) const {
        const int row0 = u.pm * BM + wr * 64 + fr, col0 = u.pn * BM + wc * 32 + 8 * fq;
#pragma unroll
        for (int ai = 0; ai < 2; ++ai)
#pragma unroll
            for (int m = 0; m < 4; ++m) { bf16_t* rowp = O + (size_t)(row0 + ai * HALF + m * 16) * ldc + col0;
#pragma unroll
                for (int bj = 0; bj < 2; ++bj) { const f32x4 v0 = acc[ai][bj][m][0], v1 = acc[ai][bj][m][1];
                    u32x4 w; w.x = cvt_pk_bf16(v0[0], v0[1]); w.y = cvt_pk_bf16(v0[2], v0[3]); w.z = cvt_pk_bf16(v1[0], v1[1]); w.w = cvt_pk_bf16(v1[2], v1[3]);
                    *(u32x4*)(rowp + bj * HALF) = w; } }
    }
};
struct EpiResid {
    static constexpr bool PERM = true, AFTER_DRAIN = false;
    const float* x; const float* g; int gp; float* out;
    __device__ __forceinline__ void operator()(const f32x4 (&acc)[2][2][4][2], const Unit& u, int wr, int wc, int fr, int fq) const {
        const int row0 = u.pm * BM + wr * 64 + fr, col0 = u.pn * BM + wc * 32 + 8 * fq;
        const float* gb = g + (size_t)((u.pm * BM) >> 12) * gp + col0;
        f32x4 gv[2][2];
#pragma unroll
        for (int bj = 0; bj < 2; ++bj) { gv[bj][0] = *(const f32x4*)(gb + bj * HALF); gv[bj][1] = *(const f32x4*)(gb + bj * HALF + 4); }
#pragma unroll
        for (int ai = 0; ai < 2; ++ai)
#pragma unroll
            for (int m = 0; m < 4; ++m) { const size_t off = (size_t)(row0 + ai * HALF + m * 16) * 1024 + col0;
#pragma unroll
                for (int bj = 0; bj < 2; ++bj) {
                    const f32x4 x0 = *(const f32x4*)(x + off + bj * HALF), x1 = *(const f32x4*)(x + off + bj * HALF + 4);
                    *(f32x4*)(out + off + bj * HALF) = x0 + gv[bj][0] * acc[ai][bj][m][0];
                    *(f32x4*)(out + off + bj * HALF + 4) = x1 + gv[bj][1] * acc[ai][bj][m][1]; } }
    }
};
struct EpiSwiglu {
    static constexpr bool PERM = true, AFTER_DRAIN = false;
    bf16_t* H;
    __device__ __forceinline__ void operator()(const f32x4 (&acc)[2][2][4][2], const Unit& u, int wr, int wc, int fr, int fq) const {
        const int row0 = u.pm * BM + wr * 64 + fr, col0 = (u.pn & 7) * 128 + wc * 16 + 4 * fq;
#pragma unroll
        for (int ai = 0; ai < 2; ++ai)
#pragma unroll
            for (int m = 0; m < 4; ++m) { bf16_t* rowp = H + (size_t)(row0 + ai * HALF + m * 16) * 1024 + col0;
#pragma unroll
                for (int bj = 0; bj < 2; ++bj) { const f32x4 v0 = acc[ai][bj][m][0], v1 = acc[ai][bj][m][1];
                    u32x2 w; w.x = cvt_pk_bf16(silu_f(v0[0]) * v0[1], silu_f(v0[2]) * v0[3]); w.y = cvt_pk_bf16(silu_f(v1[0]) * v1[1], silu_f(v1[2]) * v1[3]);
                    *(u32x2*)(rowp + bj * 64) = w; } }
    }
};
struct EpiGateBf16 {
    static constexpr bool PERM = true, AFTER_DRAIN = false;
    bf16_t* Y; const float* gate;
    __device__ __forceinline__ void operator()(const f32x4 (&acc)[2][2][4][2], const Unit& u, int wr, int wc, int fr, int fq) const {
        const int row0 = u.pm * BM + wr * 64 + fr, col0 = (u.pn & 3) * BM + wc * 32 + 8 * fq;
#pragma unroll
        for (int ai = 0; ai < 2; ++ai)
#pragma unroll
            for (int m = 0; m < 4; ++m) { const int row = row0 + ai * HALF + m * 16; const float gt = gate[row]; bf16_t* rowp = Y + (size_t)row * 1024 + col0;
#pragma unroll
                for (int bj = 0; bj < 2; ++bj) { const f32x4 v0 = acc[ai][bj][m][0] * gt, v1 = acc[ai][bj][m][1] * gt;
                    u32x4 w; w.x = cvt_pk_bf16(v0[0], v0[1]); w.y = cvt_pk_bf16(v0[2], v0[3]); w.z = cvt_pk_bf16(v1[0], v1[1]); w.w = cvt_pk_bf16(v1[2], v1[3]);
                    *(u32x4*)(rowp + bj * HALF) = w; } }
    }
};
struct OrderInProj {
    StaticOrder so;
    __device__ bool next(int i, Unit& u) const {
        const long L = (long)i * so.G + so.c;
        if (L < so.nwg) return so.next(i, u);
        const int j = (int)(L - so.nwg); if (j >= 8) return false;
        u.pm = 64 + (j >> 1); u.pn = 4 + (j & 1); return true;
    }
    __device__ __forceinline__ void a_ready(const Unit&) const {}
    __device__ __forceinline__ void done(const Unit&) const {}
};
struct OrderMoe {
    int G, c, ntn, nunits; const PG8_LAS int* tile_e;
    __device__ bool next(int i, Unit& u) const {
        const long L = (long)i * G + c; if (L >= nunits) return false;
        const int rt = (int)L / ntn, pn = (int)L % ntn;
        u.pm = rt; u.pn = tile_e[rt] * ntn + pn; return true;
    }
    __device__ __forceinline__ void a_ready(const Unit&) const {}
    __device__ __forceinline__ void done(const Unit&) const {}
};
template <class Epi, class Sched, bool ALIGN_EPI = false, bool SP2 = false>
__device__ __forceinline__ void gemm_phase(PG8_LAS unsigned char* lds, const Gemm g, const Sched& S, const Epi& E) {
    const int tid = threadIdx.x, wid = __builtin_amdgcn_readfirstlane(tid >> 6), lane = tid & 63, wr = wid >> 2, wc = wid & 3, fr = lane & 15, fq = lane >> 4;
    const int K = g.K, nt = K / BK;
    unsigned voffA[2], voffB[2];
#pragma unroll
    for (int i = 0; i < 2; ++i) { int R, C; stage_rc(tid * 16 + i * 8192, R, C); const int Rb = Epi::PERM ? ((R & ~31) + perm32(R & 31)) : R;
        voffA[i] = (unsigned)(R * K + C) * 2u; voffB[i] = (unsigned)(Rb * K + C) * 2u; }
    const size_t kstep = (size_t)(BK * 2);
    const size_t hstep = (size_t)HALF * K * 2;
    const size_t tstep = 2 * hstep;
    const unsigned ldsw = (unsigned)wid * 1024u;
    const int aoff = lds_byte(wr * 64 + fr, fq * 8), boff = lds_byte(wc * 32 + fr, fq * 8);
#define PG8_SA(b, h) (((b) * 2 + (h)) * HTB)
#define PG8_SB(b, h) ((4 + (b) * 2 + (h)) * HTB)
#define PG8_STAGE(bufoff, gbase, voff) do { _Pragma("unroll") for (int _i = 0; _i < 2; ++_i) \
        __builtin_amdgcn_global_load_lds((const unsigned*)((const char*)(gbase) + (voff)[_i]), (PG8_LAS unsigned*)(lds + (bufoff) + ldsw + _i * 8192), 16, 0, 0); } while (0)
#define PG8_LDA(dst, b, h) do { _Pragma("unroll") for (int m = 0; m < 4; ++m) _Pragma("unroll") for (int k = 0; k < 2; ++k) dst[m][k] = *(const PG8_LAS bf16x8*)(lds + PG8_SA(b, h) + aoff + m * 2048 + k * 1024); } while (0)
#define PG8_LDB(dst, b, h) do { _Pragma("unroll") for (int n = 0; n < 2; ++n) _Pragma("unroll") for (int k = 0; k < 2; ++k) dst[n][k] = *(const PG8_LAS bf16x8*)(lds + PG8_SB(b, h) + boff + n * 2048 + k * 1024); } while (0)
#define PG8_MMA(ai, bj, At, Bt) do { __builtin_amdgcn_s_setprio(1); _Pragma("unroll") for (int m = 0; m < 4; ++m) _Pragma("unroll") for (int n = 0; n < 2; ++n) _Pragma("unroll") for (int k = 0; k < 2; ++k) \
        acc[ai][bj][m][n] = __builtin_amdgcn_mfma_f32_16x16x32_bf16(Bt[n][k], At[m][k], acc[ai][bj][m][n], 0, 0, 0); __builtin_amdgcn_s_setprio(0); } while (0)
#define PG8_WAIT_V(n) asm volatile("s_waitcnt vmcnt(" #n ")" ::: "memory")
#define PG8_WAIT_L(n) asm volatile("s_waitcnt lgkmcnt(" #n ")" ::: "memory")
#define PG8_BAR __builtin_amdgcn_s_barrier()
#define PG8_SCHED __builtin_amdgcn_sched_barrier(0)
    Unit cur, nxt; int ui = 0;
    if (!S.next(0, cur)) return;
    f32x4 acc[2][2][4][2];
#pragma unroll
    for (int a = 0; a < 2; ++a)
#pragma unroll
        for (int b = 0; b < 2; ++b)
#pragma unroll
            for (int m = 0; m < 4; ++m)
#pragma unroll
                for (int n = 0; n < 2; ++n) acc[a][b][m][n] = (f32x4){0.f, 0.f, 0.f, 0.f};
    bf16x8 At[4][2], B0[2][2], B1[2][2];
    const char* cA = (const char*)g.A + (size_t)cur.pm * tstep; const char* cB = (const char*)g.Bt + (size_t)cur.pn * tstep;
    S.a_ready(cur);
    if constexpr (SP2) {
        PG8_STAGE(PG8_SB(0, 0), cB, voffB); PG8_STAGE(PG8_SB(0, 1), cB + hstep, voffB); PG8_STAGE(PG8_SA(0, 0), cA, voffA); PG8_STAGE(PG8_SA(0, 1), cA + hstep, voffA);
        if (wr == 1) PG8_BAR;
        PG8_WAIT_V(2); PG8_BAR;
        PG8_STAGE(PG8_SB(1, 0), cB + kstep, voffB); PG8_STAGE(PG8_SA(1, 0), cA + kstep, voffA); PG8_STAGE(PG8_SB(1, 1), cB + hstep + kstep, voffB);
        PG8_WAIT_V(6); PG8_BAR;
    } else {
        PG8_STAGE(PG8_SB(0, 0), cB, voffB); PG8_STAGE(PG8_SA(0, 0), cA, voffA); PG8_STAGE(PG8_SB(0, 1), cB + hstep, voffB); PG8_STAGE(PG8_SA(0, 1), cA + hstep, voffA);
        if (wr == 1) PG8_BAR;
        PG8_WAIT_V(4); PG8_BAR;
        PG8_STAGE(PG8_SB(1, 0), cB + kstep, voffB); PG8_STAGE(PG8_SA(1, 0), cA + kstep, voffA); PG8_STAGE(PG8_SB(1, 1), cB + hstep + kstep, voffB);
        PG8_WAIT_V(6); PG8_BAR;
    }
    for (;;) {
        const bool has_next = S.next(ui + 1, nxt);
        const char* nA = has_next ? (const char*)g.A + (size_t)nxt.pm * tstep : cA; const char* nB = has_next ? (const char*)g.Bt + (size_t)nxt.pn * tstep : cB;
        for (int t = 0; t < nt; t += 2) {
            const bool last = (t == nt - 2);
            const char* a1 = cA + (size_t)(t + 1) * kstep;
            const char* a2 = last ? nA : cA + (size_t)(t + 2) * kstep; const char* b2 = last ? nB : cB + (size_t)(t + 2) * kstep;
            const char* a3 = a2 + kstep; const char* b3 = b2 + kstep;
            if (last && has_next) S.a_ready(nxt);
            if constexpr (SP2) {
            PG8_LDB(B0, 0, 0); PG8_LDB(B1, 0, 1); PG8_SCHED; PG8_LDA(At, 0, 0); PG8_STAGE(PG8_SA(1, 1), a1 + hstep, voffA);
            PG8_WAIT_V(8); PG8_WAIT_L(0); PG8_BAR; PG8_MMA(0, 0, At, B0); PG8_MMA(0, 1, At, B1); PG8_BAR; PG8_SCHED;
            PG8_LDA(At, 0, 1); PG8_STAGE(PG8_SB(0, 0), b2, voffB); PG8_STAGE(PG8_SB(0, 1), b2 + hstep, voffB); PG8_STAGE(PG8_SA(0, 0), a2, voffA);
            PG8_WAIT_V(8); PG8_WAIT_L(0); PG8_BAR; PG8_MMA(1, 0, At, B0); PG8_MMA(1, 1, At, B1); PG8_BAR; PG8_SCHED;
            PG8_LDB(B0, 1, 0); PG8_LDB(B1, 1, 1); PG8_SCHED; PG8_LDA(At, 1, 0); PG8_STAGE(PG8_SA(0, 1), a2 + hstep, voffA);
            PG8_WAIT_V(8); PG8_WAIT_L(0); PG8_BAR; PG8_MMA(0, 0, At, B0); PG8_MMA(0, 1, At, B1); PG8_BAR; PG8_SCHED;
            PG8_LDA(At, 1, 1); PG8_STAGE(PG8_SB(1, 0), b3, voffB); PG8_STAGE(PG8_SB(1, 1), b3 + hstep, voffB); PG8_STAGE(PG8_SA(1, 0), a3, voffA);
            PG8_WAIT_V(8); PG8_WAIT_L(0); PG8_BAR; PG8_MMA(1, 0, At, B0); PG8_MMA(1, 1, At, B1); PG8_BAR; PG8_SCHED;
            } else {
            PG8_LDB(B0, 0, 0); PG8_SCHED; PG8_LDA(At, 0, 0); PG8_STAGE(PG8_SA(1, 1), a1 + hstep, voffA);
            PG8_WAIT_L(8); PG8_BAR; PG8_WAIT_L(0); PG8_MMA(0, 0, At, B0); PG8_BAR; PG8_SCHED;
            PG8_LDB(B1, 0, 1); PG8_STAGE(PG8_SB(0, 0), b2, voffB);
            PG8_BAR; PG8_WAIT_L(0); PG8_MMA(0, 1, At, B1); PG8_BAR;
            PG8_LDA(At, 0, 1); PG8_STAGE(PG8_SA(0, 0), a2, voffA);
            PG8_BAR; PG8_WAIT_L(0); PG8_MMA(1, 0, At, B0); PG8_BAR; PG8_SCHED;
            PG8_STAGE(PG8_SB(0, 1), b2 + hstep, voffB);
            PG8_WAIT_V(6); PG8_BAR; PG8_MMA(1, 1, At, B1); PG8_BAR;
            PG8_LDB(B0, 1, 0); PG8_SCHED; PG8_LDA(At, 1, 0); PG8_STAGE(PG8_SA(0, 1), a2 + hstep, voffA);
            PG8_WAIT_L(8); PG8_BAR; PG8_WAIT_L(0); PG8_MMA(0, 0, At, B0); PG8_BAR; PG8_SCHED;
            PG8_LDB(B1, 1, 1); PG8_STAGE(PG8_SB(1, 0), b3, voffB);
            PG8_BAR; PG8_WAIT_L(0); PG8_MMA(0, 1, At, B1); PG8_BAR;
            PG8_LDA(At, 1, 1); PG8_STAGE(PG8_SA(1, 0), a3, voffA);
            PG8_BAR; PG8_WAIT_L(0); PG8_MMA(1, 0, At, B0); PG8_BAR; PG8_SCHED;
            PG8_STAGE(PG8_SB(1, 1), b3 + hstep, voffB);
            PG8_WAIT_V(6); PG8_BAR; PG8_MMA(1, 1, At, B1); PG8_BAR;
            }
        }
        if constexpr (ALIGN_EPI) { if (wr == 0) PG8_BAR; }
        if constexpr (!Epi::AFTER_DRAIN) { E(acc, cur, wr, wc, fr, fq); S.done(cur); }
        if (!has_next) break;
#pragma unroll
        for (int a = 0; a < 2; ++a)
#pragma unroll
            for (int b = 0; b < 2; ++b)
#pragma unroll
                for (int m = 0; m < 4; ++m)
#pragma unroll
                    for (int n = 0; n < 2; ++n) acc[a][b][m][n] = (f32x4){0.f, 0.f, 0.f, 0.f};
        cur = nxt; cA = nA; cB = nB; ++ui;
        if constexpr (ALIGN_EPI) { if (wr == 1) PG8_BAR; }
    }
    PG8_WAIT_V(0);
    if constexpr (!ALIGN_EPI) { if (wr == 0) PG8_BAR; }
    PG8_BAR;
    if constexpr (Epi::AFTER_DRAIN) { E.fused(acc, cur, wr, wc, fr, fq, lds, wid, lane); S.done(cur); }
#undef PG8_SA
#undef PG8_SB
#undef PG8_STAGE
#undef PG8_LDA
#undef PG8_LDB
#undef PG8_MMA
#undef PG8_WAIT_V
#undef PG8_WAIT_L
#undef PG8_BAR
#undef PG8_SCHED
}
}

constexpr int NWAVES = 8;
#ifndef MK_N_LAUNCHES
#define MK_N_LAUNCHES 1
#endif
constexpr int NPH = 12;
constexpr int N_LAUNCHES = MK_N_LAUNCHES;

constexpr int NB = 4, SEQ = 4096, D = 1024, T = NB * SEQ, CTXL = 256, TC = NB * CTXL, TA = T + TC;
constexpr int CC = 512, LW = 512, INC = 2048, NE = 32, NSLOT = 2 * T + NE * 256;
constexpr int NCH = 272;
constexpr float EPS = 1e-6f;

constexpr size_t MiB = 1u << 20;
constexpr size_t WS_CTL = 0, CTL_ZERO_BYTES = 64 * 1024;
constexpr size_t WS_MOD = 1 * MiB;
constexpr size_t WS_RWH = WS_MOD + 128 * 1024;
constexpr size_t WS_RWL = WS_RWH + 96 * 1024;
constexpr size_t WS_RB = WS_RWL + 96 * 1024;
constexpr size_t WS_WG = 2 * MiB;
constexpr size_t WS_WIN = 3 * MiB;
constexpr size_t WS_WOUT = 7 * MiB;
constexpr size_t WS_AGG = 464 * MiB;
constexpr size_t WS_CARRY = 474 * MiB;
constexpr size_t WS_ROUTE = 13 * MiB;
constexpr size_t WS_RG = WS_ROUTE + 256 * 1024;
constexpr size_t WS_SLOT = WS_RG + 128 * 1024;
constexpr size_t WS_GATE = WS_SLOT + 128 * 1024;
constexpr size_t WS_W13 = 16 * MiB;
constexpr size_t WS_W2 = 144 * MiB;
constexpr size_t WS_RA = 208 * MiB;
constexpr size_t WS_RBB = 288 * MiB;
constexpr size_t WS_RC = 368 * MiB;
constexpr size_t WS_END = 480 * MiB;
static_assert((size_t)NSLOT * 1024 * 2 <= 80 * MiB && (size_t)TA * 2048 * 2 <= 80 * MiB && WS_GATE + (size_t)NSLOT * 4 <= WS_W13, "ws map");
constexpr int CW_CNT = 64;
constexpr int CW_BAR = 1024;

constexpr int RING_OFF = 0, RING_BYTES = 131072;
constexpr int SCR_BYTES = 147456;
constexpr int MISC_OFF = SCR_BYTES;
constexpr int LDS_BYTES = SCR_BYTES + 2048;
#define GAS __attribute__((address_space(1)))
#define LAS __attribute__((address_space(3)))
typedef unsigned short bf16;
typedef unsigned v4u __attribute__((ext_vector_type(4)));
typedef float f32x4 __attribute__((ext_vector_type(4)));
typedef short bf16x8 __attribute__((ext_vector_type(8)));
typedef GAS unsigned gu32;
typedef GAS unsigned long long gu64;
#define RLX_AGENT __ATOMIC_RELAXED, __HIP_MEMORY_SCOPE_AGENT
#define LDS_WAIT() asm volatile("s_waitcnt lgkmcnt(0)" ::: "memory")
#define VM_WAIT() asm volatile("s_waitcnt vmcnt(0)" ::: "memory")
__device__ __forceinline__ unsigned long long rt() { return __builtin_amdgcn_s_memrealtime(); }
__device__ __forceinline__ unsigned f2bf(float f) { unsigned u = __builtin_bit_cast(unsigned, f); return (u + 0x7fffu + ((u >> 16) & 1u)) >> 16; }
__device__ __forceinline__ unsigned pk2(float lo, float hi) { return f2bf(lo) | (f2bf(hi) << 16); }

#define XB_TMO      128
#define XB_XCNT(j)  (256  + 64 * (j))
#define XB_XSUB(j)  (1280 + 64 * (j))
#define XB_XGEN(j)  (2304 + 64 * (j))
#define XB_TOP      3328
#define XB_TOPGEN   3392
#define XCD_BAR_WORDS 3456
#define XB_SPIN_CAP (1u << 18)

__device__ __forceinline__ unsigned xb_ld(unsigned* p)              { return __hip_atomic_load(p, __ATOMIC_RELAXED, __HIP_MEMORY_SCOPE_AGENT); }
__device__ __forceinline__ unsigned xb_add(unsigned* p, unsigned v) { return __hip_atomic_fetch_add(p, v, __ATOMIC_RELAXED, __HIP_MEMORY_SCOPE_AGENT); }
__device__ __forceinline__ unsigned xb_xcc_id() { return (unsigned)__builtin_amdgcn_s_getreg((3 << 11) | 20) & 0xFu; }
#define XB_SPIN(cond, bar) do { unsigned _sp = 0; while (cond) { __builtin_amdgcn_s_sleep(1); \
    if ((++_sp & 255u) == 0u) { if (xb_ld(&(bar)[XB_TMO])) break; if (_sp > XB_SPIN_CAP) { atomicAdd(&(bar)[XB_TMO], 1u); break; } } } } while (0)

struct XcdBarrier {
    unsigned* bar; unsigned x;
    volatile LAS unsigned* st;
};

__device__ __forceinline__ XcdBarrier xcd_barrier_post(unsigned* bar, volatile LAS unsigned* st) {
    XcdBarrier b; b.bar = bar; b.x = xb_xcc_id(); b.st = st;
    if (threadIdx.x == 0) (void)xb_add(&bar[XB_XCNT(b.x)], 1u);
    return b;
}
__device__ __forceinline__ void xcd_barrier_complete(unsigned* bar, unsigned x, unsigned& nloc, unsigned& nx) {
    const unsigned G = gridDim.x * gridDim.y * gridDim.z;
    unsigned sum, cnt, mine, sp = 0u;
    for (;;) {
        sum = 0u; cnt = 0u; mine = 0u;
#pragma unroll
        for (unsigned j = 0; j < 16; ++j) { const unsigned c = xb_ld(&bar[XB_XCNT(j)]); sum += c; cnt += (c > 0u) ? 1u : 0u; mine = (j == x) ? c : mine; }
        if (sum == G) break;
        __builtin_amdgcn_s_sleep(1);
        if ((++sp & 255u) == 0u) { if (xb_ld(&bar[XB_TMO])) break; if (sp > XB_SPIN_CAP) { atomicAdd(&bar[XB_TMO], 1u); break; } }
    }
    nloc = mine > 0u ? mine : 1u; nx = cnt > 0u ? cnt : 1u;
}

__device__ __forceinline__ void xcd_barrier(const XcdBarrier& b) {
    asm volatile("s_waitcnt vmcnt(0)" ::: "memory");
    __syncthreads();
    if (threadIdx.x == 0) {
        unsigned* bar = b.bar;
        __builtin_amdgcn_s_waitcnt(0);
        unsigned nloc = b.st[0], nx = b.st[1];
        if (nloc == 0u) { xcd_barrier_complete(bar, b.x, nloc, nx); b.st[0] = nloc; b.st[1] = nx; }
        const unsigned old = xb_add(&bar[XB_XSUB(b.x)], 1u);
        const unsigned gen = old / nloc;
        if (old + 1u == (gen + 1u) * nloc) {
            __builtin_amdgcn_fence(__ATOMIC_RELEASE, "agent");
            asm volatile("s_waitcnt vmcnt(0)" ::: "memory");
            const unsigned og = xb_add(&bar[XB_TOP], 1u);
            const unsigned tg = og / nx;
            if (og + 1u == (tg + 1u) * nx) xb_add(&bar[XB_TOPGEN], 1u);
            else XB_SPIN(xb_ld(&bar[XB_TOPGEN]) == tg, bar);
            __builtin_amdgcn_fence(__ATOMIC_ACQUIRE, "agent");
            xb_add(&bar[XB_XGEN(b.x)], 1u);
            asm volatile("s_waitcnt vmcnt(0)" ::: "memory");
        } else {
            XB_SPIN(xb_ld(&bar[XB_XGEN(b.x)]) == gen, bar);
            __builtin_amdgcn_fence(__ATOMIC_ACQUIRE, "agent");
            asm volatile("s_waitcnt vmcnt(0)" ::: "memory");
        }
    }
    __syncthreads();
}

typedef float f32x2v __attribute__((ext_vector_type(2)));
typedef unsigned u32x2v __attribute__((ext_vector_type(2)));
typedef int i32x4v __attribute__((ext_vector_type(4)));
typedef int i32x2v __attribute__((ext_vector_type(2)));
__device__ __forceinline__ float wave_sum(float v) {
#pragma unroll
    for (int o = 1; o < 64; o <<= 1) v += __shfl_xor(v, o);
    return v;
}
__device__ __forceinline__ float bf2f(unsigned short h) { return __builtin_bit_cast(float, (unsigned)h << 16); }
__device__ __forceinline__ float bflo(unsigned w) { return __builtin_bit_cast(float, w << 16); }
__device__ __forceinline__ float bfhi(unsigned w) { return __builtin_bit_cast(float, w & 0xffff0000u); }
__device__ __forceinline__ float sigmoid_f(float v) { return __builtin_amdgcn_rcpf(1.0f + __expf(-v)); }
__device__ __forceinline__ float silu_ff(float v) { return v * __builtin_amdgcn_rcpf(1.0f + __expf(-v)); }
__device__ __forceinline__ float gelu_tanh_f(float v) { const float y = 1.5957691216057308f * (v + 0.044715f * v * v * v); return v * __builtin_amdgcn_rcpf(1.0f + __expf(-y)); }

__device__ __forceinline__ void p0_transpose_item(const float* W, int K, int N, bf16* WT, int row_off, int rmul, LAS float* scr, int item, int lane) {
    const int nblk = N / 64, kb = item / nblk, nb = item % nblk, k0 = 64 * kb, n0 = 64 * nb;
    const int r4 = lane >> 4, q = lane & 15;
    f32x4 v[16];
#pragma unroll
    for (int i = 0; i < 16; ++i) v[i] = *(const f32x4*)(W + (size_t)(k0 + 4 * i + r4) * N + n0 + 4 * q);
#pragma unroll
    for (int i = 0; i < 16; ++i) { LAS float* d = scr + (4 * i + r4) * 65 + 4 * q; d[0] = v[i].x; d[1] = v[i].y; d[2] = v[i].z; d[3] = v[i].w; }
    LDS_WAIT(); asm volatile("" ::: "memory");
    const int c = lane & 7;
#pragma unroll
    for (int j = 0; j < 8; ++j) { const int n = (lane >> 3) + 8 * j; const LAS float* s = scr + (8 * c) * 65 + n;
        v4u o; o.x = pk2(s[0 * 65], s[1 * 65]); o.y = pk2(s[2 * 65], s[3 * 65]); o.z = pk2(s[4 * 65], s[5 * 65]); o.w = pk2(s[6 * 65], s[7 * 65]);
        *(v4u*)(WT + (size_t)(row_off + rmul * (n0 + n)) * K + k0 + 8 * c) = o; }
    LDS_WAIT(); asm volatile("" ::: "memory");
}

struct Ptrs {
    const float* in[29]; float* out; unsigned char* ws;
};

__device__ __forceinline__ void phase_p0a(const Ptrs& P, LAS unsigned char* lds, int tid, int lane, int wave, int vcu, int G) {
    {
        const float* c = P.in[1]; const float* c_ctx = P.in[3]; const float* w_ada = P.in[4]; const float* b_ada = P.in[5];
        float* MOD = (float*)(P.ws + WS_MOD);
        LAS float* red = (LAS float*)lds;
        const int r4 = lane >> 4, q = lane & 15;
        for (int cb = vcu; cb < 96; cb += G) {
            f32x4 acc[5];
#pragma unroll
            for (int r = 0; r < 5; ++r) acc[r] = (f32x4){0.f, 0.f, 0.f, 0.f};
#pragma unroll 8
            for (int i = 0; i < 32; ++i) {
                const int k = wave * 128 + 4 * i + r4;
                const f32x4 w = *(const f32x4*)(w_ada + (size_t)k * 6144 + 64 * cb + 4 * q);
#pragma unroll
                for (int r = 0; r < 5; ++r) { const float sv = silu_ff(r < 4 ? c[r * 1024 + k] : c_ctx[k]); acc[r] += w * sv; }
            }
#pragma unroll
            for (int r = 0; r < 5; ++r) {
#pragma unroll
                for (int e = 0; e < 4; ++e) { float t = acc[r][e]; t += __shfl_xor(t, 16); t += __shfl_xor(t, 32); acc[r][e] = t; }
                if (r4 == 0) *(LAS f32x4*)(red + (wave * 5 + r) * 64 + 4 * q) = acc[r];
            }
            __syncthreads();
            if (tid < 320) { const int r = tid >> 6, cc = tid & 63; float sm = 0.f;
#pragma unroll
                for (int w8 = 0; w8 < 8; ++w8) sm += red[(w8 * 5 + r) * 64 + cc];
                MOD[r * 6144 + 64 * cb + cc] = sm + b_ada[64 * cb + cc]; }
            __syncthreads();
        }
    }
    {
        bf16* RWH = (bf16*)(P.ws + WS_RWH); bf16* RWL = (bf16*)(P.ws + WS_RWL); float* RB = (float*)(P.ws + WS_RB);
        const float* wg = P.in[21]; const float* bg = P.in[22]; const float* we = P.in[23]; const float* be = P.in[24];
        for (int i = vcu * 512 + tid; i < 48 * 1024; i += G * 512) { const int n = i >> 10, k = i & 1023;
            const float w = n < 4 ? wg[k * 4 + n] : (n < 36 ? we[k * 32 + n - 4] : 0.f);
            const unsigned hi = f2bf(w); const float lo = w - __builtin_bit_cast(float, hi << 16);
            RWH[i] = (bf16)hi; RWL[i] = (bf16)f2bf(lo); }
        if (vcu == 0 && tid < 48) RB[tid] = tid < 4 ? bg[tid] : (tid < 36 ? be[tid - 4] : 0.f);
    }
    {
        LAS float* scr = (LAS float*)(lds + wave * 16640);
        const int gw = vcu * NWAVES + wave, NGW = G * NWAVES;
        bf16* WIN = (bf16*)(P.ws + WS_WIN); bf16* WOUT = (bf16*)(P.ws + WS_WOUT); bf16* WG = (bf16*)(P.ws + WS_WG); bf16* W13 = (bf16*)(P.ws + WS_W13); bf16* W2 = (bf16*)(P.ws + WS_W2);
        constexpr int I_IN = 16 * 32, I_OUT = 16 * 16, I_G = 32, I_E = 32 * 256;
        constexpr int NITEMS = I_IN + I_OUT + I_G + 3 * I_E;
        for (int it = gw; it < NITEMS; it += NGW) {
            int r = it;
            if (r < I_E) { const int e = r >> 8; p0_transpose_item(P.in[25] + (size_t)e * 1048576, 1024, 1024, W13, e * 2048, 2, scr, r & 255, lane); continue; } r -= I_E;
            if (r < I_E) { const int e = r >> 8; p0_transpose_item(P.in[26] + (size_t)e * 1048576, 1024, 1024, W13, e * 2048 + 1, 2, scr, r & 255, lane); continue; } r -= I_E;
            if (r < I_E) { const int e = r >> 8; p0_transpose_item(P.in[27] + (size_t)e * 1048576, 1024, 1024, W2, e * 1024, 1, scr, r & 255, lane); continue; } r -= I_E;
            if (r < I_IN) { p0_transpose_item(P.in[8], 1024, 2048, WIN, 0, 1, scr, r, lane); continue; } r -= I_IN;
            if (r < I_OUT) { p0_transpose_item(P.in[20], 1024, 1024, WOUT, 0, 1, scr, r, lane); continue; } r -= I_OUT;
            { const int which = r >> 4, mtx = r & 15;
                p0_transpose_item((which ? P.in[17] : P.in[15]) + mtx * 4096, 64, 64, WG, mtx * 128 + which * 64, 1, scr, 0, lane); }
        }
    }
}

__device__ __forceinline__ void phase_p0b(const Ptrs& P, int lane, int wave, int vcu, int G) {
    const float* MOD = (const float*)(P.ws + WS_MOD); const float* g1n = P.in[6];
    bf16* XN = (bf16*)(P.ws + WS_RA);
    const int gw = vcu * NWAVES + wave, NGW = G * NWAVES;
    for (int m = gw; m < TA; m += NGW) {
        const float* src; int mr;
        if (m < T) { src = P.in[0] + (size_t)m * D; mr = m >> 12; } else { src = P.in[2] + (size_t)(m - T) * D; mr = 4; }
        const f32x4* xr = (const f32x4*)src + lane;
        f32x4 v[4]; float s = 0.f;
#pragma unroll
        for (int j = 0; j < 4; ++j) { v[j] = xr[64 * j]; s += (v[j].x * v[j].x + v[j].y * v[j].y) + (v[j].z * v[j].z + v[j].w * v[j].w); }
        const float rstd = 1.0f / sqrtf(wave_sum(s) * (1.f / D) + EPS);
        const f32x4* gp = (const f32x4*)g1n + lane; const f32x4* shp = (const f32x4*)(MOD + mr * 6144) + lane; const f32x4* scp = (const f32x4*)(MOD + mr * 6144 + 1024) + lane;
        unsigned long long* o8 = (unsigned long long*)(XN + (size_t)m * D) + lane;
#pragma unroll
        for (int j = 0; j < 4; ++j) { const f32x4 g = gp[64 * j], sh = shp[64 * j], sc = scp[64 * j];
            const f32x4 y = v[j] * rstd * g * (sc + 1.0f) + sh;
            o8[64 * j] = (unsigned long long)pk2(y.x, y.y) | ((unsigned long long)pk2(y.z, y.w) << 32); }
    }
}

constexpr int WL_UB = 0;
constexpr int WL_UF = 2304;
constexpr int WL_AB = 6400;
constexpr int WL_BYTES = 14592;
template <bool FINAL, int DIR>
__device__ __forceinline__ void lru_wave_sweep(const Ptrs& P, LAS unsigned char* wl, int gw, int NGW, int lane) {
    const bf16* ZL = (const bf16*)(P.ws + WS_RBB);
    const bf16* WG = (const bf16*)(P.ws + WS_WG);
    float* HF = (float*)(P.ws + WS_RA + 32 * MiB);
    LAS bf16* ub = (LAS bf16*)(wl + WL_UB); LAS float* uf = (LAS float*)(wl + WL_UF); LAS float* ab = (LAS float*)(wl + WL_AB);
    const int h = gw & 7, l15 = lane & 15, q = lane >> 4;
    float cba[4], cbx[4], csp[4];
    bf16x8 br[4][2], bi[4][2];
#pragma unroll
    for (int nt = 0; nt < 4; ++nt) { const int ch = DIR * 512 + 64 * h + 16 * nt + l15; cba[nt] = P.in[16][ch]; cbx[nt] = P.in[18][ch]; csp[nt] = -8.0f * log1pf(expf(-P.in[19][ch]));
        const bf16* wr = WG + (size_t)(((DIR * 8 + h) * 128 + 16 * nt + l15) * 64 + 8 * q);
        br[nt][0] = *(const bf16x8*)(wr); br[nt][1] = *(const bf16x8*)(wr + 32); bi[nt][0] = *(const bf16x8*)(wr + 64 * 64); bi[nt][1] = *(const bf16x8*)(wr + 64 * 64 + 32); }
    const int chl = 64 * h + lane;
    const float w0 = P.in[13][chl], w1 = P.in[13][512 + chl], w2 = P.in[13][1024 + chl], w3 = P.in[13][1536 + chl], cb = P.in[14][chl];
    const int nitems = FINAL ? NB * 256 * 8 : NB * NCH * 8;
    for (int it = gw; it < nitems; it += NGW) {
        const int bc = it >> 3;
        int b, chunk;
        if (FINAL) { b = bc >> 8; chunk = 16 + (bc & 255); } else { b = bc / NCH; chunk = bc % NCH; }
        const bool isctx = chunk < 16;
        const int seq_row0 = isctx ? (T + b * CTXL) : (b * SEQ), seq_len = isctx ? CTXL : SEQ, t0 = (isctx ? chunk : chunk - 16) * 16;
        float x[19];
#pragma unroll
        for (int r = 0; r < 19; ++r) { const int tt = t0 + r - 2; const int tc = tt < 0 ? 0 : (tt >= seq_len ? seq_len - 1 : tt);
            const float v = bf2f(ZL[(size_t)(seq_row0 + tc) * INC + 1024 + chl]); x[r] = (tt == tc) ? v : 0.f; }
        unsigned short zg[16]; float hf[16]; float cin = 0.f;
        if (FINAL) {
            const float* CARRY = (const float*)(P.ws + WS_CARRY);
            cin = CARRY[(size_t)((b * 256 + (chunk - 16)) * 2 + DIR) * 512 + chl];
            if (DIR == 1) {
#pragma unroll
                for (int t = 0; t < 16; ++t) { zg[t] = ZL[(size_t)(seq_row0 + t0 + t) * INC + 1536 + chl]; hf[t] = HF[(size_t)(b * SEQ + t0 + t) * 512 + chl]; }
            }
        }
#pragma unroll
        for (int t = 0; t < 16; ++t) { const float u = cb + w0 * x[t] + w1 * x[t + 1] + w2 * x[t + 2] + w3 * x[t + 3]; ub[t * 72 + lane] = (bf16)f2bf(u); uf[t * 64 + lane] = u; }
        asm volatile("" ::: "memory");
        bf16x8 af[2];
#pragma unroll
        for (int ks = 0; ks < 2; ++ks) af[ks] = *(const LAS bf16x8*)(ub + l15 * 72 + 32 * ks + 8 * q);
        f32x4 ar[4], ai[4];
#pragma unroll
        for (int nt = 0; nt < 4; ++nt) {
            f32x4 z = {0.f, 0.f, 0.f, 0.f};
            ar[nt] = __builtin_amdgcn_mfma_f32_16x16x32_bf16(af[0], br[nt][0], z, 0, 0, 0); ar[nt] = __builtin_amdgcn_mfma_f32_16x16x32_bf16(af[1], br[nt][1], ar[nt], 0, 0, 0);
            ai[nt] = __builtin_amdgcn_mfma_f32_16x16x32_bf16(af[0], bi[nt][0], z, 0, 0, 0); ai[nt] = __builtin_amdgcn_mfma_f32_16x16x32_bf16(af[1], bi[nt][1], ai[nt], 0, 0, 0);
        }
#pragma unroll
        for (int nt = 0; nt < 4; ++nt)
#pragma unroll
            for (int rg = 0; rg < 4; ++rg) {
                const int t = 4 * q + rg, cl = 16 * nt + l15;
                const float r = sigmoid_f(ar[nt][rg] + cba[nt]), ig = sigmoid_f(ai[nt][rg] + cbx[nt]);
                const float la = csp[nt] * r;
                const float a = __expf(la);
                const float x2 = 2.0f * la;
                const float em = x2 * (1.0f + x2 * (0.5f + x2 * (0.16666667f + x2 * (0.041666668f + x2 * (0.0083333338f + x2 * (0.0013888889f + x2 * 0.0001984127f))))));
                const float mult = __builtin_amdgcn_sqrtf(fmaxf(-em, 1e-12f));
                ab[t * 64 + cl] = a; ab[(16 + t) * 64 + cl] = mult * ig * uf[t * 64 + cl];
            }
        asm volatile("" ::: "memory");
        if (!FINAL) {
            float Pp = 1.f, Hh = 0.f;
#pragma unroll
            for (int i = 0; i < 16; ++i) { const int t = DIR ? 15 - i : i; const float a = ab[t * 64 + lane], bq = ab[(16 + t) * 64 + lane]; Hh = a * Hh + bq; Pp *= a; }
            float* AGG = (float*)(P.ws + WS_AGG);
            *(f32x2v*)(AGG + ((size_t)((b * NCH + chunk) * 2 + DIR) * 512 + chl) * 2) = (f32x2v){Pp, Hh};
        } else {
            float hh = cin; float hs[16];
#pragma unroll
            for (int i = 0; i < 16; ++i) { const int t = DIR ? 15 - i : i; const float a = ab[t * 64 + lane], bq = ab[(16 + t) * 64 + lane]; hh = a * hh + bq; hs[t] = hh; }
            if (DIR == 0) {
#pragma unroll
                for (int t = 0; t < 16; ++t) HF[(size_t)(b * SEQ + t0 + t) * 512 + chl] = hs[t];
            } else {
                bf16* MIX = (bf16*)(P.ws + WS_RC);
#pragma unroll
                for (int t = 0; t < 16; ++t) MIX[(size_t)(b * SEQ + t0 + t) * D + 512 + chl] = (bf16)f2bf((hs[t] + hf[t]) * gelu_tanh_f(bf2f(zg[t])));
            }
        }
        asm volatile("" ::: "memory");
    }
}
template <bool FINAL>
__device__ __forceinline__ void lru_wave_items(const Ptrs& P, LAS unsigned char* wl, int gw, int NGW, int lane) {
    lru_wave_sweep<FINAL, 0>(P, wl, gw, NGW, lane);
    if (FINAL) asm volatile("s_waitcnt vmcnt(0)" ::: "memory");
    lru_wave_sweep<FINAL, 1>(P, wl, gw, NGW, lane);
}

template <int T0> __device__ __forceinline__ void conv_rows8(const float (&uu)[64], const float (&w)[31], float cb, float* dst) {
#pragma unroll
    for (int tt = 0; tt < 8; ++tt) {
        float acc = cb;
#pragma unroll
        for (int j = 0; j < 31; ++j) { const int s = T0 + tt + j - 15; if (s >= 0 && s < 64) acc += w[j] * uu[s]; }
        dst[(size_t)(T0 + tt) * 512] = acc;
    }
}
__device__ __forceinline__ void conv_wave_items(const Ptrs& P, int gw, int NGW, int lane) {
    const bf16* ZL = (const bf16*)(P.ws + WS_RBB); float* CV = (float*)(P.ws + WS_RA);
    for (int it = gw; it < NB * 64 * 8; it += NGW) {
        const int s = it >> 3, c = 64 * (it & 7) + lane;
        const bf16* base = ZL + (size_t)(s * 64) * INC + c;
        float uu[64];
#pragma unroll
        for (int t = 0; t < 64; ++t) { const float val = bf2f(base[(size_t)t * INC]), gt = bf2f(base[(size_t)t * INC + 512]); uu[t] = val * sigmoid_f(gt); }
        float w[31];
#pragma unroll
        for (int j = 0; j < 31; ++j) w[j] = P.in[9][j * 512 + c];
        const float cb = P.in[10][c];
        float* dst = CV + (size_t)(s * 64) * 512 + c;
        conv_rows8<0>(uu, w, cb, dst); conv_rows8<8>(uu, w, cb, dst); conv_rows8<16>(uu, w, cb, dst); conv_rows8<24>(uu, w, cb, dst);
        conv_rows8<32>(uu, w, cb, dst); conv_rows8<40>(uu, w, cb, dst); conv_rows8<48>(uu, w, cb, dst); conv_rows8<56>(uu, w, cb, dst);
    }
}
__device__ __forceinline__ void convln_wave_items(const Ptrs& P, int gw, int NGW, int lane) {
    const float* CV = (const float*)(P.ws + WS_RA); bf16* MIX = (bf16*)(P.ws + WS_RC);
    const f32x4 g0 = *(const f32x4*)(P.in[11] + 8 * lane), g1 = *(const f32x4*)(P.in[11] + 8 * lane + 4);
    const f32x4 b0 = *(const f32x4*)(P.in[12] + 8 * lane), b1 = *(const f32x4*)(P.in[12] + 8 * lane + 4);
    for (int tok = gw; tok < T; tok += NGW) {
        f32x4 v0 = *(const f32x4*)(CV + (size_t)tok * 512 + 8 * lane), v1 = *(const f32x4*)(CV + (size_t)tok * 512 + 8 * lane + 4);
        const float mu = wave_sum((v0.x + v0.y) + (v0.z + v0.w) + (v1.x + v1.y) + (v1.z + v1.w)) * (1.f / 512.f);
        v0 = v0 - mu; v1 = v1 - mu;
        const float var = wave_sum((v0.x * v0.x + v0.y * v0.y) + (v0.z * v0.z + v0.w * v0.w) + (v1.x * v1.x + v1.y * v1.y) + (v1.z * v1.z + v1.w * v1.w)) * (1.f / 512.f);
        const float rstd = 1.0f / sqrtf(var + EPS);
        const f32x4 y0 = v0 * rstd * g0 + b0, y1 = v1 * rstd * g1 + b1;
        v4u o; o.x = pk2(silu_ff(y0.x), silu_ff(y0.y)); o.y = pk2(silu_ff(y0.z), silu_ff(y0.w)); o.z = pk2(silu_ff(y1.x), silu_ff(y1.y)); o.w = pk2(silu_ff(y1.z), silu_ff(y1.w));
        *(v4u*)(MIX + (size_t)tok * D + 8 * lane) = o;
    }
}

#ifdef PROBE_LO
#define SUBSTAMP(k) do { if (blockIdx.x == 0 && tid == 0) ((volatile LAS unsigned*)(lds + MISC_OFF))[256 + (k)] = (unsigned)__builtin_amdgcn_s_memrealtime(); } while (0)
#else
#define SUBSTAMP(k) do {} while (0)
#endif
__device__ __forceinline__ void phase_p2a(const Ptrs& P, LAS unsigned char* lds, int tid, int lane, int wave, int vcu, int G) {
    const int gw = vcu * NWAVES + wave, NGW = G * NWAVES;
    SUBSTAMP(20);
    lru_wave_items<false>(P, lds + wave * WL_BYTES, gw, NGW, lane);
    SUBSTAMP(21);
    conv_wave_items(P, gw, NGW, lane);
    SUBSTAMP(22);
}
__device__ __forceinline__ void phase_p2b(const Ptrs& P, LAS unsigned char* lds, int tid, int vcu, int G) {
    const float* AGG = (const float*)(P.ws + WS_AGG); float* CARRY = (float*)(P.ws + WS_CARRY);
    LAS float* SEGP = (LAS float*)lds;
    for (int item = vcu; item < NB * 2 * 16; item += G) {
        const int b = item >> 5, d = (item >> 4) & 1, cl = tid & 31, ch = 32 * (item & 15) + cl, seg = tid >> 5;
        float A[17], Bv[17];
#pragma unroll
        for (int i = 0; i < 17; ++i) { const int j = 17 * seg + i; const int chunk = d ? (j < 16 ? 15 - j : 287 - j) : j;
            const f32x2v abv = *(const f32x2v*)(AGG + ((size_t)((b * NCH + chunk) * 2 + d) * 512 + ch) * 2); A[i] = abv.x; Bv[i] = abv.y; }
        float Pp = 1.f, Hh = 0.f;
#pragma unroll
        for (int i = 0; i < 17; ++i) { Hh = A[i] * Hh + Bv[i]; Pp *= A[i]; }
        SEGP[(seg * 32 + cl) * 2] = Pp; SEGP[(seg * 32 + cl) * 2 + 1] = Hh;
        __syncthreads();
        float hh = 0.f;
        for (int sg = 0; sg < seg; ++sg) hh = SEGP[(sg * 32 + cl) * 2] * hh + SEGP[(sg * 32 + cl) * 2 + 1];
#pragma unroll
        for (int i = 0; i < 17; ++i) { const int j = 17 * seg + i; const int chunk = d ? (j < 16 ? 15 - j : 287 - j) : j;
            if (chunk >= 16) CARRY[(size_t)((b * 256 + chunk - 16) * 2 + d) * 512 + ch] = hh;
            hh = A[i] * hh + Bv[i]; }
        __syncthreads();
    }
}
__device__ __forceinline__ void phase_p2c(const Ptrs& P, LAS unsigned char* lds, int tid, int lane, int wave, int vcu, int G) {
    const int gw = vcu * NWAVES + wave, NGW = G * NWAVES;
    SUBSTAMP(24);
    lru_wave_items<true>(P, lds + wave * WL_BYTES, gw, NGW, lane);
    SUBSTAMP(25);
    convln_wave_items(P, gw, NGW, lane);
    SUBSTAMP(26);
}

constexpr int L_AH = 0, L_AL = 66048, HL_PITCH = 2064;
constexpr int L_PART = 0;
constexpr int L_LG = 132096;
constexpr int L_LCNT = 138240;
constexpr int L_LBASE = 138368;
__device__ __forceinline__ void phase_p4a(const Ptrs& P, LAS unsigned char* lds, int tid, int lane, int wave, int vcu, int G) {
    const float* MOD = (const float*)(P.ws + WS_MOD); const float* g2n = P.in[7];
    const bf16* RWH = (const bf16*)(P.ws + WS_RWH); const bf16* RWL = (const bf16*)(P.ws + WS_RWL); const float* RB = (const float*)(P.ws + WS_RB);
    bf16* H2 = (bf16*)(P.ws + WS_RC + 32 * MiB);
    unsigned* gcnt = (unsigned*)(P.ws + WS_CTL) + CW_CNT;
    LAS float* lg = (LAS float*)(lds + L_LG); LAS int* lcnt = (LAS int*)(lds + L_LCNT); LAS int* lbase = (LAS int*)(lds + L_LBASE); LAS float* part = (LAS float*)(lds + L_PART);
    const int l15 = lane & 15, l4 = lane >> 4;
    for (int it = vcu; it < T / 32; it += G) {
        if (tid < 32) lcnt[tid] = 0;
        for (int i = 0; i < 4; ++i) {
            const int tl = wave * 4 + i, tok = it * 32 + tl, mr = tok >> 12;
            const f32x4* xr = (const f32x4*)(P.out + (size_t)tok * D) + lane;
            f32x4 v[4]; float s = 0.f;
#pragma unroll
            for (int j = 0; j < 4; ++j) { v[j] = xr[64 * j]; s += (v[j].x * v[j].x + v[j].y * v[j].y) + (v[j].z * v[j].z + v[j].w * v[j].w); }
            const float rstd = 1.0f / sqrtf(wave_sum(s) * (1.f / D) + EPS);
            const f32x4* gp = (const f32x4*)g2n + lane; const f32x4* shp = (const f32x4*)(MOD + mr * 6144 + 3072) + lane; const f32x4* scp = (const f32x4*)(MOD + mr * 6144 + 4096) + lane;
            unsigned long long* o8 = (unsigned long long*)(H2 + (size_t)tok * D) + lane;
#pragma unroll
            for (int j = 0; j < 4; ++j) { const f32x4 g = gp[64 * j], sh = shp[64 * j], sc = scp[64 * j];
                const f32x4 y = v[j] * rstd * g * (sc + 1.0f) + sh;
                const unsigned h0 = f2bf(y.x), h1 = f2bf(y.y), h2_ = f2bf(y.z), h3 = f2bf(y.w);
                const unsigned long long pk = (unsigned long long)(h0 | (h1 << 16)) | ((unsigned long long)(h2_ | (h3 << 16)) << 32);
                const unsigned long long pl = (unsigned long long)pk2(y.x - __builtin_bit_cast(float, h0 << 16), y.y - __builtin_bit_cast(float, h1 << 16)) |
                                              ((unsigned long long)pk2(y.z - __builtin_bit_cast(float, h2_ << 16), y.w - __builtin_bit_cast(float, h3 << 16)) << 32);
                o8[64 * j] = pk;
                *(LAS unsigned long long*)(lds + L_AH + tl * HL_PITCH + (lane + 64 * j) * 8) = pk;
                *(LAS unsigned long long*)(lds + L_AL + tl * HL_PITCH + (lane + 64 * j) * 8) = pl; }
        }
        __syncthreads();
        {
            f32x4 acc[2][3];
#pragma unroll
            for (int mt = 0; mt < 2; ++mt)
#pragma unroll
                for (int nt = 0; nt < 3; ++nt) acc[mt][nt] = (f32x4){0.f, 0.f, 0.f, 0.f};
#pragma unroll
            for (int kq = 0; kq < 4; ++kq) {
                const int kof = 32 * (4 * wave + kq) + 8 * l4;
                bf16x8 ah[2], al[2], bh[3], bl[3];
#pragma unroll
                for (int nt = 0; nt < 3; ++nt) { bh[nt] = *(const bf16x8*)(RWH + (size_t)(16 * nt + l15) * 1024 + kof); bl[nt] = *(const bf16x8*)(RWL + (size_t)(16 * nt + l15) * 1024 + kof); }
#pragma unroll
                for (int mt = 0; mt < 2; ++mt) { ah[mt] = *(const LAS bf16x8*)(lds + L_AH + (16 * mt + l15) * HL_PITCH + kof * 2); al[mt] = *(const LAS bf16x8*)(lds + L_AL + (16 * mt + l15) * HL_PITCH + kof * 2); }
#pragma unroll
                for (int mt = 0; mt < 2; ++mt)
#pragma unroll
                    for (int nt = 0; nt < 3; ++nt) {
                        acc[mt][nt] = __builtin_amdgcn_mfma_f32_16x16x32_bf16(al[mt], bh[nt], acc[mt][nt], 0, 0, 0);
                        acc[mt][nt] = __builtin_amdgcn_mfma_f32_16x16x32_bf16(ah[mt], bl[nt], acc[mt][nt], 0, 0, 0);
                        acc[mt][nt] = __builtin_amdgcn_mfma_f32_16x16x32_bf16(ah[mt], bh[nt], acc[mt][nt], 0, 0, 0); }
            }
            __syncthreads();
#pragma unroll
            for (int mt = 0; mt < 2; ++mt)
#pragma unroll
                for (int nt = 0; nt < 3; ++nt)
#pragma unroll
                    for (int rg = 0; rg < 4; ++rg) part[(wave * 32 + 16 * mt + 4 * l4 + rg) * 48 + 16 * nt + l15] = acc[mt][nt][rg];
        }
        __syncthreads();
        for (int o = tid; o < 32 * 48; o += 512) { float sm = 0.f;
#pragma unroll
            for (int w8 = 0; w8 < 8; ++w8) sm += part[w8 * 1536 + o];
            lg[o] = sm + RB[o % 48]; }
        __syncthreads();
        int e0 = 0, e1 = 0, rk0 = 0, rk1 = 0; float gt0 = 0.f, gt1 = 0.f;
        if (tid < 32) {
            const LAS float* l = lg + tid * 48;
            int grp = 0; float lm = l[0];
#pragma unroll
            for (int q = 1; q < 4; ++q) if (l[q] > lm) { lm = l[q]; grp = q; }
            float den = 0.f;
#pragma unroll
            for (int q = 0; q < 4; ++q) den += __expf(l[q] - lm);
            const float pgrp = 1.0f / den;
            const LAS float* le = l + 4 + grp * 8;
            int i1 = 0; float m1 = le[0];
#pragma unroll
            for (int q = 1; q < 8; ++q) if (le[q] > m1) { m1 = le[q]; i1 = q; }
            int i2 = -1; float m2 = -3.0e38f;
#pragma unroll
            for (int q = 0; q < 8; ++q) if (q != i1 && le[q] > m2) { m2 = le[q]; i2 = q; }
            const float ex = __expf(m2 - m1), inv = 1.0f / (1.0f + ex);
            gt0 = pgrp * inv; gt1 = pgrp * ex * inv;
            e0 = grp * 8 + i1; e1 = grp * 8 + i2;
            rk0 = atomicAdd((int*)(lcnt + e0), 1); rk1 = atomicAdd((int*)(lcnt + e1), 1);
        }
        __syncthreads();
        if (tid < 32) lbase[tid] = (int)__hip_atomic_fetch_add(gcnt + tid, (unsigned)lcnt[tid], __ATOMIC_RELAXED, __HIP_MEMORY_SCOPE_AGENT);
        __syncthreads();
        if (tid < 32) {
            const int tok = it * 32 + tid;
            *(i32x4v*)(P.ws + WS_ROUTE + (size_t)tok * 16) = (i32x4v){e0, lbase[e0] + rk0, e1, lbase[e1] + rk1};
            *(f32x2v*)(P.ws + WS_RG + (size_t)tok * 8) = (f32x2v){gt0, gt1};
        }
        __syncthreads();
    }
}
__device__ __forceinline__ void build_tiles(const Ptrs& P, volatile LAS unsigned* MISC, int tid) {
    if (tid == 0) {
        unsigned* gcnt = (unsigned*)(P.ws + WS_CTL) + CW_CNT;
        int run = 0;
        for (int e = 0; e < NE; ++e) {
            const int cnt = (int)__hip_atomic_load(gcnt + e, __ATOMIC_RELAXED, __HIP_MEMORY_SCOPE_AGENT);
            const int nt = (cnt + 255) >> 8;
            MISC[16 + e] = (unsigned)(run * 256);
            for (int q = 0; q < nt && run + q < 192; ++q) MISC[64 + run + q] = (unsigned)e;
            run += nt;
        }
        MISC[8] = (unsigned)(run < 192 ? run : 192);
    }
    __syncthreads();
}
__device__ __forceinline__ void phase_p4b(const Ptrs& P, volatile LAS unsigned* MISC, int lane, int wave, int vcu, int G) {
    const bf16* H2 = (const bf16*)(P.ws + WS_RC + 32 * MiB); bf16* XS = (bf16*)(P.ws + WS_RA);
    float* GATE = (float*)(P.ws + WS_GATE);
    const int gw = vcu * NWAVES + wave, NGW = G * NWAVES;
    for (int tok = gw; tok < T; tok += NGW) {
        const i32x4v r = *(const i32x4v*)(P.ws + WS_ROUTE + (size_t)tok * 16);
        const f32x2v g = *(const f32x2v*)(P.ws + WS_RG + (size_t)tok * 8);
        const int s0 = (int)MISC[16 + r.x] + r.y, s1 = (int)MISC[16 + r.z] + r.w;
        const v4u* src = (const v4u*)(H2 + (size_t)tok * D) + lane;
        const v4u a0 = src[0], a1 = src[64];
        v4u* d0 = (v4u*)(XS + (size_t)s0 * D) + lane; v4u* d1 = (v4u*)(XS + (size_t)s1 * D) + lane;
        d0[0] = a0; d0[64] = a1; d1[0] = a0; d1[64] = a1;
        if (lane == 0) { GATE[s0] = g.x; GATE[s1] = g.y; *(i32x2v*)(P.ws + WS_SLOT + (size_t)tok * 8) = (i32x2v){s0, s1}; }
    }
}
__device__ __forceinline__ void phase_p6(const Ptrs& P, int lane, int wave, int vcu, int G) {
    const float* MOD = (const float*)(P.ws + WS_MOD); const float* fg = P.in[28];
    const bf16* Y = (const bf16*)(P.ws + WS_RC);
    const int gw = vcu * NWAVES + wave, NGW = G * NWAVES;
    for (int tok = gw; tok < T; tok += NGW) {
        const i32x2v sl = *(const i32x2v*)(P.ws + WS_SLOT + (size_t)tok * 8);
        const int mr = tok >> 12;
        f32x4* xr = (f32x4*)(P.out + (size_t)tok * D) + lane;
        const u32x2v* y0 = (const u32x2v*)(Y + (size_t)sl.x * D) + lane; const u32x2v* y1 = (const u32x2v*)(Y + (size_t)sl.y * D) + lane;
        const f32x4* g2p = (const f32x4*)(MOD + mr * 6144 + 5120) + lane;
        f32x4 v[4]; float s = 0.f;
#pragma unroll
        for (int j = 0; j < 4; ++j) { const f32x4 xv = xr[64 * j], g2 = g2p[64 * j]; const u32x2v a = y0[64 * j], bq = y1[64 * j];
            f32x4 yy; yy.x = bflo(a.x) + bflo(bq.x); yy.y = bfhi(a.x) + bfhi(bq.x); yy.z = bflo(a.y) + bflo(bq.y); yy.w = bfhi(a.y) + bfhi(bq.y);
            v[j] = xv + g2 * yy; s += (v[j].x * v[j].x + v[j].y * v[j].y) + (v[j].z * v[j].z + v[j].w * v[j].w); }
        const float rstd = 1.0f / sqrtf(wave_sum(s) * (1.f / D) + EPS);
        const f32x4* fgp = (const f32x4*)fg + lane;
#pragma unroll
        for (int j = 0; j < 4; ++j) xr[64 * j] = v[j] * rstd * fgp[64 * j];
    }
}

struct Args { const float* in[29]; float* out; unsigned char* ws; int ph_lo, ph_hi, li, pad; };
__global__ void __launch_bounds__(NWAVES * 64, 2) fwd_kernel(Args args) {
    extern __shared__ __attribute__((aligned(16))) unsigned char lds_raw[];
    LAS unsigned char* lds = (LAS unsigned char*)lds_raw;
    volatile LAS unsigned* MISC = (volatile LAS unsigned*)(lds + MISC_OFF);
    const int tid = threadIdx.x, lane = tid & 63, wave = __builtin_amdgcn_readfirstlane(tid >> 6);
    const int G = gridDim.x; const int bx = blockIdx.x; const int vcu = (G % 8 == 0) ? (bx % 8) * (G / 8) + bx / 8 : bx;
    Ptrs P;
#pragma unroll
    for (int i = 0; i < 29; ++i) P.in[i] = args.in[i];
    P.out = args.out; P.ws = args.ws;
    for (int u = tid; u < (LDS_BYTES - MISC_OFF) / 4; u += NWAVES * 64) MISC[u] = 0u;
    __syncthreads();
    unsigned* ctl = (unsigned*)(P.ws + WS_CTL);
    XcdBarrier bar; bar.bar = ctl + CW_BAR; bar.x = 0; bar.st = nullptr;
    if (N_LAUNCHES == 1) bar = xcd_barrier_post(ctl + CW_BAR, MISC);
#define GRID_BAR() do { if (N_LAUNCHES == 1) xcd_barrier(bar); } while (0)
    const int lo = args.ph_lo, hi = args.ph_hi;
#define IN(k) (lo <= (k) && (k) < hi)
#ifdef PROBE_LO
#define STAMP(k) do { if (bx == 0 && tid == 0) MISC[256 + (k)] = (unsigned)__builtin_amdgcn_s_memrealtime(); } while (0)
#else
#define STAMP(k) do {} while (0)
#endif
    STAMP(0);
#define BOTH(k) (IN(k) && IN((k) + 1))

    if (IN(0)) { phase_p0a(P, lds, tid, lane, wave, vcu, G); if (BOTH(0)) GRID_BAR(); STAMP(1); }
    if (IN(1)) { phase_p0b(P, lane, wave, vcu, G); if (BOTH(1)) GRID_BAR(); STAMP(2); }
    if (IN(2)) {
        pg8::Gemm g{(const pg8::bf16_t*)(P.ws + WS_RA), (const pg8::bf16_t*)(P.ws + WS_WIN), TA, INC, D};
        pg8::OrderInProj S; S.so.init(T, INC, G, bx);
        pg8::EpiStoreBf16 E{(pg8::bf16_t*)(P.ws + WS_RBB), INC};
        pg8::gemm_phase<pg8::EpiStoreBf16, pg8::OrderInProj, true, true>(lds + RING_OFF, g, S, E);
        if (BOTH(2)) GRID_BAR(); STAMP(3);
    }
    if (IN(3)) { phase_p2a(P, lds, tid, lane, wave, vcu, G); if (BOTH(3)) GRID_BAR(); STAMP(4); }
    if (IN(4)) { phase_p2b(P, lds, tid, vcu, G); if (BOTH(4)) GRID_BAR(); STAMP(5); }
    if (IN(5)) { phase_p2c(P, lds, tid, lane, wave, vcu, G); if (BOTH(5)) GRID_BAR(); STAMP(6); }
    if (IN(6)) {
        pg8::Gemm g{(const pg8::bf16_t*)(P.ws + WS_RC), (const pg8::bf16_t*)(P.ws + WS_WOUT), T, D, D};
        pg8::StaticOrder S; S.init(T, D, G, bx);
        pg8::EpiResid E{P.in[0], (const float*)(P.ws + WS_MOD) + 2048, 6144, P.out};
        pg8::gemm_phase<pg8::EpiResid, pg8::StaticOrder, true, true>(lds + RING_OFF, g, S, E);
        if (BOTH(6)) GRID_BAR(); STAMP(7);
    }
    if (IN(7)) { phase_p4a(P, lds, tid, lane, wave, vcu, G); if (BOTH(7)) GRID_BAR(); STAMP(8); }
    if (IN(8)) { build_tiles(P, MISC, tid); phase_p4b(P, MISC, lane, wave, vcu, G); if (BOTH(8)) GRID_BAR(); STAMP(9); }
    if (IN(9)) {
        build_tiles(P, MISC, tid);
        pg8::Gemm g{(const pg8::bf16_t*)(P.ws + WS_RA), (const pg8::bf16_t*)(P.ws + WS_W13), NSLOT, 2048, D};
        pg8::OrderMoe S{G, bx, 8, (int)MISC[8] * 8, (const LAS int*)(lds + MISC_OFF + 256)};
        pg8::EpiSwiglu E{(pg8::bf16_t*)(P.ws + WS_RBB)};
        pg8::gemm_phase<pg8::EpiSwiglu, pg8::OrderMoe, true, true>(lds + RING_OFF, g, S, E);
        if (BOTH(9)) GRID_BAR(); STAMP(10);
    }
    if (IN(10)) {
        build_tiles(P, MISC, tid);
        pg8::Gemm g{(const pg8::bf16_t*)(P.ws + WS_RBB), (const pg8::bf16_t*)(P.ws + WS_W2), NSLOT, 1024, D};
        pg8::OrderMoe S{G, bx, 4, (int)MISC[8] * 4, (const LAS int*)(lds + MISC_OFF + 256)};
        pg8::EpiGateBf16 E{(pg8::bf16_t*)(P.ws + WS_RC), (const float*)(P.ws + WS_GATE)};
        pg8::gemm_phase<pg8::EpiGateBf16, pg8::OrderMoe, true, true>(lds + RING_OFF, g, S, E);
        if (BOTH(10)) GRID_BAR(); STAMP(11);
    }
    if (IN(11)) { phase_p6(P, lane, wave, vcu, G); }
#ifdef PROBE_LO
    if (bx == 0 && tid == 0) {
        const unsigned dt = (MISC[256 + PROBE_HI] - MISC[256 + PROBE_LO]) * PROBE_MULT;
        const unsigned t0 = (unsigned)__builtin_amdgcn_s_memrealtime();
        while ((unsigned)__builtin_amdgcn_s_memrealtime() - t0 < dt) __builtin_amdgcn_s_sleep(32);
    }
#endif
#undef IN
#undef BOTH
}

extern "C" void kernel_launch(void* const* d_in, const int* in_sizes, int n_in, void* d_out, int out_size, void* d_ws, size_t ws_size, hipStream_t stream) {
    static int grid = 0;
    if (grid == 0) {
        if (n_in != 29 || in_sizes[0] != T * D || out_size != T * D || ws_size < WS_END) { fprintf(stderr, "kernel_launch: built for 29 inputs, x and out of %d floats, >= %zu bytes of workspace; got n_in %d, in0 %d, out %d, ws %zu; nothing launched\n", T * D, (size_t)WS_END, n_in, n_in > 0 ? in_sizes[0] : -1, out_size, ws_size); grid = -1; return; }
        int dev = 0, cus = 0, per_cu = 0;
        if (hipGetDevice(&dev) != hipSuccess || hipDeviceGetAttribute(&cus, hipDeviceAttributeMultiprocessorCount, dev) != hipSuccess) { fprintf(stderr, "kernel_launch: hipGetDevice / hipDeviceGetAttribute failed\n"); grid = -1; return; }
        if (hipFuncSetAttribute((const void*)fwd_kernel, hipFuncAttributeMaxDynamicSharedMemorySize, LDS_BYTES) != hipSuccess) { fprintf(stderr, "kernel_launch: hipFuncSetAttribute failed (%d bytes of dynamic LDS)\n", LDS_BYTES); grid = -1; return; }
        if (hipOccupancyMaxActiveBlocksPerMultiprocessor(&per_cu, (const void*)fwd_kernel, NWAVES * 64, LDS_BYTES) != hipSuccess || per_cu < 1)
            fprintf(stderr, "kernel_launch: note: the occupancy query reports %d workgroups per CU\n", per_cu);
        (void)hipGetLastError();
        grid = cus;
    }
    if (grid < 0) return;
    if (hipMemsetAsync((char*)d_ws + WS_CTL, 0, CTL_ZERO_BYTES, stream) != hipSuccess) { fprintf(stderr, "kernel_launch: hipMemsetAsync failed\n"); return; }
    Args a{};
    for (int i = 0; i < 29; ++i) a.in[i] = (const float*)d_in[i];
    a.out = (float*)d_out; a.ws = (unsigned char*)d_ws;
    for (int li = 0; li < N_LAUNCHES; ++li) {
        a.ph_lo = (N_LAUNCHES == 1) ? 0 : li; a.ph_hi = (N_LAUNCHES == 1) ? NPH : li + 1; a.li = li;
        hipLaunchKernelGGL(fwd_kernel, dim3(grid), dim3(NWAVES * 64), LDS_BYTES, stream, a);
        const hipError_t le = hipPeekAtLastError();
        if (le != hipSuccess) { fprintf(stderr, "kernel_launch: launch %d failed: %s\n", li, hipGetErrorName(le)); break; }
    }
}
```

```cpp
#include <hip/hip_runtime.h>
#include <cstdio>
#include <cstdint>
namespace pg8 {
#define PG8_LAS __attribute__((address_space(3)))
typedef unsigned short bf16_t;
typedef short bf16x8 __attribute__((ext_vector_type(8)));
typedef float f32x4 __attribute__((ext_vector_type(4)));
typedef unsigned u32x4 __attribute__((ext_vector_type(4)));
constexpr int BM = 256, BK = 64, HALF = 128, HTB = HALF * BK * 2  , STAGE_BYTES = 8 * HTB, NXCD = 8, WGM = 8;

__host__ __device__ __forceinline__ int lds_byte(int r, int c) { const int st = (r >> 4) * 2 + (c >> 5), rr = r & 15, cc = c & 31, ob = rr * 64 + cc * 2; return st * 1024 + (ob ^ (((ob >> 9) & 1) << 5)); }
__host__ __device__ __forceinline__ void stage_rc(int b, int& R, int& C) { const int st = b / 1024, sb = b % 1024, swz = sb ^ (((sb >> 9) & 1) << 5); R = (st >> 1) * 16 + swz / 64; C = (st & 1) * 32 + (swz % 64) / 2; }
__host__ __device__ __forceinline__ int perm32(int rho) { const int n = rho >> 4, i = rho & 15; return 8 * (i >> 2) + 4 * n + (i & 3); }

struct Unit { int pm, pn; };
struct Gemm { const bf16_t* A; const bf16_t* Bt; int M, N, K; };

struct StaticOrder {
    int nM, nN, nwg, G, c;
    __host__ __device__ void init(int M, int N, int G_, int c_) { nM = M / BM; nN = N / BM; nwg = nM * nN; G = G_; c = c_; }
    __host__ __device__ bool next(int i, Unit& u) const {
        const long L = (long)i * G + c; if (L >= nwg) return false;
        int wgid = (int)L; { const int q = nwg / NXCD, r = nwg % NXCD, xcd = wgid % NXCD, off = wgid / NXCD; wgid = (xcd < r ? xcd * (q + 1) : r * (q + 1) + (xcd - r) * q) + off; }
        const int nig = WGM * nN, gid = wgid / nig, fm = gid * WGM, gsz = (nM - fm) < WGM ? (nM - fm) : WGM;
        u.pm = fm + ((wgid % nig) % gsz); u.pn = (wgid % nig) / gsz; return true;
    }
    __device__ __forceinline__ void a_ready(const Unit&) const {}
    __device__ __forceinline__ void done(const Unit&) const {}
};

__device__ __forceinline__ unsigned cvt_pk_bf16(float lo, float hi) { unsigned r; asm volatile("v_cvt_pk_bf16_f32 %0, %1, %2" : "=v"(r) : "v"(lo), "v"(hi)); return r; }
typedef unsigned u32x2 __attribute__((ext_vector_type(2)));
__device__ __forceinline__ float silu_f(float v) { return v * __builtin_amdgcn_rcpf(1.0f + __expf(-v)); }

struct EpiStoreBf16 {
    static constexpr bool PERM = true, AFTER_DRAIN = false;
    bf16_t* O; int ldc;
    __device__ __forceinline__ void operator()(const f32x4 (&acc)[2][2][4][2], const Unit& u, int wr, int wc, int fr, int fq) const {
        const int row0 = u.pm * BM + wr * 64 + fr, col0 = u.pn * BM + wc * 32 + 8 * fq;
#pragma unroll
        for (int ai = 0; ai < 2; ++ai)
#pragma unroll
            for (int m = 0; m < 4; ++m) { bf16_t* rowp = O + (size_t)(row0 + ai * HALF + m * 16) * ldc + col0;
#pragma unroll
                for (int bj = 0; bj < 2; ++bj) { const f32x4 v0 = acc[ai][bj][m][0], v1 = acc[ai][bj][m][1];
                    u32x4 w; w.x = cvt_pk_bf16(v0[0], v0[1]); w.y = cvt_pk_bf16(v0[2], v0[3]); w.z = cvt_pk_bf16(v1[0], v1[1]); w.w = cvt_pk_bf16(v1[2], v1[3]);
                    *(u32x4*)(rowp + bj * HALF) = w; } }
    }
};
struct EpiResid {
    static constexpr bool PERM = true, AFTER_DRAIN = false;
    const float* x; const float* g; int gp; float* out;
    __device__ __forceinline__ void operator()(const f32x4 (&acc)[2][2][4][2], const Unit& u, int wr, int wc, int fr, int fq) const {
        const int row0 = u.pm * BM + wr * 64 + fr, col0 = u.pn * BM + wc * 32 + 8 * fq;
        const float* gb = g + (size_t)((u.pm * BM) >> 12) * gp + col0;
        f32x4 gv[2][2];
#pragma unroll
        for (int bj = 0; bj < 2; ++bj) { gv[bj][0] = *(const f32x4*)(gb + bj * HALF); gv[bj][1] = *(const f32x4*)(gb + bj * HALF + 4); }
#pragma unroll
        for (int ai = 0; ai < 2; ++ai)
#pragma unroll
            for (int m = 0; m < 4; ++m) { const size_t off = (size_t)(row0 + ai * HALF + m * 16) * 1024 + col0;
#pragma unroll
                for (int bj = 0; bj < 2; ++bj) {
                    const f32x4 x0 = *(const f32x4*)(x + off + bj * HALF), x1 = *(const f32x4*)(x + off + bj * HALF + 4);
                    *(f32x4*)(out + off + bj * HALF) = x0 + gv[bj][0] * acc[ai][bj][m][0];
                    *(f32x4*)(out + off + bj * HALF + 4) = x1 + gv[bj][1] * acc[ai][bj][m][1]; } }
    }
};
struct EpiSwiglu {
    static constexpr bool PERM = true, AFTER_DRAIN = false;
    bf16_t* H;
    __device__ __forceinline__ void operator()(const f32x4 (&acc)[2][2][4][2], const Unit& u, int wr, int wc, int fr, int fq) const {
        const int row0 = u.pm * BM + wr * 64 + fr, col0 = (u.pn & 7) * 128 + wc * 16 + 4 * fq;
#pragma unroll
        for (int ai = 0; ai < 2; ++ai)
#pragma unroll
            for (int m = 0; m < 4; ++m) { bf16_t* rowp = H + (size_t)(row0 + ai * HALF + m * 16) * 1024 + col0;
#pragma unroll
                for (int bj = 0; bj < 2; ++bj) { const f32x4 v0 = acc[ai][bj][m][0], v1 = acc[ai][bj][m][1];
                    u32x2 w; w.x = cvt_pk_bf16(silu_f(v0[0]) * v0[1], silu_f(v0[2]) * v0[3]); w.y = cvt_pk_bf16(silu_f(v1[0]) * v1[1], silu_f(v1[2]) * v1[3]);
                    *(u32x2*)(rowp + bj * 64) = w; } }
    }
};
struct EpiGateBf16 {
    static constexpr bool PERM = true, AFTER_DRAIN = false;
    bf16_t* Y; const float* gate;
    __device__ __forceinline__ void operator()(const f32x4 (&acc)[2][2][4][2], const Unit& u, int wr, int wc, int fr, int fq) const {
        const int row0 = u.pm * BM + wr * 64 + fr, col0 = (u.pn & 3) * BM + wc * 32 + 8 * fq;
#pragma unroll
        for (int ai = 0; ai < 2; ++ai)
#pragma unroll
            for (int m = 0; m < 4; ++m) { const int row = row0 + ai * HALF + m * 16; const float gt = gate[row]; bf16_t* rowp = Y + (size_t)row * 1024 + col0;
#pragma unroll
                for (int bj = 0; bj < 2; ++bj) { const f32x4 v0 = acc[ai][bj][m][0] * gt, v1 = acc[ai][bj][m][1] * gt;
                    u32x4 w; w.x = cvt_pk_bf16(v0[0], v0[1]); w.y = cvt_pk_bf16(v0[2], v0[3]); w.z = cvt_pk_bf16(v1[0], v1[1]); w.w = cvt_pk_bf16(v1[2], v1[3]);
                    *(u32x4*)(rowp + bj * HALF) = w; } }
    }
};
struct OrderInProj {
    StaticOrder so;
    __device__ bool next(int i, Unit& u) const {
        const long L = (long)i * so.G + so.c;
        if (L < so.nwg) return so.next(i, u);
        const int j = (int)(L - so.nwg); if (j >= 8) return false;
        u.pm = 64 + (j >> 1); u.pn = 4 + (j & 1); return true;
    }
    __device__ __forceinline__ void a_ready(const Unit&) const {}
    __device__ __forceinline__ void done(const Unit&) const {}
};
struct OrderMoe {
    int lc, ntn; const PG8_LAS int* xt;
    __device__ bool next(int i, Unit& u) const {
        const int j = i * 32 + lc; if (j >= xt[8] * ntn) return false;
        int k = 0;
#pragma unroll
        for (int q = 1; q < 4; ++q) if (j >= xt[4 + q] * ntn) k = q;
        const int jj = j - xt[4 + k] * ntn;
        u.pm = xt[k] + jj / ntn; u.pn = ((lc_x + 8 * k) * ntn) + jj % ntn; return true;
    }
    int lc_x;
    __device__ __forceinline__ void a_ready(const Unit&) const {}
    __device__ __forceinline__ void done(const Unit&) const {}
};
template <class Epi, class Sched, bool ALIGN_EPI = false, bool SP2 = false>
__device__ __forceinline__ void gemm_phase(PG8_LAS unsigned char* lds, const Gemm g, const Sched& S, const Epi& E) {
    const int tid = threadIdx.x, wid = __builtin_amdgcn_readfirstlane(tid >> 6), lane = tid & 63, wr = wid >> 2, wc = wid & 3, fr = lane & 15, fq = lane >> 4;
    const int K = g.K, nt = K / BK;
    unsigned voffA[2], voffB[2];
#pragma unroll
    for (int i = 0; i < 2; ++i) { int R, C; stage_rc(tid * 16 + i * 8192, R, C); const int Rb = Epi::PERM ? ((R & ~31) + perm32(R & 31)) : R;
        voffA[i] = (unsigned)(R * K + C) * 2u; voffB[i] = (unsigned)(Rb * K + C) * 2u; }
    const size_t kstep = (size_t)(BK * 2);
    const size_t hstep = (size_t)HALF * K * 2;
    const size_t tstep = 2 * hstep;
    const unsigned ldsw = (unsigned)wid * 1024u;
    const int aoff = lds_byte(wr * 64 + fr, fq * 8), boff = lds_byte(wc * 32 + fr, fq * 8);
#define PG8_SA(b, h) (((b) * 2 + (h)) * HTB)
#define PG8_SB(b, h) ((4 + (b) * 2 + (h)) * HTB)
#define PG8_STAGE(bufoff, gbase, voff) do { _Pragma("unroll") for (int _i = 0; _i < 2; ++_i) \
        __builtin_amdgcn_global_load_lds((const unsigned*)((const char*)(gbase) + (voff)[_i]), (PG8_LAS unsigned*)(lds + (bufoff) + ldsw + _i * 8192), 16, 0, 0); } while (0)
#define PG8_LDA(dst, b, h) do { _Pragma("unroll") for (int m = 0; m < 4; ++m) _Pragma("unroll") for (int k = 0; k < 2; ++k) dst[m][k] = *(const PG8_LAS bf16x8*)(lds + PG8_SA(b, h) + aoff + m * 2048 + k * 1024); } while (0)
#define PG8_LDB(dst, b, h) do { _Pragma("unroll") for (int n = 0; n < 2; ++n) _Pragma("unroll") for (int k = 0; k < 2; ++k) dst[n][k] = *(const PG8_LAS bf16x8*)(lds + PG8_SB(b, h) + boff + n * 2048 + k * 1024); } while (0)
#define PG8_MMA(ai, bj, At, Bt) do { __builtin_amdgcn_s_setprio(1); _Pragma("unroll") for (int m = 0; m < 4; ++m) _Pragma("unroll") for (int n = 0; n < 2; ++n) _Pragma("unroll") for (int k = 0; k < 2; ++k) \
        acc[ai][bj][m][n] = __builtin_amdgcn_mfma_f32_16x16x32_bf16(Bt[n][k], At[m][k], acc[ai][bj][m][n], 0, 0, 0); __builtin_amdgcn_s_setprio(0); } while (0)
#define PG8_WAIT_V(n) asm volatile("s_waitcnt vmcnt(" #n ")" ::: "memory")
#define PG8_WAIT_L(n) asm volatile("s_waitcnt lgkmcnt(" #n ")" ::: "memory")
#define PG8_BAR __builtin_amdgcn_s_barrier()
#define PG8_SCHED __builtin_amdgcn_sched_barrier(0)
    Unit cur, nxt; int ui = 0;
    if (!S.next(0, cur)) return;
    f32x4 acc[2][2][4][2];
#pragma unroll
    for (int a = 0; a < 2; ++a)
#pragma unroll
        for (int b = 0; b < 2; ++b)
#pragma unroll
            for (int m = 0; m < 4; ++m)
#pragma unroll
                for (int n = 0; n < 2; ++n) acc[a][b][m][n] = (f32x4){0.f, 0.f, 0.f, 0.f};
    bf16x8 At[4][2], B0[2][2], B1[2][2];
    const char* cA = (const char*)g.A + (size_t)cur.pm * tstep; const char* cB = (const char*)g.Bt + (size_t)cur.pn * tstep;
    S.a_ready(cur);
    if constexpr (SP2) {
        PG8_STAGE(PG8_SB(0, 0), cB, voffB); PG8_STAGE(PG8_SB(0, 1), cB + hstep, voffB); PG8_STAGE(PG8_SA(0, 0), cA, voffA); PG8_STAGE(PG8_SA(0, 1), cA + hstep, voffA);
        if (wr == 1) PG8_BAR;
        PG8_WAIT_V(2); PG8_BAR;
        PG8_STAGE(PG8_SB(1, 0), cB + kstep, voffB); PG8_STAGE(PG8_SA(1, 0), cA + kstep, voffA); PG8_STAGE(PG8_SB(1, 1), cB + hstep + kstep, voffB);
        PG8_WAIT_V(6); PG8_BAR;
    } else {
        PG8_STAGE(PG8_SB(0, 0), cB, voffB); PG8_STAGE(PG8_SA(0, 0), cA, voffA); PG8_STAGE(PG8_SB(0, 1), cB + hstep, voffB); PG8_STAGE(PG8_SA(0, 1), cA + hstep, voffA);
        if (wr == 1) PG8_BAR;
        PG8_WAIT_V(4); PG8_BAR;
        PG8_STAGE(PG8_SB(1, 0), cB + kstep, voffB); PG8_STAGE(PG8_SA(1, 0), cA + kstep, voffA); PG8_STAGE(PG8_SB(1, 1), cB + hstep + kstep, voffB);
        PG8_WAIT_V(6); PG8_BAR;
    }
    for (;;) {
        const bool has_next = S.next(ui + 1, nxt);
        const char* nA = has_next ? (const char*)g.A + (size_t)nxt.pm * tstep : cA; const char* nB = has_next ? (const char*)g.Bt + (size_t)nxt.pn * tstep : cB;
        for (int t = 0; t < nt; t += 2) {
            const bool last = (t == nt - 2);
            const char* a1 = cA + (size_t)(t + 1) * kstep;
            const char* a2 = last ? nA : cA + (size_t)(t + 2) * kstep; const char* b2 = last ? nB : cB + (size_t)(t + 2) * kstep;
            const char* a3 = a2 + kstep; const char* b3 = b2 + kstep;
            if (last && has_next) S.a_ready(nxt);
            if constexpr (SP2) {
            PG8_LDB(B0, 0, 0); PG8_LDB(B1, 0, 1); PG8_SCHED; PG8_LDA(At, 0, 0); PG8_STAGE(PG8_SA(1, 1), a1 + hstep, voffA);
            PG8_WAIT_V(8); PG8_WAIT_L(0); PG8_BAR; PG8_MMA(0, 0, At, B0); PG8_MMA(0, 1, At, B1); PG8_BAR; PG8_SCHED;
            PG8_LDA(At, 0, 1); PG8_STAGE(PG8_SB(0, 0), b2, voffB); PG8_STAGE(PG8_SB(0, 1), b2 + hstep, voffB); PG8_STAGE(PG8_SA(0, 0), a2, voffA);
            PG8_WAIT_V(8); PG8_WAIT_L(0); PG8_BAR; PG8_MMA(1, 0, At, B0); PG8_MMA(1, 1, At, B1); PG8_BAR; PG8_SCHED;
            PG8_LDB(B0, 1, 0); PG8_LDB(B1, 1, 1); PG8_SCHED; PG8_LDA(At, 1, 0); PG8_STAGE(PG8_SA(0, 1), a2 + hstep, voffA);
            PG8_WAIT_V(8); PG8_WAIT_L(0); PG8_BAR; PG8_MMA(0, 0, At, B0); PG8_MMA(0, 1, At, B1); PG8_BAR; PG8_SCHED;
            PG8_LDA(At, 1, 1); PG8_STAGE(PG8_SB(1, 0), b3, voffB); PG8_STAGE(PG8_SB(1, 1), b3 + hstep, voffB); PG8_STAGE(PG8_SA(1, 0), a3, voffA);
            PG8_WAIT_V(8); PG8_WAIT_L(0); PG8_BAR; PG8_MMA(1, 0, At, B0); PG8_MMA(1, 1, At, B1); PG8_BAR; PG8_SCHED;
            } else {
            PG8_LDB(B0, 0, 0); PG8_SCHED; PG8_LDA(At, 0, 0); PG8_STAGE(PG8_SA(1, 1), a1 + hstep, voffA);
            PG8_WAIT_L(8); PG8_BAR; PG8_WAIT_L(0); PG8_MMA(0, 0, At, B0); PG8_BAR; PG8_SCHED;
            PG8_LDB(B1, 0, 1); PG8_STAGE(PG8_SB(0, 0), b2, voffB);
            PG8_BAR; PG8_WAIT_L(0); PG8_MMA(0, 1, At, B1); PG8_BAR;
            PG8_LDA(At, 0, 1); PG8_STAGE(PG8_SA(0, 0), a2, voffA);
            PG8_BAR; PG8_WAIT_L(0); PG8_MMA(1, 0, At, B0); PG8_BAR; PG8_SCHED;
            PG8_STAGE(PG8_SB(0, 1), b2 + hstep, voffB);
            PG8_WAIT_V(6); PG8_BAR; PG8_MMA(1, 1, At, B1); PG8_BAR;
            PG8_LDB(B0, 1, 0); PG8_SCHED; PG8_LDA(At, 1, 0); PG8_STAGE(PG8_SA(0, 1), a2 + hstep, voffA);
            PG8_WAIT_L(8); PG8_BAR; PG8_WAIT_L(0); PG8_MMA(0, 0, At, B0); PG8_BAR; PG8_SCHED;
            PG8_LDB(B1, 1, 1); PG8_STAGE(PG8_SB(1, 0), b3, voffB);
            PG8_BAR; PG8_WAIT_L(0); PG8_MMA(0, 1, At, B1); PG8_BAR;
            PG8_LDA(At, 1, 1); PG8_STAGE(PG8_SA(1, 0), a3, voffA);
            PG8_BAR; PG8_WAIT_L(0); PG8_MMA(1, 0, At, B0); PG8_BAR; PG8_SCHED;
            PG8_STAGE(PG8_SB(1, 1), b3 + hstep, voffB);
            PG8_WAIT_V(6); PG8_BAR; PG8_MMA(1, 1, At, B1); PG8_BAR;
            }
        }
        if constexpr (ALIGN_EPI) { if (wr == 0) PG8_BAR; }
        if constexpr (!Epi::AFTER_DRAIN) { E(acc, cur, wr, wc, fr, fq); S.done(cur); }
        if (!has_next) break;
#pragma unroll
        for (int a = 0; a < 2; ++a)
#pragma unroll
            for (int b = 0; b < 2; ++b)
#pragma unroll
                for (int m = 0; m < 4; ++m)
#pragma unroll
                    for (int n = 0; n < 2; ++n) acc[a][b][m][n] = (f32x4){0.f, 0.f, 0.f, 0.f};
        cur = nxt; cA = nA; cB = nB; ++ui;
        if constexpr (ALIGN_EPI) { if (wr == 1) PG8_BAR; }
    }
    PG8_WAIT_V(0);
    if constexpr (!ALIGN_EPI) { if (wr == 0) PG8_BAR; }
    PG8_BAR;
    if constexpr (Epi::AFTER_DRAIN) { E.fused(acc, cur, wr, wc, fr, fq, lds, wid, lane); S.done(cur); }
#undef PG8_SA
#undef PG8_SB
#undef PG8_STAGE
#undef PG8_LDA
#undef PG8_LDB
#undef PG8_MMA
#undef PG8_WAIT_V
#undef PG8_WAIT_L
#undef PG8_BAR
#undef PG8_SCHED
}
}

constexpr int NWAVES = 8;
#ifndef MK_N_LAUNCHES
#define MK_N_LAUNCHES 1
#endif
constexpr int NPH = 12;
constexpr int N_LAUNCHES = MK_N_LAUNCHES;

constexpr int NB = 4, SEQ = 4096, D = 1024, T = NB * SEQ, CTXL = 256, TC = NB * CTXL, TA = T + TC;
constexpr int CC = 512, LW = 512, INC = 2048, NE = 32, NSLOT = 2 * T + NE * 256;
constexpr int NCH = 272;
constexpr float EPS = 1e-6f;

constexpr size_t MiB = 1u << 20;
constexpr size_t WS_CTL = 0, CTL_ZERO_BYTES = 64 * 1024;
constexpr size_t WS_MOD = 1 * MiB;
constexpr size_t WS_RWH = WS_MOD + 128 * 1024;
constexpr size_t WS_RWL = WS_RWH + 96 * 1024;
constexpr size_t WS_RB = WS_RWL + 96 * 1024;
constexpr size_t WS_WG = 2 * MiB;
constexpr size_t WS_WIN = 3 * MiB;
constexpr size_t WS_WOUT = 7 * MiB;
constexpr size_t WS_AGG = 464 * MiB;
constexpr size_t WS_CARRY = 474 * MiB;
constexpr size_t WS_ROUTE = 13 * MiB;
constexpr size_t WS_RG = WS_ROUTE + 256 * 1024;
constexpr size_t WS_SLOT = WS_RG + 128 * 1024;
constexpr size_t WS_GATE = WS_SLOT + 128 * 1024;
constexpr size_t WS_W13 = 16 * MiB;
constexpr size_t WS_W2 = 144 * MiB;
constexpr size_t WS_RA = 208 * MiB;
constexpr size_t WS_RBB = 288 * MiB;
constexpr size_t WS_RC = 368 * MiB;
constexpr size_t WS_END = 480 * MiB;
static_assert((size_t)NSLOT * 1024 * 2 <= 80 * MiB && (size_t)TA * 2048 * 2 <= 80 * MiB && WS_GATE + (size_t)NSLOT * 4 <= WS_W13, "ws map");
constexpr int CW_CNT = 64;
constexpr int CW_BAR = 1024;

constexpr int RING_OFF = 0, RING_BYTES = 131072;
constexpr int SCR_BYTES = 147456;
constexpr int MISC_OFF = SCR_BYTES;
constexpr int LDS_BYTES = SCR_BYTES + 2048;
#define GAS __attribute__((address_space(1)))
#define LAS __attribute__((address_space(3)))
typedef unsigned short bf16;
typedef unsigned v4u __attribute__((ext_vector_type(4)));
typedef float f32x4 __attribute__((ext_vector_type(4)));
typedef short bf16x8 __attribute__((ext_vector_type(8)));
typedef GAS unsigned gu32;
typedef GAS unsigned long long gu64;
#define RLX_AGENT __ATOMIC_RELAXED, __HIP_MEMORY_SCOPE_AGENT
#define LDS_WAIT() asm volatile("s_waitcnt lgkmcnt(0)" ::: "memory")
#define VM_WAIT() asm volatile("s_waitcnt vmcnt(0)" ::: "memory")
__device__ __forceinline__ unsigned long long rt() { return __builtin_amdgcn_s_memrealtime(); }
__device__ __forceinline__ unsigned f2bf(float f) { unsigned u = __builtin_bit_cast(unsigned, f); return (u + 0x7fffu + ((u >> 16) & 1u)) >> 16; }
__device__ __forceinline__ unsigned pk2(float lo, float hi) { return f2bf(lo) | (f2bf(hi) << 16); }

#define XB_TMO      128
#define XB_XCNT(j)  (256  + 64 * (j))
#define XB_XSUB(j)  (1280 + 64 * (j))
#define XB_XGEN(j)  (2304 + 64 * (j))
#define XB_TOP      3328
#define XB_TOPGEN   3392
#define XCD_BAR_WORDS 3456
#define XB_SPIN_CAP (1u << 18)

__device__ __forceinline__ unsigned xb_ld(unsigned* p)              { return __hip_atomic_load(p, __ATOMIC_RELAXED, __HIP_MEMORY_SCOPE_AGENT); }
__device__ __forceinline__ unsigned xb_add(unsigned* p, unsigned v) { return __hip_atomic_fetch_add(p, v, __ATOMIC_RELAXED, __HIP_MEMORY_SCOPE_AGENT); }
__device__ __forceinline__ unsigned xb_xcc_id() { return (unsigned)__builtin_amdgcn_s_getreg((3 << 11) | 20) & 0xFu; }
#define XB_SPIN(cond, bar) do { unsigned _sp = 0; while (cond) { __builtin_amdgcn_s_sleep(1); \
    if ((++_sp & 255u) == 0u) { if (xb_ld(&(bar)[XB_TMO])) break; if (_sp > XB_SPIN_CAP) { atomicAdd(&(bar)[XB_TMO], 1u); break; } } } } while (0)

struct XcdBarrier {
    unsigned* bar; unsigned x;
    volatile LAS unsigned* st;
};

__device__ __forceinline__ XcdBarrier xcd_barrier_post(unsigned* bar, volatile LAS unsigned* st) {
    XcdBarrier b; b.bar = bar; b.x = xb_xcc_id(); b.st = st;
    if (threadIdx.x == 0) (void)xb_add(&bar[XB_XCNT(b.x)], 1u);
    return b;
}
__device__ __forceinline__ void xcd_barrier_complete(unsigned* bar, unsigned x, unsigned& nloc, unsigned& nx) {
    const unsigned G = gridDim.x * gridDim.y * gridDim.z;
    unsigned sum, cnt, mine, sp = 0u;
    for (;;) {
        sum = 0u; cnt = 0u; mine = 0u;
#pragma unroll
        for (unsigned j = 0; j < 16; ++j) { const unsigned c = xb_ld(&bar[XB_XCNT(j)]); sum += c; cnt += (c > 0u) ? 1u : 0u; mine = (j == x) ? c : mine; }
        if (sum == G) break;
        __builtin_amdgcn_s_sleep(1);
        if ((++sp & 255u) == 0u) { if (xb_ld(&bar[XB_TMO])) break; if (sp > XB_SPIN_CAP) { atomicAdd(&bar[XB_TMO], 1u); break; } }
    }
    nloc = mine > 0u ? mine : 1u; nx = cnt > 0u ? cnt : 1u;
}

__device__ __forceinline__ void xcd_barrier(const XcdBarrier& b) {
    asm volatile("s_waitcnt vmcnt(0)" ::: "memory");
    __syncthreads();
    if (threadIdx.x == 0) {
        unsigned* bar = b.bar;
        __builtin_amdgcn_s_waitcnt(0);
        unsigned nloc = b.st[0], nx = b.st[1];
        if (nloc == 0u) { xcd_barrier_complete(bar, b.x, nloc, nx); b.st[0] = nloc; b.st[1] = nx; }
        const unsigned old = xb_add(&bar[XB_XSUB(b.x)], 1u);
        const unsigned gen = old / nloc;
        if (old + 1u == (gen + 1u) * nloc) {
            __builtin_amdgcn_fence(__ATOMIC_RELEASE, "agent");
            asm volatile("s_waitcnt vmcnt(0)" ::: "memory");
            const unsigned og = xb_add(&bar[XB_TOP], 1u);
            const unsigned tg = og / nx;
            if (og + 1u == (tg + 1u) * nx) xb_add(&bar[XB_TOPGEN], 1u);
            else XB_SPIN(xb_ld(&bar[XB_TOPGEN]) == tg, bar);
            __builtin_amdgcn_fence(__ATOMIC_ACQUIRE, "agent");
            xb_add(&bar[XB_XGEN(b.x)], 1u);
            asm volatile("s_waitcnt vmcnt(0)" ::: "memory");
        } else {
            XB_SPIN(xb_ld(&bar[XB_XGEN(b.x)]) == gen, bar);
            __builtin_amdgcn_fence(__ATOMIC_ACQUIRE, "agent");
            asm volatile("s_waitcnt vmcnt(0)" ::: "memory");
        }
    }
    __syncthreads();
}

typedef float f32x2v __attribute__((ext_vector_type(2)));
typedef unsigned u32x2v __attribute__((ext_vector_type(2)));
typedef int i32x4v __attribute__((ext_vector_type(4)));
typedef int i32x2v __attribute__((ext_vector_type(2)));
__device__ __forceinline__ float wave_sum(float v) {
#pragma unroll
    for (int o = 1; o < 64; o <<= 1) v += __shfl_xor(v, o);
    return v;
}
__device__ __forceinline__ float bf2f(unsigned short h) { return __builtin_bit_cast(float, (unsigned)h << 16); }
__device__ __forceinline__ float bflo(unsigned w) { return __builtin_bit_cast(float, w << 16); }
__device__ __forceinline__ float bfhi(unsigned w) { return __builtin_bit_cast(float, w & 0xffff0000u); }
__device__ __forceinline__ float sigmoid_f(float v) { return __builtin_amdgcn_rcpf(1.0f + __expf(-v)); }
__device__ __forceinline__ float silu_ff(float v) { return v * __builtin_amdgcn_rcpf(1.0f + __expf(-v)); }
__device__ __forceinline__ float gelu_tanh_f(float v) { const float y = 1.5957691216057308f * (v + 0.044715f * v * v * v); return v * __builtin_amdgcn_rcpf(1.0f + __expf(-y)); }

__device__ __forceinline__ void p0_transpose_item(const float* W, int K, int N, bf16* WT, int row_off, int rmul, LAS float* scr, int item, int lane) {
    const int nblk = N / 64, kb = item / nblk, nb = item % nblk, k0 = 64 * kb, n0 = 64 * nb;
    const int r4 = lane >> 4, q = lane & 15;
    f32x4 v[16];
#pragma unroll
    for (int i = 0; i < 16; ++i) v[i] = *(const f32x4*)(W + (size_t)(k0 + 4 * i + r4) * N + n0 + 4 * q);
#pragma unroll
    for (int i = 0; i < 16; ++i) { LAS float* d = scr + (4 * i + r4) * 65 + 4 * q; d[0] = v[i].x; d[1] = v[i].y; d[2] = v[i].z; d[3] = v[i].w; }
    LDS_WAIT(); asm volatile("" ::: "memory");
    const int c = lane & 7;
#pragma unroll
    for (int j = 0; j < 8; ++j) { const int n = (lane >> 3) + 8 * j; const LAS float* s = scr + (8 * c) * 65 + n;
        v4u o; o.x = pk2(s[0 * 65], s[1 * 65]); o.y = pk2(s[2 * 65], s[3 * 65]); o.z = pk2(s[4 * 65], s[5 * 65]); o.w = pk2(s[6 * 65], s[7 * 65]);
        *(v4u*)(WT + (size_t)(row_off + rmul * (n0 + n)) * K + k0 + 8 * c) = o; }
    LDS_WAIT(); asm volatile("" ::: "memory");
}

struct Ptrs {
    const float* in[29]; float* out; unsigned char* ws;
};

__device__ __forceinline__ void phase_p0a(const Ptrs& P, LAS unsigned char* lds, int tid, int lane, int wave, int vcu, int G) {
    {
        const float* c = P.in[1]; const float* c_ctx = P.in[3]; const float* w_ada = P.in[4]; const float* b_ada = P.in[5];
        float* MOD = (float*)(P.ws + WS_MOD);
        LAS float* red = (LAS float*)lds;
        const int r4 = lane >> 4, q = lane & 15;
        for (int cb = vcu; cb < 96; cb += G) {
            f32x4 acc[5];
#pragma unroll
            for (int r = 0; r < 5; ++r) acc[r] = (f32x4){0.f, 0.f, 0.f, 0.f};
#pragma unroll 8
            for (int i = 0; i < 32; ++i) {
                const int k = wave * 128 + 4 * i + r4;
                const f32x4 w = *(const f32x4*)(w_ada + (size_t)k * 6144 + 64 * cb + 4 * q);
#pragma unroll
                for (int r = 0; r < 5; ++r) { const float sv = silu_ff(r < 4 ? c[r * 1024 + k] : c_ctx[k]); acc[r] += w * sv; }
            }
#pragma unroll
            for (int r = 0; r < 5; ++r) {
#pragma unroll
                for (int e = 0; e < 4; ++e) { float t = acc[r][e]; t += __shfl_xor(t, 16); t += __shfl_xor(t, 32); acc[r][e] = t; }
                if (r4 == 0) *(LAS f32x4*)(red + (wave * 5 + r) * 64 + 4 * q) = acc[r];
            }
            __syncthreads();
            if (tid < 320) { const int r = tid >> 6, cc = tid & 63; float sm = 0.f;
#pragma unroll
                for (int w8 = 0; w8 < 8; ++w8) sm += red[(w8 * 5 + r) * 64 + cc];
                MOD[r * 6144 + 64 * cb + cc] = sm + b_ada[64 * cb + cc]; }
            __syncthreads();
        }
    }
    {
        bf16* RWH = (bf16*)(P.ws + WS_RWH); bf16* RWL = (bf16*)(P.ws + WS_RWL); float* RB = (float*)(P.ws + WS_RB);
        const float* wg = P.in[21]; const float* bg = P.in[22]; const float* we = P.in[23]; const float* be = P.in[24];
        for (int i = vcu * 512 + tid; i < 48 * 1024; i += G * 512) { const int n = i >> 10, k = i & 1023;
            const float w = n < 4 ? wg[k * 4 + n] : (n < 36 ? we[k * 32 + n - 4] : 0.f);
            const unsigned hi = f2bf(w); const float lo = w - __builtin_bit_cast(float, hi << 16);
            RWH[i] = (bf16)hi; RWL[i] = (bf16)f2bf(lo); }
        if (vcu == 0 && tid < 48) RB[tid] = tid < 4 ? bg[tid] : (tid < 36 ? be[tid - 4] : 0.f);
    }
    {
        LAS float* scr = (LAS float*)(lds + wave * 16640);
        const int gw = vcu * NWAVES + wave, NGW = G * NWAVES;
        bf16* WIN = (bf16*)(P.ws + WS_WIN); bf16* WOUT = (bf16*)(P.ws + WS_WOUT); bf16* WG = (bf16*)(P.ws + WS_WG); bf16* W13 = (bf16*)(P.ws + WS_W13); bf16* W2 = (bf16*)(P.ws + WS_W2);
        constexpr int I_IN = 16 * 32, I_OUT = 16 * 16, I_G = 32, I_E = 32 * 256;
        constexpr int NITEMS = I_IN + I_OUT + I_G + 3 * I_E;
        for (int it = gw; it < NITEMS; it += NGW) {
            int r = it;
            if (r < I_E) { const int e = r >> 8; p0_transpose_item(P.in[25] + (size_t)e * 1048576, 1024, 1024, W13, e * 2048, 2, scr, r & 255, lane); continue; } r -= I_E;
            if (r < I_E) { const int e = r >> 8; p0_transpose_item(P.in[26] + (size_t)e * 1048576, 1024, 1024, W13, e * 2048 + 1, 2, scr, r & 255, lane); continue; } r -= I_E;
            if (r < I_E) { const int e = r >> 8; p0_transpose_item(P.in[27] + (size_t)e * 1048576, 1024, 1024, W2, e * 1024, 1, scr, r & 255, lane); continue; } r -= I_E;
            if (r < I_IN) { p0_transpose_item(P.in[8], 1024, 2048, WIN, 0, 1, scr, r, lane); continue; } r -= I_IN;
            if (r < I_OUT) { p0_transpose_item(P.in[20], 1024, 1024, WOUT, 0, 1, scr, r, lane); continue; } r -= I_OUT;
            { const int which = r >> 4, mtx = r & 15;
                p0_transpose_item((which ? P.in[17] : P.in[15]) + mtx * 4096, 64, 64, WG, mtx * 128 + which * 64, 1, scr, 0, lane); }
        }
    }
}

__device__ __forceinline__ void phase_p0b(const Ptrs& P, int lane, int wave, int vcu, int G) {
    const float* MOD = (const float*)(P.ws + WS_MOD); const float* g1n = P.in[6];
    bf16* XN = (bf16*)(P.ws + WS_RA);
    const int gw = vcu * NWAVES + wave, NGW = G * NWAVES;
    for (int m = gw; m < TA; m += NGW) {
        const float* src; int mr;
        if (m < T) { src = P.in[0] + (size_t)m * D; mr = m >> 12; } else { src = P.in[2] + (size_t)(m - T) * D; mr = 4; }
        const f32x4* xr = (const f32x4*)src + lane;
        f32x4 v[4]; float s = 0.f;
#pragma unroll
        for (int j = 0; j < 4; ++j) { v[j] = xr[64 * j]; s += (v[j].x * v[j].x + v[j].y * v[j].y) + (v[j].z * v[j].z + v[j].w * v[j].w); }
        const float rstd = 1.0f / sqrtf(wave_sum(s) * (1.f / D) + EPS);
        const f32x4* gp = (const f32x4*)g1n + lane; const f32x4* shp = (const f32x4*)(MOD + mr * 6144) + lane; const f32x4* scp = (const f32x4*)(MOD + mr * 6144 + 1024) + lane;
        unsigned long long* o8 = (unsigned long long*)(XN + (size_t)m * D) + lane;
#pragma unroll
        for (int j = 0; j < 4; ++j) { const f32x4 g = gp[64 * j], sh = shp[64 * j], sc = scp[64 * j];
            const f32x4 y = v[j] * rstd * g * (sc + 1.0f) + sh;
            o8[64 * j] = (unsigned long long)pk2(y.x, y.y) | ((unsigned long long)pk2(y.z, y.w) << 32); }
    }
}

constexpr int WL_UB = 0;
constexpr int WL_UF = 2304;
constexpr int WL_AB = 6400;
constexpr int WL_BYTES = 14592;
template <bool FINAL, int DIR>
__device__ __forceinline__ void lru_wave_sweep(const Ptrs& P, LAS unsigned char* wl, int gw, int NGW, int lane) {
    const bf16* ZL = (const bf16*)(P.ws + WS_RBB);
    const bf16* WG = (const bf16*)(P.ws + WS_WG);
    float* HF = (float*)(P.ws + WS_RA + 32 * MiB);
    LAS bf16* ub = (LAS bf16*)(wl + WL_UB); LAS float* uf = (LAS float*)(wl + WL_UF); LAS float* ab = (LAS float*)(wl + WL_AB);
    const int h = gw & 7, l15 = lane & 15, q = lane >> 4;
    float cba[4], cbx[4], csp[4];
    bf16x8 br[4][2], bi[4][2];
#pragma unroll
    for (int nt = 0; nt < 4; ++nt) { const int ch = DIR * 512 + 64 * h + 16 * nt + l15; cba[nt] = P.in[16][ch]; cbx[nt] = P.in[18][ch]; csp[nt] = -8.0f * log1pf(expf(-P.in[19][ch]));
        const bf16* wr = WG + (size_t)(((DIR * 8 + h) * 128 + 16 * nt + l15) * 64 + 8 * q);
        br[nt][0] = *(const bf16x8*)(wr); br[nt][1] = *(const bf16x8*)(wr + 32); bi[nt][0] = *(const bf16x8*)(wr + 64 * 64); bi[nt][1] = *(const bf16x8*)(wr + 64 * 64 + 32); }
    const int chl = 64 * h + lane;
    const float w0 = P.in[13][chl], w1 = P.in[13][512 + chl], w2 = P.in[13][1024 + chl], w3 = P.in[13][1536 + chl], cb = P.in[14][chl];
    const int nitems = FINAL ? NB * 256 * 8 : NB * NCH * 8;
    for (int it = gw; it < nitems; it += NGW) {
        const int bc = it >> 3;
        int b, chunk;
        if (FINAL) { b = bc >> 8; chunk = 16 + (bc & 255); } else { b = bc / NCH; chunk = bc % NCH; }
        const bool isctx = chunk < 16;
        const int seq_row0 = isctx ? (T + b * CTXL) : (b * SEQ), seq_len = isctx ? CTXL : SEQ, t0 = (isctx ? chunk : chunk - 16) * 16;
        float x[19];
#pragma unroll
        for (int r = 0; r < 19; ++r) { const int tt = t0 + r - 2; const int tc = tt < 0 ? 0 : (tt >= seq_len ? seq_len - 1 : tt);
            const float v = bf2f(ZL[(size_t)(seq_row0 + tc) * INC + 1024 + chl]); x[r] = (tt == tc) ? v : 0.f; }
        unsigned short zg[16]; float hf[16]; float cin = 0.f;
        if (FINAL) {
            const float* CARRY = (const float*)(P.ws + WS_CARRY);
            cin = CARRY[(size_t)((b * 256 + (chunk - 16)) * 2 + DIR) * 512 + chl];
            if (DIR == 1) {
#pragma unroll
                for (int t = 0; t < 16; ++t) { zg[t] = ZL[(size_t)(seq_row0 + t0 + t) * INC + 1536 + chl]; hf[t] = HF[(size_t)(b * SEQ + t0 + t) * 512 + chl]; }
            }
        }
#pragma unroll
        for (int t = 0; t < 16; ++t) { const float u = cb + w0 * x[t] + w1 * x[t + 1] + w2 * x[t + 2] + w3 * x[t + 3]; ub[t * 72 + lane] = (bf16)f2bf(u); uf[t * 64 + lane] = u; }
        asm volatile("" ::: "memory");
        bf16x8 af[2];
#pragma unroll
        for (int ks = 0; ks < 2; ++ks) af[ks] = *(const LAS bf16x8*)(ub + l15 * 72 + 32 * ks + 8 * q);
        f32x4 ar[4], ai[4];
#pragma unroll
        for (int nt = 0; nt < 4; ++nt) {
            f32x4 z = {0.f, 0.f, 0.f, 0.f};
            ar[nt] = __builtin_amdgcn_mfma_f32_16x16x32_bf16(af[0], br[nt][0], z, 0, 0, 0); ar[nt] = __builtin_amdgcn_mfma_f32_16x16x32_bf16(af[1], br[nt][1], ar[nt], 0, 0, 0);
            ai[nt] = __builtin_amdgcn_mfma_f32_16x16x32_bf16(af[0], bi[nt][0], z, 0, 0, 0); ai[nt] = __builtin_amdgcn_mfma_f32_16x16x32_bf16(af[1], bi[nt][1], ai[nt], 0, 0, 0);
        }
#pragma unroll
        for (int nt = 0; nt < 4; ++nt)
#pragma unroll
            for (int rg = 0; rg < 4; ++rg) {
                const int t = 4 * q + rg, cl = 16 * nt + l15;
                const float r = sigmoid_f(ar[nt][rg] + cba[nt]), ig = sigmoid_f(ai[nt][rg] + cbx[nt]);
                const float la = csp[nt] * r;
                const float a = __expf(la);
                const float x2 = 2.0f * la;
                const float em = x2 * (1.0f + x2 * (0.5f + x2 * (0.16666667f + x2 * (0.041666668f + x2 * (0.0083333338f + x2 * (0.0013888889f + x2 * 0.0001984127f))))));
                const float mult = __builtin_amdgcn_sqrtf(fmaxf(-em, 1e-12f));
                ab[t * 64 + cl] = a; ab[(16 + t) * 64 + cl] = mult * ig * uf[t * 64 + cl];
            }
        asm volatile("" ::: "memory");
        if (!FINAL) {
            float Pp = 1.f, Hh = 0.f;
#pragma unroll
            for (int i = 0; i < 16; ++i) { const int t = DIR ? 15 - i : i; const float a = ab[t * 64 + lane], bq = ab[(16 + t) * 64 + lane]; Hh = a * Hh + bq; Pp *= a; }
            float* AGG = (float*)(P.ws + WS_AGG);
            *(f32x2v*)(AGG + ((size_t)((b * NCH + chunk) * 2 + DIR) * 512 + chl) * 2) = (f32x2v){Pp, Hh};
        } else {
            float hh = cin; float hs[16];
#pragma unroll
            for (int i = 0; i < 16; ++i) { const int t = DIR ? 15 - i : i; const float a = ab[t * 64 + lane], bq = ab[(16 + t) * 64 + lane]; hh = a * hh + bq; hs[t] = hh; }
            if (DIR == 0) {
#pragma unroll
                for (int t = 0; t < 16; ++t) HF[(size_t)(b * SEQ + t0 + t) * 512 + chl] = hs[t];
            } else {
                bf16* MIX = (bf16*)(P.ws + WS_RC);
#pragma unroll
                for (int t = 0; t < 16; ++t) MIX[(size_t)(b * SEQ + t0 + t) * D + 512 + chl] = (bf16)f2bf((hs[t] + hf[t]) * gelu_tanh_f(bf2f(zg[t])));
            }
        }
        asm volatile("" ::: "memory");
    }
}
template <bool FINAL>
__device__ __forceinline__ void lru_wave_items(const Ptrs& P, LAS unsigned char* wl, int gw, int NGW, int lane) {
    lru_wave_sweep<FINAL, 0>(P, wl, gw, NGW, lane);
    if (FINAL) asm volatile("s_waitcnt vmcnt(0)" ::: "memory");
    lru_wave_sweep<FINAL, 1>(P, wl, gw, NGW, lane);
}

template <int T0> __device__ __forceinline__ void conv_rows8(const float (&uu)[64], const float (&w)[31], float cb, float* dst) {
#pragma unroll
    for (int tt = 0; tt < 8; ++tt) {
        float acc = cb;
#pragma unroll
        for (int j = 0; j < 31; ++j) { const int s = T0 + tt + j - 15; if (s >= 0 && s < 64) acc += w[j] * uu[s]; }
        dst[(size_t)(T0 + tt) * 512] = acc;
    }
}
__device__ __forceinline__ void conv_wave_items(const Ptrs& P, int gw, int NGW, int lane) {
    const bf16* ZL = (const bf16*)(P.ws + WS_RBB); float* CV = (float*)(P.ws + WS_RA);
    for (int it = gw; it < NB * 64 * 8; it += NGW) {
        const int s = it >> 3, c = 64 * (it & 7) + lane;
        const bf16* base = ZL + (size_t)(s * 64) * INC + c;
        float uu[64];
#pragma unroll
        for (int t = 0; t < 64; ++t) { const float val = bf2f(base[(size_t)t * INC]), gt = bf2f(base[(size_t)t * INC + 512]); uu[t] = val * sigmoid_f(gt); }
        float w[31];
#pragma unroll
        for (int j = 0; j < 31; ++j) w[j] = P.in[9][j * 512 + c];
        const float cb = P.in[10][c];
        float* dst = CV + (size_t)(s * 64) * 512 + c;
        conv_rows8<0>(uu, w, cb, dst); conv_rows8<8>(uu, w, cb, dst); conv_rows8<16>(uu, w, cb, dst); conv_rows8<24>(uu, w, cb, dst);
        conv_rows8<32>(uu, w, cb, dst); conv_rows8<40>(uu, w, cb, dst); conv_rows8<48>(uu, w, cb, dst); conv_rows8<56>(uu, w, cb, dst);
    }
}
__device__ __forceinline__ void convln_wave_items(const Ptrs& P, int gw, int NGW, int lane) {
    const float* CV = (const float*)(P.ws + WS_RA); bf16* MIX = (bf16*)(P.ws + WS_RC);
    const f32x4 g0 = *(const f32x4*)(P.in[11] + 8 * lane), g1 = *(const f32x4*)(P.in[11] + 8 * lane + 4);
    const f32x4 b0 = *(const f32x4*)(P.in[12] + 8 * lane), b1 = *(const f32x4*)(P.in[12] + 8 * lane + 4);
    for (int tok = gw; tok < T; tok += NGW) {
        f32x4 v0 = *(const f32x4*)(CV + (size_t)tok * 512 + 8 * lane), v1 = *(const f32x4*)(CV + (size_t)tok * 512 + 8 * lane + 4);
        const float mu = wave_sum((v0.x + v0.y) + (v0.z + v0.w) + (v1.x + v1.y) + (v1.z + v1.w)) * (1.f / 512.f);
        v0 = v0 - mu; v1 = v1 - mu;
        const float var = wave_sum((v0.x * v0.x + v0.y * v0.y) + (v0.z * v0.z + v0.w * v0.w) + (v1.x * v1.x + v1.y * v1.y) + (v1.z * v1.z + v1.w * v1.w)) * (1.f / 512.f);
        const float rstd = 1.0f / sqrtf(var + EPS);
        const f32x4 y0 = v0 * rstd * g0 + b0, y1 = v1 * rstd * g1 + b1;
        v4u o; o.x = pk2(silu_ff(y0.x), silu_ff(y0.y)); o.y = pk2(silu_ff(y0.z), silu_ff(y0.w)); o.z = pk2(silu_ff(y1.x), silu_ff(y1.y)); o.w = pk2(silu_ff(y1.z), silu_ff(y1.w));
        *(v4u*)(MIX + (size_t)tok * D + 8 * lane) = o;
    }
}

#ifdef PROBE_LO
#define SUBSTAMP(k) do { if (blockIdx.x == 0 && tid == 0) ((volatile LAS unsigned*)(lds + MISC_OFF))[256 + (k)] = (unsigned)__builtin_amdgcn_s_memrealtime(); } while (0)
#else
#define SUBSTAMP(k) do {} while (0)
#endif
__device__ __forceinline__ void phase_p2a(const Ptrs& P, LAS unsigned char* lds, int tid, int lane, int wave, int vcu, int G) {
    const int gw = vcu * NWAVES + wave, NGW = G * NWAVES;
    SUBSTAMP(20);
    lru_wave_items<false>(P, lds + wave * WL_BYTES, gw, NGW, lane);
    SUBSTAMP(21);
    conv_wave_items(P, gw, NGW, lane);
    SUBSTAMP(22);
}
__device__ __forceinline__ void phase_p2b(const Ptrs& P, LAS unsigned char* lds, int tid, int vcu, int G) {
    const float* AGG = (const float*)(P.ws + WS_AGG); float* CARRY = (float*)(P.ws + WS_CARRY);
    LAS float* SEGP = (LAS float*)lds;
    for (int item = vcu; item < NB * 2 * 16; item += G) {
        const int b = item >> 5, d = (item >> 4) & 1, cl = tid & 31, ch = 32 * (item & 15) + cl, seg = tid >> 5;
        float A[17], Bv[17];
#pragma unroll
        for (int i = 0; i < 17; ++i) { const int j = 17 * seg + i; const int chunk = d ? (j < 16 ? 15 - j : 287 - j) : j;
            const f32x2v abv = *(const f32x2v*)(AGG + ((size_t)((b * NCH + chunk) * 2 + d) * 512 + ch) * 2); A[i] = abv.x; Bv[i] = abv.y; }
        float Pp = 1.f, Hh = 0.f;
#pragma unroll
        for (int i = 0; i < 17; ++i) { Hh = A[i] * Hh + Bv[i]; Pp *= A[i]; }
        SEGP[(seg * 32 + cl) * 2] = Pp; SEGP[(seg * 32 + cl) * 2 + 1] = Hh;
        __syncthreads();
        float hh = 0.f;
        for (int sg = 0; sg < seg; ++sg) hh = SEGP[(sg * 32 + cl) * 2] * hh + SEGP[(sg * 32 + cl) * 2 + 1];
#pragma unroll
        for (int i = 0; i < 17; ++i) { const int j = 17 * seg + i; const int chunk = d ? (j < 16 ? 15 - j : 287 - j) : j;
            if (chunk >= 16) CARRY[(size_t)((b * 256 + chunk - 16) * 2 + d) * 512 + ch] = hh;
            hh = A[i] * hh + Bv[i]; }
        __syncthreads();
    }
}
__device__ __forceinline__ void phase_p2c(const Ptrs& P, LAS unsigned char* lds, int tid, int lane, int wave, int vcu, int G) {
    const int gw = vcu * NWAVES + wave, NGW = G * NWAVES;
    SUBSTAMP(24);
    lru_wave_items<true>(P, lds + wave * WL_BYTES, gw, NGW, lane);
    SUBSTAMP(25);
    convln_wave_items(P, gw, NGW, lane);
    SUBSTAMP(26);
}

constexpr int L_AH = 0, L_AL = 66048, HL_PITCH = 2064;
constexpr int L_PART = 0;
constexpr int L_LG = 132096;
constexpr int L_LCNT = 138240;
constexpr int L_LBASE = 138368;
__device__ __forceinline__ void phase_p4a(const Ptrs& P, LAS unsigned char* lds, int tid, int lane, int wave, int vcu, int G) {
    const float* MOD = (const float*)(P.ws + WS_MOD); const float* g2n = P.in[7];
    const bf16* RWH = (const bf16*)(P.ws + WS_RWH); const bf16* RWL = (const bf16*)(P.ws + WS_RWL); const float* RB = (const float*)(P.ws + WS_RB);
    bf16* H2 = (bf16*)(P.ws + WS_RC + 32 * MiB);
    unsigned* gcnt = (unsigned*)(P.ws + WS_CTL) + CW_CNT;
    LAS float* lg = (LAS float*)(lds + L_LG); LAS int* lcnt = (LAS int*)(lds + L_LCNT); LAS int* lbase = (LAS int*)(lds + L_LBASE); LAS float* part = (LAS float*)(lds + L_PART);
    const int l15 = lane & 15, l4 = lane >> 4;
    for (int it = vcu; it < T / 32; it += G) {
        if (tid < 32) lcnt[tid] = 0;
        for (int i = 0; i < 4; ++i) {
            const int tl = wave * 4 + i, tok = it * 32 + tl, mr = tok >> 12;
            const f32x4* xr = (const f32x4*)(P.out + (size_t)tok * D) + lane;
            f32x4 v[4]; float s = 0.f;
#pragma unroll
            for (int j = 0; j < 4; ++j) { v[j] = xr[64 * j]; s += (v[j].x * v[j].x + v[j].y * v[j].y) + (v[j].z * v[j].z + v[j].w * v[j].w); }
            const float rstd = 1.0f / sqrtf(wave_sum(s) * (1.f / D) + EPS);
            const f32x4* gp = (const f32x4*)g2n + lane; const f32x4* shp = (const f32x4*)(MOD + mr * 6144 + 3072) + lane; const f32x4* scp = (const f32x4*)(MOD + mr * 6144 + 4096) + lane;
            unsigned long long* o8 = (unsigned long long*)(H2 + (size_t)tok * D) + lane;
#pragma unroll
            for (int j = 0; j < 4; ++j) { const f32x4 g = gp[64 * j], sh = shp[64 * j], sc = scp[64 * j];
                const f32x4 y = v[j] * rstd * g * (sc + 1.0f) + sh;
                const unsigned h0 = f2bf(y.x), h1 = f2bf(y.y), h2_ = f2bf(y.z), h3 = f2bf(y.w);
                const unsigned long long pk = (unsigned long long)(h0 | (h1 << 16)) | ((unsigned long long)(h2_ | (h3 << 16)) << 32);
                const unsigned long long pl = (unsigned long long)pk2(y.x - __builtin_bit_cast(float, h0 << 16), y.y - __builtin_bit_cast(float, h1 << 16)) |
                                              ((unsigned long long)pk2(y.z - __builtin_bit_cast(float, h2_ << 16), y.w - __builtin_bit_cast(float, h3 << 16)) << 32);
                o8[64 * j] = pk;
                *(LAS unsigned long long*)(lds + L_AH + tl * HL_PITCH + (lane + 64 * j) * 8) = pk;
                *(LAS unsigned long long*)(lds + L_AL + tl * HL_PITCH + (lane + 64 * j) * 8) = pl; }
        }
        __syncthreads();
        {
            f32x4 acc[2][3];
#pragma unroll
            for (int mt = 0; mt < 2; ++mt)
#pragma unroll
                for (int nt = 0; nt < 3; ++nt) acc[mt][nt] = (f32x4){0.f, 0.f, 0.f, 0.f};
#pragma unroll
            for (int kq = 0; kq < 4; ++kq) {
                const int kof = 32 * (4 * wave + kq) + 8 * l4;
                bf16x8 ah[2], al[2], bh[3], bl[3];
#pragma unroll
                for (int nt = 0; nt < 3; ++nt) { bh[nt] = *(const bf16x8*)(RWH + (size_t)(16 * nt + l15) * 1024 + kof); bl[nt] = *(const bf16x8*)(RWL + (size_t)(16 * nt + l15) * 1024 + kof); }
#pragma unroll
                for (int mt = 0; mt < 2; ++mt) { ah[mt] = *(const LAS bf16x8*)(lds + L_AH + (16 * mt + l15) * HL_PITCH + kof * 2); al[mt] = *(const LAS bf16x8*)(lds + L_AL + (16 * mt + l15) * HL_PITCH + kof * 2); }
#pragma unroll
                for (int mt = 0; mt < 2; ++mt)
#pragma unroll
                    for (int nt = 0; nt < 3; ++nt) {
                        acc[mt][nt] = __builtin_amdgcn_mfma_f32_16x16x32_bf16(al[mt], bh[nt], acc[mt][nt], 0, 0, 0);
                        acc[mt][nt] = __builtin_amdgcn_mfma_f32_16x16x32_bf16(ah[mt], bl[nt], acc[mt][nt], 0, 0, 0);
                        acc[mt][nt] = __builtin_amdgcn_mfma_f32_16x16x32_bf16(ah[mt], bh[nt], acc[mt][nt], 0, 0, 0); }
            }
            __syncthreads();
#pragma unroll
            for (int mt = 0; mt < 2; ++mt)
#pragma unroll
                for (int nt = 0; nt < 3; ++nt)
#pragma unroll
                    for (int rg = 0; rg < 4; ++rg) part[(wave * 32 + 16 * mt + 4 * l4 + rg) * 48 + 16 * nt + l15] = acc[mt][nt][rg];
        }
        __syncthreads();
        for (int o = tid; o < 32 * 48; o += 512) { float sm = 0.f;
#pragma unroll
            for (int w8 = 0; w8 < 8; ++w8) sm += part[w8 * 1536 + o];
            lg[o] = sm + RB[o % 48]; }
        __syncthreads();
        int e0 = 0, e1 = 0, rk0 = 0, rk1 = 0; float gt0 = 0.f, gt1 = 0.f;
        if (tid < 32) {
            const LAS float* l = lg + tid * 48;
            int grp = 0; float lm = l[0];
#pragma unroll
            for (int q = 1; q < 4; ++q) if (l[q] > lm) { lm = l[q]; grp = q; }
            float den = 0.f;
#pragma unroll
            for (int q = 0; q < 4; ++q) den += __expf(l[q] - lm);
            const float pgrp = 1.0f / den;
            const LAS float* le = l + 4 + grp * 8;
            int i1 = 0; float m1 = le[0];
#pragma unroll
            for (int q = 1; q < 8; ++q) if (le[q] > m1) { m1 = le[q]; i1 = q; }
            int i2 = -1; float m2 = -3.0e38f;
#pragma unroll
            for (int q = 0; q < 8; ++q) if (q != i1 && le[q] > m2) { m2 = le[q]; i2 = q; }
            const float ex = __expf(m2 - m1), inv = 1.0f / (1.0f + ex);
            gt0 = pgrp * inv; gt1 = pgrp * ex * inv;
            e0 = grp * 8 + i1; e1 = grp * 8 + i2;
            rk0 = atomicAdd((int*)(lcnt + e0), 1); rk1 = atomicAdd((int*)(lcnt + e1), 1);
        }
        __syncthreads();
        if (tid < 32) lbase[tid] = (int)__hip_atomic_fetch_add(gcnt + tid, (unsigned)lcnt[tid], __ATOMIC_RELAXED, __HIP_MEMORY_SCOPE_AGENT);
        __syncthreads();
        if (tid < 32) {
            const int tok = it * 32 + tid;
            *(i32x4v*)(P.ws + WS_ROUTE + (size_t)tok * 16) = (i32x4v){e0, lbase[e0] + rk0, e1, lbase[e1] + rk1};
            *(f32x2v*)(P.ws + WS_RG + (size_t)tok * 8) = (f32x2v){gt0, gt1};
        }
        __syncthreads();
    }
}
__device__ __forceinline__ void build_tiles(const Ptrs& P, volatile LAS unsigned* MISC, int tid) {
    if (tid == 0) {
        unsigned* gcnt = (unsigned*)(P.ws + WS_CTL) + CW_CNT;
        int run = 0;
        for (int e = 0; e < NE; ++e) {
            const int cnt = (int)__hip_atomic_load(gcnt + e, __ATOMIC_RELAXED, __HIP_MEMORY_SCOPE_AGENT);
            const int nt = (cnt + 255) >> 8;
            MISC[16 + e] = (unsigned)(run * 256);
            MISC[192 + e] = (unsigned)nt;
            run += nt;
        }
        MISC[8] = (unsigned)run;
        for (int x = 0; x < 8; ++x) { int cum = 0;
            for (int k = 0; k < 4; ++k) { const int e = x + 8 * k; MISC[64 + 16 * x + k] = MISC[16 + e] >> 8; MISC[64 + 16 * x + 4 + k] = (unsigned)cum; cum += (int)MISC[192 + e]; }
            MISC[64 + 16 * x + 8] = (unsigned)cum; }
    }
    __syncthreads();
}
__device__ __forceinline__ void phase_p4b(const Ptrs& P, volatile LAS unsigned* MISC, int lane, int wave, int vcu, int G) {
    const bf16* H2 = (const bf16*)(P.ws + WS_RC + 32 * MiB); bf16* XS = (bf16*)(P.ws + WS_RA);
    float* GATE = (float*)(P.ws + WS_GATE);
    const int gw = vcu * NWAVES + wave, NGW = G * NWAVES;
    for (int tok = gw; tok < T; tok += NGW) {
        const i32x4v r = *(const i32x4v*)(P.ws + WS_ROUTE + (size_t)tok * 16);
        const f32x2v g = *(const f32x2v*)(P.ws + WS_RG + (size_t)tok * 8);
        const int s0 = (int)MISC[16 + r.x] + r.y, s1 = (int)MISC[16 + r.z] + r.w;
        const v4u* src = (const v4u*)(H2 + (size_t)tok * D) + lane;
        const v4u a0 = src[0], a1 = src[64];
        v4u* d0 = (v4u*)(XS + (size_t)s0 * D) + lane; v4u* d1 = (v4u*)(XS + (size_t)s1 * D) + lane;
        d0[0] = a0; d0[64] = a1; d1[0] = a0; d1[64] = a1;
        if (lane == 0) { GATE[s0] = g.x; GATE[s1] = g.y; *(i32x2v*)(P.ws + WS_SLOT + (size_t)tok * 8) = (i32x2v){s0, s1}; }
    }
}
__device__ __forceinline__ void phase_p6(const Ptrs& P, int lane, int wave, int vcu, int G) {
    const float* MOD = (const float*)(P.ws + WS_MOD); const float* fg = P.in[28];
    const bf16* Y = (const bf16*)(P.ws + WS_RC);
    const int gw = vcu * NWAVES + wave, NGW = G * NWAVES;
    for (int tok = gw; tok < T; tok += NGW) {
        const i32x2v sl = *(const i32x2v*)(P.ws + WS_SLOT + (size_t)tok * 8);
        const int mr = tok >> 12;
        f32x4* xr = (f32x4*)(P.out + (size_t)tok * D) + lane;
        const u32x2v* y0 = (const u32x2v*)(Y + (size_t)sl.x * D) + lane; const u32x2v* y1 = (const u32x2v*)(Y + (size_t)sl.y * D) + lane;
        const f32x4* g2p = (const f32x4*)(MOD + mr * 6144 + 5120) + lane;
        f32x4 v[4]; float s = 0.f;
#pragma unroll
        for (int j = 0; j < 4; ++j) { const f32x4 xv = xr[64 * j], g2 = g2p[64 * j]; const u32x2v a = y0[64 * j], bq = y1[64 * j];
            f32x4 yy; yy.x = bflo(a.x) + bflo(bq.x); yy.y = bfhi(a.x) + bfhi(bq.x); yy.z = bflo(a.y) + bflo(bq.y); yy.w = bfhi(a.y) + bfhi(bq.y);
            v[j] = xv + g2 * yy; s += (v[j].x * v[j].x + v[j].y * v[j].y) + (v[j].z * v[j].z + v[j].w * v[j].w); }
        const float rstd = 1.0f / sqrtf(wave_sum(s) * (1.f / D) + EPS);
        const f32x4* fgp = (const f32x4*)fg + lane;
#pragma unroll
        for (int j = 0; j < 4; ++j) xr[64 * j] = v[j] * rstd * fgp[64 * j];
    }
}

struct Args { const float* in[29]; float* out; unsigned char* ws; int ph_lo, ph_hi, li, pad; };
__global__ void __launch_bounds__(NWAVES * 64, 2) fwd_kernel(Args args) {
    extern __shared__ __attribute__((aligned(16))) unsigned char lds_raw[];
    LAS unsigned char* lds = (LAS unsigned char*)lds_raw;
    volatile LAS unsigned* MISC = (volatile LAS unsigned*)(lds + MISC_OFF);
    const int tid = threadIdx.x, lane = tid & 63, wave = __builtin_amdgcn_readfirstlane(tid >> 6);
    const int G = gridDim.x; const int bx = blockIdx.x; const int vcu = (G % 8 == 0) ? (bx % 8) * (G / 8) + bx / 8 : bx;
    Ptrs P;
#pragma unroll
    for (int i = 0; i < 29; ++i) P.in[i] = args.in[i];
    P.out = args.out; P.ws = args.ws;
    for (int u = tid; u < (LDS_BYTES - MISC_OFF) / 4; u += NWAVES * 64) MISC[u] = 0u;
    __syncthreads();
    unsigned* ctl = (unsigned*)(P.ws + WS_CTL);
    XcdBarrier bar; bar.bar = ctl + CW_BAR; bar.x = 0; bar.st = nullptr;
    if (N_LAUNCHES == 1) bar = xcd_barrier_post(ctl + CW_BAR, MISC);
#define GRID_BAR() do { if (N_LAUNCHES == 1) xcd_barrier(bar); } while (0)
    const int lo = args.ph_lo, hi = args.ph_hi;
#define IN(k) (lo <= (k) && (k) < hi)
#ifdef PROBE_LO
#define STAMP(k) do { if (bx == 0 && tid == 0) MISC[256 + (k)] = (unsigned)__builtin_amdgcn_s_memrealtime(); } while (0)
#else
#define STAMP(k) do {} while (0)
#endif
    STAMP(0);
#define BOTH(k) (IN(k) && IN((k) + 1))

    if (IN(0)) { phase_p0a(P, lds, tid, lane, wave, vcu, G); if (BOTH(0)) GRID_BAR(); STAMP(1); }
    if (IN(1)) { phase_p0b(P, lane, wave, vcu, G); if (BOTH(1)) GRID_BAR(); STAMP(2); }
    if (IN(2)) {
        pg8::Gemm g{(const pg8::bf16_t*)(P.ws + WS_RA), (const pg8::bf16_t*)(P.ws + WS_WIN), TA, INC, D};
        pg8::OrderInProj S; S.so.init(T, INC, G, bx);
        pg8::EpiStoreBf16 E{(pg8::bf16_t*)(P.ws + WS_RBB), INC};
        pg8::gemm_phase<pg8::EpiStoreBf16, pg8::OrderInProj, true, true>(lds + RING_OFF, g, S, E);
        if (BOTH(2)) GRID_BAR(); STAMP(3);
    }
    if (IN(3)) { phase_p2a(P, lds, tid, lane, wave, vcu, G); if (BOTH(3)) GRID_BAR(); STAMP(4); }
    if (IN(4)) { phase_p2b(P, lds, tid, vcu, G); if (BOTH(4)) GRID_BAR(); STAMP(5); }
    if (IN(5)) { phase_p2c(P, lds, tid, lane, wave, vcu, G); if (BOTH(5)) GRID_BAR(); STAMP(6); }
    if (IN(6)) {
        pg8::Gemm g{(const pg8::bf16_t*)(P.ws + WS_RC), (const pg8::bf16_t*)(P.ws + WS_WOUT), T, D, D};
        pg8::StaticOrder S; S.init(T, D, G, bx);
        pg8::EpiResid E{P.in[0], (const float*)(P.ws + WS_MOD) + 2048, 6144, P.out};
        pg8::gemm_phase<pg8::EpiResid, pg8::StaticOrder, true, true>(lds + RING_OFF, g, S, E);
        if (BOTH(6)) GRID_BAR(); STAMP(7);
    }
    if (IN(7)) { phase_p4a(P, lds, tid, lane, wave, vcu, G); if (BOTH(7)) GRID_BAR(); STAMP(8); }
    if (IN(8)) { build_tiles(P, MISC, tid); phase_p4b(P, MISC, lane, wave, vcu, G); if (BOTH(8)) GRID_BAR(); STAMP(9); }
    if (IN(9)) {
        build_tiles(P, MISC, tid);
        pg8::Gemm g{(const pg8::bf16_t*)(P.ws + WS_RA), (const pg8::bf16_t*)(P.ws + WS_W13), NSLOT, 2048, D};
        pg8::OrderMoe S{bx >> 3, 8, (const LAS int*)(lds + MISC_OFF + 256 + 64 * (bx & 7)), bx & 7};
        pg8::EpiSwiglu E{(pg8::bf16_t*)(P.ws + WS_RBB)};
        pg8::gemm_phase<pg8::EpiSwiglu, pg8::OrderMoe, true, true>(lds + RING_OFF, g, S, E);
        if (BOTH(9)) GRID_BAR(); STAMP(10);
    }
    if (IN(10)) {
        build_tiles(P, MISC, tid);
        pg8::Gemm g{(const pg8::bf16_t*)(P.ws + WS_RBB), (const pg8::bf16_t*)(P.ws + WS_W2), NSLOT, 1024, D};
        pg8::OrderMoe S{bx >> 3, 4, (const LAS int*)(lds + MISC_OFF + 256 + 64 * (bx & 7)), bx & 7};
        pg8::EpiGateBf16 E{(pg8::bf16_t*)(P.ws + WS_RC), (const float*)(P.ws + WS_GATE)};
        pg8::gemm_phase<pg8::EpiGateBf16, pg8::OrderMoe, true, true>(lds + RING_OFF, g, S, E);
        if (BOTH(10)) GRID_BAR(); STAMP(11);
    }
    if (IN(11)) { phase_p6(P, lane, wave, vcu, G); STAMP(12); }
#ifdef PROBE_LO
    if (bx == 0 && tid == 0) {
        const unsigned dt = (MISC[256 + PROBE_HI] - MISC[256 + PROBE_LO]) * PROBE_MULT;
        const unsigned t0 = (unsigned)__builtin_amdgcn_s_memrealtime();
        while ((unsigned)__builtin_amdgcn_s_memrealtime() - t0 < dt) __builtin_amdgcn_s_sleep(32);
    }
#endif
#undef IN
#undef BOTH
}

extern "C" void kernel_launch(void* const* d_in, const int* in_sizes, int n_in, void* d_out, int out_size, void* d_ws, size_t ws_size, hipStream_t stream) {
    static int grid = 0;
    if (grid == 0) {
        if (n_in != 29 || in_sizes[0] != T * D || out_size != T * D || ws_size < WS_END) { fprintf(stderr, "kernel_launch: built for 29 inputs, x and out of %d floats, >= %zu bytes of workspace; got n_in %d, in0 %d, out %d, ws %zu; nothing launched\n", T * D, (size_t)WS_END, n_in, n_in > 0 ? in_sizes[0] : -1, out_size, ws_size); grid = -1; return; }
        int dev = 0, cus = 0, per_cu = 0;
        if (hipGetDevice(&dev) != hipSuccess || hipDeviceGetAttribute(&cus, hipDeviceAttributeMultiprocessorCount, dev) != hipSuccess) { fprintf(stderr, "kernel_launch: hipGetDevice / hipDeviceGetAttribute failed\n"); grid = -1; return; }
        if (hipFuncSetAttribute((const void*)fwd_kernel, hipFuncAttributeMaxDynamicSharedMemorySize, LDS_BYTES) != hipSuccess) { fprintf(stderr, "kernel_launch: hipFuncSetAttribute failed (%d bytes of dynamic LDS)\n", LDS_BYTES); grid = -1; return; }
        if (hipOccupancyMaxActiveBlocksPerMultiprocessor(&per_cu, (const void*)fwd_kernel, NWAVES * 64, LDS_BYTES) != hipSuccess || per_cu < 1)
            fprintf(stderr, "kernel_launch: note: the occupancy query reports %d workgroups per CU\n", per_cu);
        (void)hipGetLastError();
        grid = cus;
    }
    if (grid < 0) return;
    if (hipMemsetAsync((char*)d_ws + WS_CTL, 0, CTL_ZERO_BYTES, stream) != hipSuccess) { fprintf(stderr, "kernel_launch: hipMemsetAsync failed\n"); return; }
    Args a{};
    for (int i = 0; i < 29; ++i) a.in[i] = (const float*)d_in[i];
    a.out = (float*)d_out; a.ws = (unsigned char*)d_ws;
    for (int li = 0; li < N_LAUNCHES; ++li) {
        a.ph_lo = (N_LAUNCHES == 1) ? 0 : li; a.ph_hi = (N_LAUNCHES == 1) ? NPH : li + 1; a.li = li;
        hipLaunchKernelGGL(fwd_kernel, dim3(grid), dim3(NWAVES * 64), LDS_BYTES, stream, a);
        const hipError_t le = hipPeekAtLastError();
        if (le != hipSuccess) { fprintf(stderr, "kernel_launch: launch %d failed: %s\n", li, hipGetErrorName(le)); break; }
    }
}
```

```cpp
#include <hip/hip_runtime.h>
#include <cstdio>
#include <cstdint>
namespace pg8 {
#define PG8_LAS __attribute__((address_space(3)))
typedef unsigned short bf16_t;
typedef short bf16x8 __attribute__((ext_vector_type(8)));
typedef float f32x4 __attribute__((ext_vector_type(4)));
typedef unsigned u32x4 __attribute__((ext_vector_type(4)));
constexpr int BM = 256, BK = 64, HALF = 128, HTB = HALF * BK * 2  , STAGE_BYTES = 8 * HTB, NXCD = 8, WGM = 8;

__host__ __device__ __forceinline__ int lds_byte(int r, int c) { const int st = (r >> 4) * 2 + (c >> 5), rr = r & 15, cc = c & 31, ob = rr * 64 + cc * 2; return st * 1024 + (ob ^ (((ob >> 9) & 1) << 5)); }
__host__ __device__ __forceinline__ void stage_rc(int b, int& R, int& C) { const int st = b / 1024, sb = b % 1024, swz = sb ^ (((sb >> 9) & 1) << 5); R = (st >> 1) * 16 + swz / 64; C = (st & 1) * 32 + (swz % 64) / 2; }
__host__ __device__ __forceinline__ int perm32(int rho) { const int n = rho >> 4, i = rho & 15; return 8 * (i >> 2) + 4 * n + (i & 3); }

struct Unit { int pm, pn; };
struct Gemm { const bf16_t* A; const bf16_t* Bt; int M, N, K; };

struct StaticOrder {
    int nM, nN, nwg, G, c;
    __host__ __device__ void init(int M, int N, int G_, int c_) { nM = M / BM; nN = N / BM; nwg = nM * nN; G = G_; c = c_; }
    __host__ __device__ bool next(int i, Unit& u) const {
        const long L = (long)i * G + c; if (L >= nwg) return false;
        int wgid = (int)L; { const int q = nwg / NXCD, r = nwg % NXCD, xcd = wgid % NXCD, off = wgid / NXCD; wgid = (xcd < r ? xcd * (q + 1) : r * (q + 1) + (xcd - r) * q) + off; }
        const int nig = WGM * nN, gid = wgid / nig, fm = gid * WGM, gsz = (nM - fm) < WGM ? (nM - fm) : WGM;
        u.pm = fm + ((wgid % nig) % gsz); u.pn = (wgid % nig) / gsz; return true;
    }
    __device__ __forceinline__ void a_ready(const Unit&) const {}
    __device__ __forceinline__ void done(const Unit&) const {}
};

__device__ __forceinline__ unsigned cvt_pk_bf16(float lo, float hi) { unsigned r; asm volatile("v_cvt_pk_bf16_f32 %0, %1, %2" : "=v"(r) : "v"(lo), "v"(hi)); return r; }
typedef unsigned u32x2 __attribute__((ext_vector_type(2)));
__device__ __forceinline__ float silu_f(float v) { return v * __builtin_amdgcn_rcpf(1.0f + __expf(-v)); }

struct EpiStoreBf16 {
    static constexpr bool PERM = true, AFTER_DRAIN = false;
    bf16_t* O; int ldc;
    __device__ __forceinline__ void operator()(const f32x4 (&acc)[2][2][4][2], const Unit& u, int wr, int wc, int fr, int fq) const {
        const int row0 = u.pm * BM + wr * 64 + fr, col0 = u.pn * BM + wc * 32 + 8 * fq;
#pragma unroll
        for (int ai = 0; ai < 2; ++ai)
#pragma unroll
            for (int m = 0; m < 4; ++m) { bf16_t* rowp = O + (size_t)(row0 + ai * HALF + m * 16) * ldc + col0;
#pragma unroll
                for (int bj = 0; bj < 2; ++bj) { const f32x4 v0 = acc[ai][bj][m][0], v1 = acc[ai][bj][m][1];
                    u32x4 w; w.x = cvt_pk_bf16(v0[0], v0[1]); w.y = cvt_pk_bf16(v0[2], v0[3]); w.z = cvt_pk_bf16(v1[0], v1[1]); w.w = cvt_pk_bf16(v1[2], v1[3]);
                    *(u32x4*)(rowp + bj * HALF) = w; } }
    }
};
struct EpiResid {
    static constexpr bool PERM = true, AFTER_DRAIN = false;
    const float* x; const float* g; int gp; float* out;
    __device__ __forceinline__ void operator()(const f32x4 (&acc)[2][2][4][2], const Unit& u, int wr, int wc, int fr, int fq) const {
        const int row0 = u.pm * BM + wr * 64 + fr, col0 = u.pn * BM + wc * 32 + 8 * fq;
        const float* gb = g + (size_t)((u.pm * BM) >> 12) * gp + col0;
        f32x4 gv[2][2];
#pragma unroll
        for (int bj = 0; bj < 2; ++bj) { gv[bj][0] = *(const f32x4*)(gb + bj * HALF); gv[bj][1] = *(const f32x4*)(gb + bj * HALF + 4); }
#pragma unroll
        for (int ai = 0; ai < 2; ++ai)
#pragma unroll
            for (int m = 0; m < 4; ++m) { const size_t off = (size_t)(row0 + ai * HALF + m * 16) * 1024 + col0;
#pragma unroll
                for (int bj = 0; bj < 2; ++bj) {
                    const f32x4 x0 = *(const f32x4*)(x + off + bj * HALF), x1 = *(const f32x4*)(x + off + bj * HALF + 4);
                    *(f32x4*)(out + off + bj * HALF) = x0 + gv[bj][0] * acc[ai][bj][m][0];
                    *(f32x4*)(out + off + bj * HALF + 4) = x1 + gv[bj][1] * acc[ai][bj][m][1]; } }
    }
};
struct EpiSwiglu {
    static constexpr bool PERM = true, AFTER_DRAIN = false;
    bf16_t* H;
    __device__ __forceinline__ void operator()(const f32x4 (&acc)[2][2][4][2], const Unit& u, int wr, int wc, int fr, int fq) const {
        const int row0 = u.pm * BM + wr * 64 + fr, col0 = (u.pn & 7) * 128 + wc * 16 + 4 * fq;
#pragma unroll
        for (int ai = 0; ai < 2; ++ai)
#pragma unroll
            for (int m = 0; m < 4; ++m) { bf16_t* rowp = H + (size_t)(row0 + ai * HALF + m * 16) * 1024 + col0;
#pragma unroll
                for (int bj = 0; bj < 2; ++bj) { const f32x4 v0 = acc[ai][bj][m][0], v1 = acc[ai][bj][m][1];
                    u32x2 w; w.x = cvt_pk_bf16(silu_f(v0[0]) * v0[1], silu_f(v0[2]) * v0[3]); w.y = cvt_pk_bf16(silu_f(v1[0]) * v1[1], silu_f(v1[2]) * v1[3]);
                    *(u32x2*)(rowp + bj * 64) = w; } }
    }
};
struct EpiGateBf16 {
    static constexpr bool PERM = true, AFTER_DRAIN = false;
    bf16_t* Y; const float* gate;
    __device__ __forceinline__ void operator()(const f32x4 (&acc)[2][2][4][2], const Unit& u, int wr, int wc, int fr, int fq) const {
        const int row0 = u.pm * BM + wr * 64 + fr, col0 = (u.pn & 3) * BM + wc * 32 + 8 * fq;
#pragma unroll
        for (int ai = 0; ai < 2; ++ai)
#pragma unroll
            for (int m = 0; m < 4; ++m) { const int row = row0 + ai * HALF + m * 16; const float gt = gate[row]; bf16_t* rowp = Y + (size_t)row * 1024 + col0;
#pragma unroll
                for (int bj = 0; bj < 2; ++bj) { const f32x4 v0 = acc[ai][bj][m][0] * gt, v1 = acc[ai][bj][m][1] * gt;
                    u32x4 w; w.x = cvt_pk_bf16(v0[0], v0[1]); w.y = cvt_pk_bf16(v0[2], v0[3]); w.z = cvt_pk_bf16(v1[0], v1[1]); w.w = cvt_pk_bf16(v1[2], v1[3]);
                    *(u32x4*)(rowp + bj * HALF) = w; } }
    }
};
struct OrderInProj {
    StaticOrder so;
    __device__ bool next(int i, Unit& u) const {
        const long L = (long)i * so.G + so.c;
        if (L < so.nwg) return so.next(i, u);
        const int j = (int)(L - so.nwg); if (j >= 8) return false;
        u.pm = 64 + (j >> 1); u.pn = 4 + (j & 1); return true;
    }
    __device__ __forceinline__ void a_ready(const Unit&) const {}
    __device__ __forceinline__ void done(const Unit&) const {}
};
struct OrderMoe {
    int lc, ntn; const PG8_LAS int* xt;
    __device__ bool next(int i, Unit& u) const {
        const int j = i * 32 + lc; if (j >= xt[8] * ntn) return false;
        int k = 0;
#pragma unroll
        for (int q = 1; q < 4; ++q) if (j >= xt[4 + q] * ntn) k = q;
        const int jj = j - xt[4 + k] * ntn;
        u.pm = xt[k] + jj / ntn; u.pn = ((lc_x + 8 * k) * ntn) + jj % ntn; return true;
    }
    int lc_x;
    __device__ __forceinline__ void a_ready(const Unit&) const {}
    __device__ __forceinline__ void done(const Unit&) const {}
};
template <class Epi, class Sched, bool ALIGN_EPI = false, bool SP2 = false>
__device__ __forceinline__ void gemm_phase(PG8_LAS unsigned char* lds, const Gemm g, const Sched& S, const Epi& E) {
    const int tid = threadIdx.x, wid = __builtin_amdgcn_readfirstlane(tid >> 6), lane = tid & 63, wr = wid >> 2, wc = wid & 3, fr = lane & 15, fq = lane >> 4;
    const int K = g.K, nt = K / BK;
    unsigned voffA[2], voffB[2];
#pragma unroll
    for (int i = 0; i < 2; ++i) { int R, C; stage_rc(tid * 16 + i * 8192, R, C); const int Rb = Epi::PERM ? ((R & ~31) + perm32(R & 31)) : R;
        voffA[i] = (unsigned)(R * K + C) * 2u; voffB[i] = (unsigned)(Rb * K + C) * 2u; }
    const size_t kstep = (size_t)(BK * 2);
    const size_t hstep = (size_t)HALF * K * 2;
    const size_t tstep = 2 * hstep;
    const unsigned ldsw = (unsigned)wid * 1024u;
    const int aoff = lds_byte(wr * 64 + fr, fq * 8), boff = lds_byte(wc * 32 + fr, fq * 8);
#define PG8_SA(b, h) (((b) * 2 + (h)) * HTB)
#define PG8_SB(b, h) ((4 + (b) * 2 + (h)) * HTB)
#define PG8_STAGE(bufoff, gbase, voff) do { _Pragma("unroll") for (int _i = 0; _i < 2; ++_i) \
        __builtin_amdgcn_global_load_lds((const unsigned*)((const char*)(gbase) + (voff)[_i]), (PG8_LAS unsigned*)(lds + (bufoff) + ldsw + _i * 8192), 16, 0, 0); } while (0)
#define PG8_LDA(dst, b, h) do { _Pragma("unroll") for (int m = 0; m < 4; ++m) _Pragma("unroll") for (int k = 0; k < 2; ++k) dst[m][k] = *(const PG8_LAS bf16x8*)(lds + PG8_SA(b, h) + aoff + m * 2048 + k * 1024); } while (0)
#define PG8_LDB(dst, b, h) do { _Pragma("unroll") for (int n = 0; n < 2; ++n) _Pragma("unroll") for (int k = 0; k < 2; ++k) dst[n][k] = *(const PG8_LAS bf16x8*)(lds + PG8_SB(b, h) + boff + n * 2048 + k * 1024); } while (0)
#define PG8_MMA(ai, bj, At, Bt) do { __builtin_amdgcn_s_setprio(1); _Pragma("unroll") for (int m = 0; m < 4; ++m) _Pragma("unroll") for (int n = 0; n < 2; ++n) _Pragma("unroll") for (int k = 0; k < 2; ++k) \
        acc[ai][bj][m][n] = __builtin_amdgcn_mfma_f32_16x16x32_bf16(Bt[n][k], At[m][k], acc[ai][bj][m][n], 0, 0, 0); __builtin_amdgcn_s_setprio(0); } while (0)
#define PG8_WAIT_V(n) asm volatile("s_waitcnt vmcnt(" #n ")" ::: "memory")
#define PG8_WAIT_L(n) asm volatile("s_waitcnt lgkmcnt(" #n ")" ::: "memory")
#define PG8_BAR __builtin_amdgcn_s_barrier()
#define PG8_SCHED __builtin_amdgcn_sched_barrier(0)
    Unit cur, nxt; int ui = 0;
    if (!S.next(0, cur)) return;
    f32x4 acc[2][2][4][2];
#pragma unroll
    for (int a = 0; a < 2; ++a)
#pragma unroll
        for (int b = 0; b < 2; ++b)
#pragma unroll
            for (int m = 0; m < 4; ++m)
#pragma unroll
                for (int n = 0; n < 2; ++n) acc[a][b][m][n] = (f32x4){0.f, 0.f, 0.f, 0.f};
    bf16x8 At[4][2], B0[2][2], B1[2][2];
    const char* cA = (const char*)g.A + (size_t)cur.pm * tstep; const char* cB = (const char*)g.Bt + (size_t)cur.pn * tstep;
    S.a_ready(cur);
    if constexpr (SP2) {
        PG8_STAGE(PG8_SB(0, 0), cB, voffB); PG8_STAGE(PG8_SB(0, 1), cB + hstep, voffB); PG8_STAGE(PG8_SA(0, 0), cA, voffA); PG8_STAGE(PG8_SA(0, 1), cA + hstep, voffA);
        if (wr == 1) PG8_BAR;
        PG8_WAIT_V(2); PG8_BAR;
        PG8_STAGE(PG8_SB(1, 0), cB + kstep, voffB); PG8_STAGE(PG8_SA(1, 0), cA + kstep, voffA); PG8_STAGE(PG8_SB(1, 1), cB + hstep + kstep, voffB);
        PG8_WAIT_V(6); PG8_BAR;
    } else {
        PG8_STAGE(PG8_SB(0, 0), cB, voffB); PG8_STAGE(PG8_SA(0, 0), cA, voffA); PG8_STAGE(PG8_SB(0, 1), cB + hstep, voffB); PG8_STAGE(PG8_SA(0, 1), cA + hstep, voffA);
        if (wr == 1) PG8_BAR;
        PG8_WAIT_V(4); PG8_BAR;
        PG8_STAGE(PG8_SB(1, 0), cB + kstep, voffB); PG8_STAGE(PG8_SA(1, 0), cA + kstep, voffA); PG8_STAGE(PG8_SB(1, 1), cB + hstep + kstep, voffB);
        PG8_WAIT_V(6); PG8_BAR;
    }
    for (;;) {
        const bool has_next = S.next(ui + 1, nxt);
        const char* nA = has_next ? (const char*)g.A + (size_t)nxt.pm * tstep : cA; const char* nB = has_next ? (const char*)g.Bt + (size_t)nxt.pn * tstep : cB;
        for (int t = 0; t < nt; t += 2) {
            const bool last = (t == nt - 2);
            const char* a1 = cA + (size_t)(t + 1) * kstep;
            const char* a2 = last ? nA : cA + (size_t)(t + 2) * kstep; const char* b2 = last ? nB : cB + (size_t)(t + 2) * kstep;
            const char* a3 = a2 + kstep; const char* b3 = b2 + kstep;
            if (last && has_next) S.a_ready(nxt);
            if constexpr (SP2) {
            PG8_LDB(B0, 0, 0); PG8_LDB(B1, 0, 1); PG8_SCHED; PG8_LDA(At, 0, 0); PG8_STAGE(PG8_SA(1, 1), a1 + hstep, voffA);
            PG8_WAIT_V(8); PG8_WAIT_L(0); PG8_BAR; PG8_MMA(0, 0, At, B0); PG8_MMA(0, 1, At, B1); PG8_BAR; PG8_SCHED;
            PG8_LDA(At, 0, 1); PG8_STAGE(PG8_SB(0, 0), b2, voffB); PG8_STAGE(PG8_SB(0, 1), b2 + hstep, voffB); PG8_STAGE(PG8_SA(0, 0), a2, voffA);
            PG8_WAIT_V(8); PG8_WAIT_L(0); PG8_BAR; PG8_MMA(1, 0, At, B0); PG8_MMA(1, 1, At, B1); PG8_BAR; PG8_SCHED;
            PG8_LDB(B0, 1, 0); PG8_LDB(B1, 1, 1); PG8_SCHED; PG8_LDA(At, 1, 0); PG8_STAGE(PG8_SA(0, 1), a2 + hstep, voffA);
            PG8_WAIT_V(8); PG8_WAIT_L(0); PG8_BAR; PG8_MMA(0, 0, At, B0); PG8_MMA(0, 1, At, B1); PG8_BAR; PG8_SCHED;
            PG8_LDA(At, 1, 1); PG8_STAGE(PG8_SB(1, 0), b3, voffB); PG8_STAGE(PG8_SB(1, 1), b3 + hstep, voffB); PG8_STAGE(PG8_SA(1, 0), a3, voffA);
            PG8_WAIT_V(8); PG8_WAIT_L(0); PG8_BAR; PG8_MMA(1, 0, At, B0); PG8_MMA(1, 1, At, B1); PG8_BAR; PG8_SCHED;
            } else {
            PG8_LDB(B0, 0, 0); PG8_SCHED; PG8_LDA(At, 0, 0); PG8_STAGE(PG8_SA(1, 1), a1 + hstep, voffA);
            PG8_WAIT_L(8); PG8_BAR; PG8_WAIT_L(0); PG8_MMA(0, 0, At, B0); PG8_BAR; PG8_SCHED;
            PG8_LDB(B1, 0, 1); PG8_STAGE(PG8_SB(0, 0), b2, voffB);
            PG8_BAR; PG8_WAIT_L(0); PG8_MMA(0, 1, At, B1); PG8_BAR;
            PG8_LDA(At, 0, 1); PG8_STAGE(PG8_SA(0, 0), a2, voffA);
            PG8_BAR; PG8_WAIT_L(0); PG8_MMA(1, 0, At, B0); PG8_BAR; PG8_SCHED;
            PG8_STAGE(PG8_SB(0, 1), b2 + hstep, voffB);
            PG8_WAIT_V(6); PG8_BAR; PG8_MMA(1, 1, At, B1); PG8_BAR;
            PG8_LDB(B0, 1, 0); PG8_SCHED; PG8_LDA(At, 1, 0); PG8_STAGE(PG8_SA(0, 1), a2 + hstep, voffA);
            PG8_WAIT_L(8); PG8_BAR; PG8_WAIT_L(0); PG8_MMA(0, 0, At, B0); PG8_BAR; PG8_SCHED;
            PG8_LDB(B1, 1, 1); PG8_STAGE(PG8_SB(1, 0), b3, voffB);
            PG8_BAR; PG8_WAIT_L(0); PG8_MMA(0, 1, At, B1); PG8_BAR;
            PG8_LDA(At, 1, 1); PG8_STAGE(PG8_SA(1, 0), a3, voffA);
            PG8_BAR; PG8_WAIT_L(0); PG8_MMA(1, 0, At, B0); PG8_BAR; PG8_SCHED;
            PG8_STAGE(PG8_SB(1, 1), b3 + hstep, voffB);
            PG8_WAIT_V(6); PG8_BAR; PG8_MMA(1, 1, At, B1); PG8_BAR;
            }
        }
        if constexpr (ALIGN_EPI) { if (wr == 0) PG8_BAR; }
        if constexpr (!Epi::AFTER_DRAIN) { E(acc, cur, wr, wc, fr, fq); S.done(cur); }
        if (!has_next) break;
#pragma unroll
        for (int a = 0; a < 2; ++a)
#pragma unroll
            for (int b = 0; b < 2; ++b)
#pragma unroll
                for (int m = 0; m < 4; ++m)
#pragma unroll
                    for (int n = 0; n < 2; ++n) acc[a][b][m][n] = (f32x4){0.f, 0.f, 0.f, 0.f};
        cur = nxt; cA = nA; cB = nB; ++ui;
        if constexpr (ALIGN_EPI) { if (wr == 1) PG8_BAR; }
    }
    PG8_WAIT_V(0);
    if constexpr (!ALIGN_EPI) { if (wr == 0) PG8_BAR; }
    PG8_BAR;
    if constexpr (Epi::AFTER_DRAIN) { E.fused(acc, cur, wr, wc, fr, fq, lds, wid, lane); S.done(cur); }
#undef PG8_SA
#undef PG8_SB
#undef PG8_STAGE
#undef PG8_LDA
#undef PG8_LDB
#undef PG8_MMA
#undef PG8_WAIT_V
#undef PG8_WAIT_L
#undef PG8_BAR
#undef PG8_SCHED
}
}

constexpr int NWAVES = 8;
#ifndef MK_N_LAUNCHES
#define MK_N_LAUNCHES 1
#endif
constexpr int NPH = 12;
constexpr int N_LAUNCHES = MK_N_LAUNCHES;

constexpr int NB = 4, SEQ = 4096, D = 1024, T = NB * SEQ, CTXL = 256, TC = NB * CTXL, TA = T + TC;
constexpr int CC = 512, LW = 512, INC = 2048, NE = 32, NSLOT = 2 * T + NE * 256;
constexpr int NCH = 272;
constexpr float EPS = 1e-6f;

constexpr size_t MiB = 1u << 20;
constexpr size_t WS_CTL = 0, CTL_ZERO_BYTES = 64 * 1024;
constexpr size_t WS_MOD = 1 * MiB;
constexpr size_t WS_RWH = WS_MOD + 128 * 1024;
constexpr size_t WS_RWL = WS_RWH + 96 * 1024;
constexpr size_t WS_RB = WS_RWL + 96 * 1024;
constexpr size_t WS_WG = 2 * MiB;
constexpr size_t WS_WIN = 3 * MiB;
constexpr size_t WS_WOUT = 7 * MiB;
constexpr size_t WS_AGG = 464 * MiB;
constexpr size_t WS_CARRY = 474 * MiB;
constexpr size_t WS_ROUTE = 13 * MiB;
constexpr size_t WS_RG = WS_ROUTE + 256 * 1024;
constexpr size_t WS_SLOT = WS_RG + 128 * 1024;
constexpr size_t WS_GATE = WS_SLOT + 128 * 1024;
constexpr size_t WS_W13 = 16 * MiB;
constexpr size_t WS_W2 = 144 * MiB;
constexpr size_t WS_RA = 208 * MiB;
constexpr size_t WS_RBB = 288 * MiB;
constexpr size_t WS_RC = 368 * MiB;
constexpr size_t WS_END = 480 * MiB;
static_assert((size_t)NSLOT * 1024 * 2 <= 80 * MiB && (size_t)TA * 2048 * 2 <= 80 * MiB && WS_GATE + (size_t)NSLOT * 4 <= WS_W13, "ws map");
constexpr int CW_CNT = 64;
constexpr int CW_BAR = 1024;

constexpr int RING_OFF = 0, RING_BYTES = 131072;
constexpr int SCR_BYTES = 147456;
constexpr int MISC_OFF = SCR_BYTES;
constexpr int LDS_BYTES = SCR_BYTES + 2048;
#define GAS __attribute__((address_space(1)))
#define LAS __attribute__((address_space(3)))
typedef unsigned short bf16;
typedef unsigned v4u __attribute__((ext_vector_type(4)));
typedef float f32x4 __attribute__((ext_vector_type(4)));
typedef short bf16x8 __attribute__((ext_vector_type(8)));
typedef GAS unsigned gu32;
typedef GAS unsigned long long gu64;
#define RLX_AGENT __ATOMIC_RELAXED, __HIP_MEMORY_SCOPE_AGENT
#define LDS_WAIT() asm volatile("s_waitcnt lgkmcnt(0)" ::: "memory")
#define VM_WAIT() asm volatile("s_waitcnt vmcnt(0)" ::: "memory")
__device__ __forceinline__ unsigned long long rt() { return __builtin_amdgcn_s_memrealtime(); }
__device__ __forceinline__ unsigned f2bf(float f) { unsigned u = __builtin_bit_cast(unsigned, f); return (u + 0x7fffu + ((u >> 16) & 1u)) >> 16; }
__device__ __forceinline__ unsigned pk2(float lo, float hi) { return f2bf(lo) | (f2bf(hi) << 16); }

#define XB_TMO      128
#define XB_XCNT(j)  (256  + 64 * (j))
#define XB_XSUB(j)  (1280 + 64 * (j))
#define XB_XGEN(j)  (2304 + 64 * (j))
#define XB_TOP      3328
#define XB_TOPGEN   3392
#define XCD_BAR_WORDS 3456
#define XB_SPIN_CAP (1u << 18)

__device__ __forceinline__ unsigned xb_ld(unsigned* p)              { return __hip_atomic_load(p, __ATOMIC_RELAXED, __HIP_MEMORY_SCOPE_AGENT); }
__device__ __forceinline__ unsigned xb_add(unsigned* p, unsigned v) { return __hip_atomic_fetch_add(p, v, __ATOMIC_RELAXED, __HIP_MEMORY_SCOPE_AGENT); }
__device__ __forceinline__ unsigned xb_xcc_id() { return (unsigned)__builtin_amdgcn_s_getreg((3 << 11) | 20) & 0xFu; }
#define XB_SPIN(cond, bar) do { unsigned _sp = 0; while (cond) { __builtin_amdgcn_s_sleep(1); \
    if ((++_sp & 255u) == 0u) { if (xb_ld(&(bar)[XB_TMO])) break; if (_sp > XB_SPIN_CAP) { atomicAdd(&(bar)[XB_TMO], 1u); break; } } } } while (0)

struct XcdBarrier {
    unsigned* bar; unsigned x;
    volatile LAS unsigned* st;
};

__device__ __forceinline__ XcdBarrier xcd_barrier_post(unsigned* bar, volatile LAS unsigned* st) {
    XcdBarrier b; b.bar = bar; b.x = xb_xcc_id(); b.st = st;
    if (threadIdx.x == 0) (void)xb_add(&bar[XB_XCNT(b.x)], 1u);
    return b;
}
__device__ __forceinline__ void xcd_barrier_complete(unsigned* bar, unsigned x, unsigned& nloc, unsigned& nx) {
    const unsigned G = gridDim.x * gridDim.y * gridDim.z;
    unsigned sum, cnt, mine, sp = 0u;
    for (;;) {
        sum = 0u; cnt = 0u; mine = 0u;
#pragma unroll
        for (unsigned j = 0; j < 16; ++j) { const unsigned c = xb_ld(&bar[XB_XCNT(j)]); sum += c; cnt += (c > 0u) ? 1u : 0u; mine = (j == x) ? c : mine; }
        if (sum == G) break;
        __builtin_amdgcn_s_sleep(1);
        if ((++sp & 255u) == 0u) { if (xb_ld(&bar[XB_TMO])) break; if (sp > XB_SPIN_CAP) { atomicAdd(&bar[XB_TMO], 1u); break; } }
    }
    nloc = mine > 0u ? mine : 1u; nx = cnt > 0u ? cnt : 1u;
}

__device__ __forceinline__ void xcd_barrier(const XcdBarrier& b) {
    asm volatile("s_waitcnt vmcnt(0)" ::: "memory");
    __syncthreads();
    if (threadIdx.x == 0) {
        unsigned* bar = b.bar;
        __builtin_amdgcn_s_waitcnt(0);
        unsigned nloc = b.st[0], nx = b.st[1];
        if (nloc == 0u) { xcd_barrier_complete(bar, b.x, nloc, nx); b.st[0] = nloc; b.st[1] = nx; }
        const unsigned old = xb_add(&bar[XB_XSUB(b.x)], 1u);
        const unsigned gen = old / nloc;
        if (old + 1u == (gen + 1u) * nloc) {
            __builtin_amdgcn_fence(__ATOMIC_RELEASE, "agent");
            asm volatile("s_waitcnt vmcnt(0)" ::: "memory");
            const unsigned og = xb_add(&bar[XB_TOP], 1u);
            const unsigned tg = og / nx;
            if (og + 1u == (tg + 1u) * nx) xb_add(&bar[XB_TOPGEN], 1u);
            else XB_SPIN(xb_ld(&bar[XB_TOPGEN]) == tg, bar);
            __builtin_amdgcn_fence(__ATOMIC_ACQUIRE, "agent");
            xb_add(&bar[XB_XGEN(b.x)], 1u);
            asm volatile("s_waitcnt vmcnt(0)" ::: "memory");
        } else {
            XB_SPIN(xb_ld(&bar[XB_XGEN(b.x)]) == gen, bar);
            __builtin_amdgcn_fence(__ATOMIC_ACQUIRE, "agent");
            asm volatile("s_waitcnt vmcnt(0)" ::: "memory");
        }
    }
    __syncthreads();
}

typedef float f32x2v __attribute__((ext_vector_type(2)));
typedef unsigned u32x2v __attribute__((ext_vector_type(2)));
typedef int i32x4v __attribute__((ext_vector_type(4)));
typedef int i32x2v __attribute__((ext_vector_type(2)));
__device__ __forceinline__ float wave_sum(float v) {
#pragma unroll
    for (int o = 1; o < 64; o <<= 1) v += __shfl_xor(v, o);
    return v;
}
__device__ __forceinline__ float bf2f(unsigned short h) { return __builtin_bit_cast(float, (unsigned)h << 16); }
__device__ __forceinline__ float bflo(unsigned w) { return __builtin_bit_cast(float, w << 16); }
__device__ __forceinline__ float bfhi(unsigned w) { return __builtin_bit_cast(float, w & 0xffff0000u); }
__device__ __forceinline__ float sigmoid_f(float v) { return __builtin_amdgcn_rcpf(1.0f + __expf(-v)); }
__device__ __forceinline__ float silu_ff(float v) { return v * __builtin_amdgcn_rcpf(1.0f + __expf(-v)); }
__device__ __forceinline__ float gelu_tanh_f(float v) { const float y = 1.5957691216057308f * (v + 0.044715f * v * v * v); return v * __builtin_amdgcn_rcpf(1.0f + __expf(-y)); }

struct TrItem { const float* W; bf16* WT; int K, N, row_off, rmul, item; };
__device__ __forceinline__ void tr_load(const TrItem& t, f32x4 (&v)[16], int lane) {
    const int nblk = t.N / 64, kb = t.item / nblk, nb = t.item % nblk, k0 = 64 * kb, n0 = 64 * nb;
    const int r4 = lane >> 4, q = lane & 15;
#pragma unroll
    for (int i = 0; i < 16; ++i) v[i] = *(const f32x4*)(t.W + (size_t)(k0 + 4 * i + r4) * t.N + n0 + 4 * q);
}
__device__ __forceinline__ void tr_store(const TrItem& t, const f32x4 (&v)[16], LAS float* scr, int lane) {
    const int nblk = t.N / 64, kb = t.item / nblk, nb = t.item % nblk, k0 = 64 * kb, n0 = 64 * nb;
    const int r4 = lane >> 4, q = lane & 15;
#pragma unroll
    for (int i = 0; i < 16; ++i) { LAS float* d = scr + (4 * i + r4) * 65 + 4 * q; d[0] = v[i].x; d[1] = v[i].y; d[2] = v[i].z; d[3] = v[i].w; }
    LDS_WAIT(); asm volatile("" ::: "memory");
    const int c = lane & 7;
#pragma unroll
    for (int j = 0; j < 8; ++j) { const int n = (lane >> 3) + 8 * j; const LAS float* s = scr + (8 * c) * 65 + n;
        v4u o; o.x = pk2(s[0 * 65], s[1 * 65]); o.y = pk2(s[2 * 65], s[3 * 65]); o.z = pk2(s[4 * 65], s[5 * 65]); o.w = pk2(s[6 * 65], s[7 * 65]);
        *(v4u*)(t.WT + (size_t)(t.row_off + t.rmul * (n0 + n)) * t.K + k0 + 8 * c) = o; }
    LDS_WAIT(); asm volatile("" ::: "memory");
}

struct Ptrs {
    const float* in[29]; float* out; unsigned char* ws;
};

constexpr int I_E = 32 * 256, I_IN = 16 * 32, I_OUT = 16 * 16, I_G = 32, TR_ITEMS = 3 * I_E + I_IN + I_OUT + I_G;
__device__ __forceinline__ TrItem tr_decode(const Ptrs& P, int it) {
    bf16* W13 = (bf16*)(P.ws + WS_W13); bf16* W2 = (bf16*)(P.ws + WS_W2); bf16* WIN = (bf16*)(P.ws + WS_WIN); bf16* WOUT = (bf16*)(P.ws + WS_WOUT); bf16* WG = (bf16*)(P.ws + WS_WG);
    int r = it;
    if (r < I_E) { const int e = r >> 8; return TrItem{P.in[25] + (size_t)e * 1048576, W13, 1024, 1024, e * 2048, 2, r & 255}; } r -= I_E;
    if (r < I_E) { const int e = r >> 8; return TrItem{P.in[26] + (size_t)e * 1048576, W13, 1024, 1024, e * 2048 + 1, 2, r & 255}; } r -= I_E;
    if (r < I_E) { const int e = r >> 8; return TrItem{P.in[27] + (size_t)e * 1048576, W2, 1024, 1024, e * 1024, 1, r & 255}; } r -= I_E;
    if (r < I_IN) return TrItem{P.in[8], WIN, 1024, 2048, 0, 1, r}; r -= I_IN;
    if (r < I_OUT) return TrItem{P.in[20], WOUT, 1024, 1024, 0, 1, r}; r -= I_OUT;
    const int which = r >> 4, mtx = r & 15;
    return TrItem{(which ? P.in[17] : P.in[15]) + mtx * 4096, WG, 64, 64, mtx * 128 + which * 64, 1, 0};
}
__device__ __forceinline__ void tr_range(const Ptrs& P, LAS float* scr, int lo, int hi, int w, int NW, int lane) {
    int it = lo + w; if (it >= hi) return;
    TrItem cur = tr_decode(P, it);
    f32x4 v[16], vn[16];
    tr_load(cur, v, lane);
    for (;;) {
        const int nx = it + NW; const bool more = nx < hi;
        TrItem nxt = cur;
        if (more) { nxt = tr_decode(P, nx); tr_load(nxt, vn, lane); }
        tr_store(cur, v, scr, lane);
        if (!more) break;
#pragma unroll
        for (int i = 0; i < 16; ++i) v[i] = vn[i];
        cur = nxt; it = nx;
    }
}

__device__ __forceinline__ void phase_p0a(const Ptrs& P, LAS unsigned char* lds, int tid, int lane, int wave, int vcu, int G) {
    {
        const float* c = P.in[1]; const float* c_ctx = P.in[3]; const float* w_ada = P.in[4]; const float* b_ada = P.in[5];
        float* MOD = (float*)(P.ws + WS_MOD);
        LAS float* red = (LAS float*)lds;
        const int r4 = lane >> 4, q = lane & 15;
        for (int cb = vcu; cb < 96; cb += G) {
            f32x4 acc[5];
#pragma unroll
            for (int r = 0; r < 5; ++r) acc[r] = (f32x4){0.f, 0.f, 0.f, 0.f};
#pragma unroll 8
            for (int i = 0; i < 32; ++i) {
                const int k = wave * 128 + 4 * i + r4;
                const f32x4 w = *(const f32x4*)(w_ada + (size_t)k * 6144 + 64 * cb + 4 * q);
#pragma unroll
                for (int r = 0; r < 5; ++r) { const float sv = silu_ff(r < 4 ? c[r * 1024 + k] : c_ctx[k]); acc[r] += w * sv; }
            }
#pragma unroll
            for (int r = 0; r < 5; ++r) {
#pragma unroll
                for (int e = 0; e < 4; ++e) { float t = acc[r][e]; t += __shfl_xor(t, 16); t += __shfl_xor(t, 32); acc[r][e] = t; }
                if (r4 == 0) *(LAS f32x4*)(red + (wave * 5 + r) * 64 + 4 * q) = acc[r];
            }
            __syncthreads();
            if (tid < 320) { const int r = tid >> 6, cc = tid & 63; float sm = 0.f;
#pragma unroll
                for (int w8 = 0; w8 < 8; ++w8) sm += red[(w8 * 5 + r) * 64 + cc];
                MOD[r * 6144 + 64 * cb + cc] = sm + b_ada[64 * cb + cc]; }
            __syncthreads();
        }
    }
    {
        bf16* RWH = (bf16*)(P.ws + WS_RWH); bf16* RWL = (bf16*)(P.ws + WS_RWL); float* RB = (float*)(P.ws + WS_RB);
        const float* wg = P.in[21]; const float* bg = P.in[22]; const float* we = P.in[23]; const float* be = P.in[24];
        for (int i = vcu * 512 + tid; i < 48 * 1024; i += G * 512) { const int n = i >> 10, k = i & 1023;
            const float w = n < 4 ? wg[k * 4 + n] : (n < 36 ? we[k * 32 + n - 4] : 0.f);
            const unsigned hi = f2bf(w); const float lo = w - __builtin_bit_cast(float, hi << 16);
            RWH[i] = (bf16)hi; RWL[i] = (bf16)f2bf(lo); }
        if (vcu == 0 && tid < 48) RB[tid] = tid < 4 ? bg[tid] : (tid < 36 ? be[tid - 4] : 0.f);
    }
    {
        LAS float* scr = (LAS float*)(lds + wave * 16640);
        const int gw = vcu * NWAVES + wave, NGW = G * NWAVES;
        tr_range(P, scr, 0, TR_ITEMS, gw, NGW, lane);
    }
}

__device__ __forceinline__ void phase_p0b(const Ptrs& P, int lane, int wave, int vcu, int G) {
    const float* MOD = (const float*)(P.ws + WS_MOD); const float* g1n = P.in[6];
    bf16* XN = (bf16*)(P.ws + WS_RA);
    const int gw = vcu * NWAVES + wave, NGW = G * NWAVES;
    for (int m = gw; m < TA; m += NGW) {
        const float* src; int mr;
        if (m < T) { src = P.in[0] + (size_t)m * D; mr = m >> 12; } else { src = P.in[2] + (size_t)(m - T) * D; mr = 4; }
        const f32x4* xr = (const f32x4*)src + lane;
        f32x4 v[4]; float s = 0.f;
#pragma unroll
        for (int j = 0; j < 4; ++j) { v[j] = xr[64 * j]; s += (v[j].x * v[j].x + v[j].y * v[j].y) + (v[j].z * v[j].z + v[j].w * v[j].w); }
        const float rstd = 1.0f / sqrtf(wave_sum(s) * (1.f / D) + EPS);
        const f32x4* gp = (const f32x4*)g1n + lane; const f32x4* shp = (const f32x4*)(MOD + mr * 6144) + lane; const f32x4* scp = (const f32x4*)(MOD + mr * 6144 + 1024) + lane;
        unsigned long long* o8 = (unsigned long long*)(XN + (size_t)m * D) + lane;
#pragma unroll
        for (int j = 0; j < 4; ++j) { const f32x4 g = gp[64 * j], sh = shp[64 * j], sc = scp[64 * j];
            const f32x4 y = v[j] * rstd * g * (sc + 1.0f) + sh;
            o8[64 * j] = (unsigned long long)pk2(y.x, y.y) | ((unsigned long long)pk2(y.z, y.w) << 32); }
    }
}

constexpr int WL_UB = 0;
constexpr int WL_UF = 2304;
constexpr int WL_AB = 6400;
constexpr int WL_BYTES = 14592;
template <bool FINAL, int DIR>
__device__ __forceinline__ void lru_wave_sweep(const Ptrs& P, LAS unsigned char* wl, int gw, int NGW, int lane) {
    const bf16* ZL = (const bf16*)(P.ws + WS_RBB);
    const bf16* WG = (const bf16*)(P.ws + WS_WG);
    float* HF = (float*)(P.ws + WS_RA + 32 * MiB);
    LAS bf16* ub = (LAS bf16*)(wl + WL_UB); LAS float* uf = (LAS float*)(wl + WL_UF); LAS float* ab = (LAS float*)(wl + WL_AB);
    const int h = gw & 7, l15 = lane & 15, q = lane >> 4;
    float cba[4], cbx[4], csp[4];
    bf16x8 br[4][2], bi[4][2];
#pragma unroll
    for (int nt = 0; nt < 4; ++nt) { const int ch = DIR * 512 + 64 * h + 16 * nt + l15; cba[nt] = P.in[16][ch]; cbx[nt] = P.in[18][ch]; csp[nt] = -8.0f * log1pf(expf(-P.in[19][ch]));
        const bf16* wr = WG + (size_t)(((DIR * 8 + h) * 128 + 16 * nt + l15) * 64 + 8 * q);
        br[nt][0] = *(const bf16x8*)(wr); br[nt][1] = *(const bf16x8*)(wr + 32); bi[nt][0] = *(const bf16x8*)(wr + 64 * 64); bi[nt][1] = *(const bf16x8*)(wr + 64 * 64 + 32); }
    const int chl = 64 * h + lane;
    const float w0 = P.in[13][chl], w1 = P.in[13][512 + chl], w2 = P.in[13][1024 + chl], w3 = P.in[13][1536 + chl], cb = P.in[14][chl];
    const int nitems = FINAL ? NB * 256 * 8 : NB * NCH * 8;
    for (int it = gw; it < nitems; it += NGW) {
        const int bc = it >> 3;
        int b, chunk;
        if (FINAL) { b = bc >> 8; chunk = 16 + (bc & 255); } else { b = bc / NCH; chunk = bc % NCH; }
        const bool isctx = chunk < 16;
        const int seq_row0 = isctx ? (T + b * CTXL) : (b * SEQ), seq_len = isctx ? CTXL : SEQ, t0 = (isctx ? chunk : chunk - 16) * 16;
        float x[19];
#pragma unroll
        for (int r = 0; r < 19; ++r) { const int tt = t0 + r - 2; const int tc = tt < 0 ? 0 : (tt >= seq_len ? seq_len - 1 : tt);
            const float v = bf2f(ZL[(size_t)(seq_row0 + tc) * INC + 1024 + chl]); x[r] = (tt == tc) ? v : 0.f; }
        unsigned short zg[16]; float hf[16]; float cin = 0.f;
        if (FINAL) {
            const float* CARRY = (const float*)(P.ws + WS_CARRY);
            cin = CARRY[(size_t)((b * 256 + (chunk - 16)) * 2 + DIR) * 512 + chl];
            if (DIR == 1) {
#pragma unroll
                for (int t = 0; t < 16; ++t) { zg[t] = ZL[(size_t)(seq_row0 + t0 + t) * INC + 1536 + chl]; hf[t] = HF[(size_t)(b * SEQ + t0 + t) * 512 + chl]; }
            }
        }
#pragma unroll
        for (int t = 0; t < 16; ++t) { const float u = cb + w0 * x[t] + w1 * x[t + 1] + w2 * x[t + 2] + w3 * x[t + 3]; ub[t * 72 + lane] = (bf16)f2bf(u); uf[t * 64 + lane] = u; }
        asm volatile("" ::: "memory");
        bf16x8 af[2];
#pragma unroll
        for (int ks = 0; ks < 2; ++ks) af[ks] = *(const LAS bf16x8*)(ub + l15 * 72 + 32 * ks + 8 * q);
        f32x4 ar[4], ai[4];
#pragma unroll
        for (int nt = 0; nt < 4; ++nt) {
            f32x4 z = {0.f, 0.f, 0.f, 0.f};
            ar[nt] = __builtin_amdgcn_mfma_f32_16x16x32_bf16(af[0], br[nt][0], z, 0, 0, 0); ar[nt] = __builtin_amdgcn_mfma_f32_16x16x32_bf16(af[1], br[nt][1], ar[nt], 0, 0, 0);
            ai[nt] = __builtin_amdgcn_mfma_f32_16x16x32_bf16(af[0], bi[nt][0], z, 0, 0, 0); ai[nt] = __builtin_amdgcn_mfma_f32_16x16x32_bf16(af[1], bi[nt][1], ai[nt], 0, 0, 0);
        }
#pragma unroll
        for (int nt = 0; nt < 4; ++nt)
#pragma unroll
            for (int rg = 0; rg < 4; ++rg) {
                const int t = 4 * q + rg, cl = 16 * nt + l15;
                const float r = sigmoid_f(ar[nt][rg] + cba[nt]), ig = sigmoid_f(ai[nt][rg] + cbx[nt]);
                const float la = csp[nt] * r;
                const float a = __expf(la);
                const float x2 = 2.0f * la;
                const float em = x2 * (1.0f + x2 * (0.5f + x2 * (0.16666667f + x2 * (0.041666668f + x2 * (0.0083333338f + x2 * (0.0013888889f + x2 * 0.0001984127f))))));
                const float mult = __builtin_amdgcn_sqrtf(fmaxf(-em, 1e-12f));
                ab[t * 64 + cl] = a; ab[(16 + t) * 64 + cl] = mult * ig * uf[t * 64 + cl];
            }
        asm volatile("" ::: "memory");
        if (!FINAL) {
            float Pp = 1.f, Hh = 0.f;
#pragma unroll
            for (int i = 0; i < 16; ++i) { const int t = DIR ? 15 - i : i; const float a = ab[t * 64 + lane], bq = ab[(16 + t) * 64 + lane]; Hh = a * Hh + bq; Pp *= a; }
            float* AGG = (float*)(P.ws + WS_AGG);
            *(f32x2v*)(AGG + ((size_t)((b * NCH + chunk) * 2 + DIR) * 512 + chl) * 2) = (f32x2v){Pp, Hh};
        } else {
            float hh = cin; float hs[16];
#pragma unroll
            for (int i = 0; i < 16; ++i) { const int t = DIR ? 15 - i : i; const float a = ab[t * 64 + lane], bq = ab[(16 + t) * 64 + lane]; hh = a * hh + bq; hs[t] = hh; }
            if (DIR == 0) {
#pragma unroll
                for (int t = 0; t < 16; ++t) HF[(size_t)(b * SEQ + t0 + t) * 512 + chl] = hs[t];
            } else {
                bf16* MIX = (bf16*)(P.ws + WS_RC);
#pragma unroll
                for (int t = 0; t < 16; ++t) MIX[(size_t)(b * SEQ + t0 + t) * D + 512 + chl] = (bf16)f2bf((hs[t] + hf[t]) * gelu_tanh_f(bf2f(zg[t])));
            }
        }
        asm volatile("" ::: "memory");
    }
}
template <bool FINAL>
__device__ __forceinline__ void lru_wave_items(const Ptrs& P, LAS unsigned char* wl, int gw, int NGW, int lane) {
    lru_wave_sweep<FINAL, 0>(P, wl, gw, NGW, lane);
    if (FINAL) asm volatile("s_waitcnt vmcnt(0)" ::: "memory");
    lru_wave_sweep<FINAL, 1>(P, wl, gw, NGW, lane);
}

template <int T0> __device__ __forceinline__ void conv_rows8(const float (&uu)[64], const float (&w)[31], float cb, LAS float* dst) {
#pragma unroll
    for (int tt = 0; tt < 8; ++tt) {
        float acc = cb;
#pragma unroll
        for (int j = 0; j < 31; ++j) { const int s = T0 + tt + j - 15; if (s >= 0 && s < 64) acc += w[j] * uu[s]; }
        dst[(T0 + tt) * 68] = acc;
    }
}
__device__ __forceinline__ void conv_wave_items(const Ptrs& P, LAS unsigned char* wl, int gw, int NGW, int lane) {
    const bf16* ZL = (const bf16*)(P.ws + WS_RBB); float* CV = (float*)(P.ws + WS_RA);
    LAS float* U = (LAS float*)wl;
    for (int it = gw; it < NB * 64 * 8; it += NGW) {
        const int s = it >> 3, cg = it & 7;
        {
            const int r8 = lane >> 3, ck = lane & 7;
            const bf16* base = ZL + (size_t)(s * 64 + r8) * INC + 64 * cg + 8 * ck;
            v4u vv[8], gg[8];
#pragma unroll
            for (int i = 0; i < 8; ++i) { vv[i] = *(const v4u*)(base + (size_t)(8 * i) * INC); gg[i] = *(const v4u*)(base + (size_t)(8 * i) * INC + 512); }
#pragma unroll
            for (int i = 0; i < 8; ++i) {
                f32x4 u0, u1;
                u0.x = bflo(vv[i].x) * sigmoid_f(bflo(gg[i].x)); u0.y = bfhi(vv[i].x) * sigmoid_f(bfhi(gg[i].x)); u0.z = bflo(vv[i].y) * sigmoid_f(bflo(gg[i].y)); u0.w = bfhi(vv[i].y) * sigmoid_f(bfhi(gg[i].y));
                u1.x = bflo(vv[i].z) * sigmoid_f(bflo(gg[i].z)); u1.y = bfhi(vv[i].z) * sigmoid_f(bfhi(gg[i].z)); u1.z = bflo(vv[i].w) * sigmoid_f(bflo(gg[i].w)); u1.w = bfhi(vv[i].w) * sigmoid_f(bfhi(gg[i].w));
                *(LAS f32x4*)(U + (8 * i + r8) * 68 + 8 * ck) = u0; *(LAS f32x4*)(U + (8 * i + r8) * 68 + 8 * ck + 4) = u1;
            }
        }
        asm volatile("" ::: "memory");
        {
            const int c = 64 * cg + lane;
            float uu[64];
#pragma unroll
            for (int t = 0; t < 64; ++t) uu[t] = U[t * 68 + lane];
            float w[31];
#pragma unroll
            for (int j = 0; j < 31; ++j) w[j] = P.in[9][j * 512 + c];
            const float cb = P.in[10][c];
            LAS float* dst = U + lane;
            conv_rows8<0>(uu, w, cb, dst); conv_rows8<8>(uu, w, cb, dst); conv_rows8<16>(uu, w, cb, dst); conv_rows8<24>(uu, w, cb, dst);
            conv_rows8<32>(uu, w, cb, dst); conv_rows8<40>(uu, w, cb, dst); conv_rows8<48>(uu, w, cb, dst); conv_rows8<56>(uu, w, cb, dst);
        }
        asm volatile("" ::: "memory");
        {
            const int r4 = lane >> 4, q = lane & 15;
            float* ob = CV + (size_t)(s * 64 + r4) * 512 + 64 * cg + 4 * q;
#pragma unroll
            for (int i = 0; i < 16; ++i) *(f32x4*)(ob + (size_t)(4 * i) * 512) = *(const LAS f32x4*)(U + (4 * i + r4) * 68 + 4 * q);
        }
        asm volatile("" ::: "memory");
    }
}
__device__ __forceinline__ void convln_wave_items(const Ptrs& P, int gw, int NGW, int lane) {
    const float* CV = (const float*)(P.ws + WS_RA); bf16* MIX = (bf16*)(P.ws + WS_RC);
    const f32x4 g0 = *(const f32x4*)(P.in[11] + 8 * lane), g1 = *(const f32x4*)(P.in[11] + 8 * lane + 4);
    const f32x4 b0 = *(const f32x4*)(P.in[12] + 8 * lane), b1 = *(const f32x4*)(P.in[12] + 8 * lane + 4);
    for (int tok = gw; tok < T; tok += NGW) {
        f32x4 v0 = *(const f32x4*)(CV + (size_t)tok * 512 + 8 * lane), v1 = *(const f32x4*)(CV + (size_t)tok * 512 + 8 * lane + 4);
        const float mu = wave_sum((v0.x + v0.y) + (v0.z + v0.w) + (v1.x + v1.y) + (v1.z + v1.w)) * (1.f / 512.f);
        v0 = v0 - mu; v1 = v1 - mu;
        const float var = wave_sum((v0.x * v0.x + v0.y * v0.y) + (v0.z * v0.z + v0.w * v0.w) + (v1.x * v1.x + v1.y * v1.y) + (v1.z * v1.z + v1.w * v1.w)) * (1.f / 512.f);
        const float rstd = 1.0f / sqrtf(var + EPS);
        const f32x4 y0 = v0 * rstd * g0 + b0, y1 = v1 * rstd * g1 + b1;
        v4u o; o.x = pk2(silu_ff(y0.x), silu_ff(y0.y)); o.y = pk2(silu_ff(y0.z), silu_ff(y0.w)); o.z = pk2(silu_ff(y1.x), silu_ff(y1.y)); o.w = pk2(silu_ff(y1.z), silu_ff(y1.w));
        *(v4u*)(MIX + (size_t)tok * D + 8 * lane) = o;
    }
}

#ifdef PROBE_LO
#define SUBSTAMP(k) do { if (blockIdx.x == 0 && tid == 0) ((volatile LAS unsigned*)(lds + MISC_OFF))[256 + (k)] = (unsigned)__builtin_amdgcn_s_memrealtime(); } while (0)
#else
#define SUBSTAMP(k) do {} while (0)
#endif
constexpr int NFG = 8, FG_BYTES = 18432, BG_OFF = NFG * FG_BYTES;
static_assert(WL_BYTES <= FG_BYTES && 64 * 68 * 4 <= FG_BYTES && BG_OFF + (NWAVES - NFG) * 16640 <= SCR_BYTES, "P2 LDS map");
__device__ __forceinline__ void phase_p2a(const Ptrs& P, LAS unsigned char* lds, int tid, int lane, int wave, int vcu, int G) {
    SUBSTAMP(20);
    if (wave < NFG) {
        const int gw = vcu * NFG + wave, NGW = G * NFG;
        lru_wave_items<false>(P, lds + wave * FG_BYTES, gw, NGW, lane);
        SUBSTAMP(21);
        conv_wave_items(P, lds + wave * FG_BYTES, gw, NGW, lane);
        SUBSTAMP(22);
    } else {
        (void)0;
    }
}
__device__ __forceinline__ void phase_p2b(const Ptrs& P, LAS unsigned char* lds, int tid, int vcu, int G) {
    const float* AGG = (const float*)(P.ws + WS_AGG); float* CARRY = (float*)(P.ws + WS_CARRY);
    LAS float* SEGP = (LAS float*)lds;
    for (int item = vcu; item < NB * 2 * 16; item += G) {
        const int b = item >> 5, d = (item >> 4) & 1, cl = tid & 31, ch = 32 * (item & 15) + cl, seg = tid >> 5;
        float A[17], Bv[17];
#pragma unroll
        for (int i = 0; i < 17; ++i) { const int j = 17 * seg + i; const int chunk = d ? (j < 16 ? 15 - j : 287 - j) : j;
            const f32x2v abv = *(const f32x2v*)(AGG + ((size_t)((b * NCH + chunk) * 2 + d) * 512 + ch) * 2); A[i] = abv.x; Bv[i] = abv.y; }
        float Pp = 1.f, Hh = 0.f;
#pragma unroll
        for (int i = 0; i < 17; ++i) { Hh = A[i] * Hh + Bv[i]; Pp *= A[i]; }
        SEGP[(seg * 32 + cl) * 2] = Pp; SEGP[(seg * 32 + cl) * 2 + 1] = Hh;
        __syncthreads();
        float hh = 0.f;
        for (int sg = 0; sg < seg; ++sg) hh = SEGP[(sg * 32 + cl) * 2] * hh + SEGP[(sg * 32 + cl) * 2 + 1];
#pragma unroll
        for (int i = 0; i < 17; ++i) { const int j = 17 * seg + i; const int chunk = d ? (j < 16 ? 15 - j : 287 - j) : j;
            if (chunk >= 16) CARRY[(size_t)((b * 256 + chunk - 16) * 2 + d) * 512 + ch] = hh;
            hh = A[i] * hh + Bv[i]; }
        __syncthreads();
    }
}
__device__ __forceinline__ void phase_p2c(const Ptrs& P, LAS unsigned char* lds, int tid, int lane, int wave, int vcu, int G) {
    SUBSTAMP(24);
    if (wave < NFG) {
        const int gw = vcu * NFG + wave, NGW = G * NFG;
        lru_wave_items<true>(P, lds + wave * FG_BYTES, gw, NGW, lane);
        SUBSTAMP(25);
        convln_wave_items(P, gw, NGW, lane);
        SUBSTAMP(26);
    } else {
        (void)0;
    }
}

constexpr int L_AH = 0, L_AL = 66048, HL_PITCH = 2064;
constexpr int L_PART = 0;
constexpr int L_LG = 132096;
constexpr int L_LCNT = 138240;
constexpr int L_LBASE = 138368;
__device__ __forceinline__ void phase_p4a(const Ptrs& P, LAS unsigned char* lds, int tid, int lane, int wave, int vcu, int G) {
    const float* MOD = (const float*)(P.ws + WS_MOD); const float* g2n = P.in[7];
    const bf16* RWH = (const bf16*)(P.ws + WS_RWH); const bf16* RWL = (const bf16*)(P.ws + WS_RWL); const float* RB = (const float*)(P.ws + WS_RB);
    bf16* H2 = (bf16*)(P.ws + WS_RC + 32 * MiB);
    unsigned* gcnt = (unsigned*)(P.ws + WS_CTL) + CW_CNT;
    LAS float* lg = (LAS float*)(lds + L_LG); LAS int* lcnt = (LAS int*)(lds + L_LCNT); LAS int* lbase = (LAS int*)(lds + L_LBASE); LAS float* part = (LAS float*)(lds + L_PART);
    const int l15 = lane & 15, l4 = lane >> 4;
    for (int it = vcu; it < T / 32; it += G) {
        if (tid < 32) lcnt[tid] = 0;
        for (int i = 0; i < 4; ++i) {
            const int tl = wave * 4 + i, tok = it * 32 + tl, mr = tok >> 12;
            const f32x4* xr = (const f32x4*)(P.out + (size_t)tok * D) + lane;
            f32x4 v[4]; float s = 0.f;
#pragma unroll
            for (int j = 0; j < 4; ++j) { v[j] = xr[64 * j]; s += (v[j].x * v[j].x + v[j].y * v[j].y) + (v[j].z * v[j].z + v[j].w * v[j].w); }
            const float rstd = 1.0f / sqrtf(wave_sum(s) * (1.f / D) + EPS);
            const f32x4* gp = (const f32x4*)g2n + lane; const f32x4* shp = (const f32x4*)(MOD + mr * 6144 + 3072) + lane; const f32x4* scp = (const f32x4*)(MOD + mr * 6144 + 4096) + lane;
            unsigned long long* o8 = (unsigned long long*)(H2 + (size_t)tok * D) + lane;
#pragma unroll
            for (int j = 0; j < 4; ++j) { const f32x4 g = gp[64 * j], sh = shp[64 * j], sc = scp[64 * j];
                const f32x4 y = v[j] * rstd * g * (sc + 1.0f) + sh;
                const unsigned h0 = f2bf(y.x), h1 = f2bf(y.y), h2_ = f2bf(y.z), h3 = f2bf(y.w);
                const unsigned long long pk = (unsigned long long)(h0 | (h1 << 16)) | ((unsigned long long)(h2_ | (h3 << 16)) << 32);
                const unsigned long long pl = (unsigned long long)pk2(y.x - __builtin_bit_cast(float, h0 << 16), y.y - __builtin_bit_cast(float, h1 << 16)) |
                                              ((unsigned long long)pk2(y.z - __builtin_bit_cast(float, h2_ << 16), y.w - __builtin_bit_cast(float, h3 << 16)) << 32);
                o8[64 * j] = pk;
                *(LAS unsigned long long*)(lds + L_AH + tl * HL_PITCH + (lane + 64 * j) * 8) = pk;
                *(LAS unsigned long long*)(lds + L_AL + tl * HL_PITCH + (lane + 64 * j) * 8) = pl; }
        }
        __syncthreads();
        {
            f32x4 acc[2][3];
#pragma unroll
            for (int mt = 0; mt < 2; ++mt)
#pragma unroll
                for (int nt = 0; nt < 3; ++nt) acc[mt][nt] = (f32x4){0.f, 0.f, 0.f, 0.f};
#pragma unroll
            for (int kq = 0; kq < 4; ++kq) {
                const int kof = 32 * (4 * wave + kq) + 8 * l4;
                bf16x8 ah[2], al[2], bh[3], bl[3];
#pragma unroll
                for (int nt = 0; nt < 3; ++nt) { bh[nt] = *(const bf16x8*)(RWH + (size_t)(16 * nt + l15) * 1024 + kof); bl[nt] = *(const bf16x8*)(RWL + (size_t)(16 * nt + l15) * 1024 + kof); }
#pragma unroll
                for (int mt = 0; mt < 2; ++mt) { ah[mt] = *(const LAS bf16x8*)(lds + L_AH + (16 * mt + l15) * HL_PITCH + kof * 2); al[mt] = *(const LAS bf16x8*)(lds + L_AL + (16 * mt + l15) * HL_PITCH + kof * 2); }
#pragma unroll
                for (int mt = 0; mt < 2; ++mt)
#pragma unroll
                    for (int nt = 0; nt < 3; ++nt) {
                        acc[mt][nt] = __builtin_amdgcn_mfma_f32_16x16x32_bf16(al[mt], bh[nt], acc[mt][nt], 0, 0, 0);
                        acc[mt][nt] = __builtin_amdgcn_mfma_f32_16x16x32_bf16(ah[mt], bl[nt], acc[mt][nt], 0, 0, 0);
                        acc[mt][nt] = __builtin_amdgcn_mfma_f32_16x16x32_bf16(ah[mt], bh[nt], acc[mt][nt], 0, 0, 0); }
            }
            __syncthreads();
#pragma unroll
            for (int mt = 0; mt < 2; ++mt)
#pragma unroll
                for (int nt = 0; nt < 3; ++nt)
#pragma unroll
                    for (int rg = 0; rg < 4; ++rg) part[(wave * 32 + 16 * mt + 4 * l4 + rg) * 48 + 16 * nt + l15] = acc[mt][nt][rg];
        }
        __syncthreads();
        for (int o = tid; o < 32 * 48; o += 512) { float sm = 0.f;
#pragma unroll
            for (int w8 = 0; w8 < 8; ++w8) sm += part[w8 * 1536 + o];
            lg[o] = sm + RB[o % 48]; }
        __syncthreads();
        int e0 = 0, e1 = 0, rk0 = 0, rk1 = 0; float gt0 = 0.f, gt1 = 0.f;
        if (tid < 32) {
            const LAS float* l = lg + tid * 48;
            int grp = 0; float lm = l[0];
#pragma unroll
            for (int q = 1; q < 4; ++q) if (l[q] > lm) { lm = l[q]; grp = q; }
            float den = 0.f;
#pragma unroll
            for (int q = 0; q < 4; ++q) den += __expf(l[q] - lm);
            const float pgrp = 1.0f / den;
            const LAS float* le = l + 4 + grp * 8;
            int i1 = 0; float m1 = le[0];
#pragma unroll
            for (int q = 1; q < 8; ++q) if (le[q] > m1) { m1 = le[q]; i1 = q; }
            int i2 = -1; float m2 = -3.0e38f;
#pragma unroll
            for (int q = 0; q < 8; ++q) if (q != i1 && le[q] > m2) { m2 = le[q]; i2 = q; }
            const float ex = __expf(m2 - m1), inv = 1.0f / (1.0f + ex);
            gt0 = pgrp * inv; gt1 = pgrp * ex * inv;
            e0 = grp * 8 + i1; e1 = grp * 8 + i2;
            rk0 = atomicAdd((int*)(lcnt + e0), 1); rk1 = atomicAdd((int*)(lcnt + e1), 1);
        }
        __syncthreads();
        if (tid < 32) lbase[tid] = (int)__hip_atomic_fetch_add(gcnt + tid, (unsigned)lcnt[tid], __ATOMIC_RELAXED, __HIP_MEMORY_SCOPE_AGENT);
        __syncthreads();
        if (tid < 32) {
            const int tok = it * 32 + tid;
            *(i32x4v*)(P.ws + WS_ROUTE + (size_t)tok * 16) = (i32x4v){e0, lbase[e0] + rk0, e1, lbase[e1] + rk1};
            *(f32x2v*)(P.ws + WS_RG + (size_t)tok * 8) = (f32x2v){gt0, gt1};
        }
        __syncthreads();
    }
}
__device__ __forceinline__ void build_tiles(const Ptrs& P, volatile LAS unsigned* MISC, int tid) {
    if (tid == 0) {
        unsigned* gcnt = (unsigned*)(P.ws + WS_CTL) + CW_CNT;
        int run = 0;
        for (int e = 0; e < NE; ++e) {
            const int cnt = (int)__hip_atomic_load(gcnt + e, __ATOMIC_RELAXED, __HIP_MEMORY_SCOPE_AGENT);
            const int nt = (cnt + 255) >> 8;
            MISC[16 + e] = (unsigned)(run * 256);
            MISC[192 + e] = (unsigned)nt;
            run += nt;
        }
        MISC[8] = (unsigned)run;
        for (int x = 0; x < 8; ++x) { int cum = 0;
            for (int k = 0; k < 4; ++k) { const int e = x + 8 * k; MISC[64 + 16 * x + k] = MISC[16 + e] >> 8; MISC[64 + 16 * x + 4 + k] = (unsigned)cum; cum += (int)MISC[192 + e]; }
            MISC[64 + 16 * x + 8] = (unsigned)cum; }
    }
    __syncthreads();
}
__device__ __forceinline__ void phase_p4b(const Ptrs& P, volatile LAS unsigned* MISC, int lane, int wave, int vcu, int G) {
    const bf16* H2 = (const bf16*)(P.ws + WS_RC + 32 * MiB); bf16* XS = (bf16*)(P.ws + WS_RA);
    float* GATE = (float*)(P.ws + WS_GATE);
    const int gw = vcu * NWAVES + wave, NGW = G * NWAVES;
    for (int tok = gw; tok < T; tok += NGW) {
        const i32x4v r = *(const i32x4v*)(P.ws + WS_ROUTE + (size_t)tok * 16);
        const f32x2v g = *(const f32x2v*)(P.ws + WS_RG + (size_t)tok * 8);
        const int s0 = (int)MISC[16 + r.x] + r.y, s1 = (int)MISC[16 + r.z] + r.w;
        const v4u* src = (const v4u*)(H2 + (size_t)tok * D) + lane;
        const v4u a0 = src[0], a1 = src[64];
        v4u* d0 = (v4u*)(XS + (size_t)s0 * D) + lane; v4u* d1 = (v4u*)(XS + (size_t)s1 * D) + lane;
        d0[0] = a0; d0[64] = a1; d1[0] = a0; d1[64] = a1;
        if (lane == 0) { GATE[s0] = g.x; GATE[s1] = g.y; *(i32x2v*)(P.ws + WS_SLOT + (size_t)tok * 8) = (i32x2v){s0, s1}; }
    }
}
__device__ __forceinline__ void phase_p6(const Ptrs& P, int lane, int wave, int vcu, int G) {
    const float* MOD = (const float*)(P.ws + WS_MOD); const float* fg = P.in[28];
    const bf16* Y = (const bf16*)(P.ws + WS_RC);
    const int gw = vcu * NWAVES + wave, NGW = G * NWAVES;
    for (int tok = gw; tok < T; tok += NGW) {
        const i32x2v sl = *(const i32x2v*)(P.ws + WS_SLOT + (size_t)tok * 8);
        const int mr = tok >> 12;
        f32x4* xr = (f32x4*)(P.out + (size_t)tok * D) + lane;
        const u32x2v* y0 = (const u32x2v*)(Y + (size_t)sl.x * D) + lane; const u32x2v* y1 = (const u32x2v*)(Y + (size_t)sl.y * D) + lane;
        const f32x4* g2p = (const f32x4*)(MOD + mr * 6144 + 5120) + lane;
        f32x4 v[4]; float s = 0.f;
#pragma unroll
        for (int j = 0; j < 4; ++j) { const f32x4 xv = xr[64 * j], g2 = g2p[64 * j]; const u32x2v a = y0[64 * j], bq = y1[64 * j];
            f32x4 yy; yy.x = bflo(a.x) + bflo(bq.x); yy.y = bfhi(a.x) + bfhi(bq.x); yy.z = bflo(a.y) + bflo(bq.y); yy.w = bfhi(a.y) + bfhi(bq.y);
            v[j] = xv + g2 * yy; s += (v[j].x * v[j].x + v[j].y * v[j].y) + (v[j].z * v[j].z + v[j].w * v[j].w); }
        const float rstd = 1.0f / sqrtf(wave_sum(s) * (1.f / D) + EPS);
        const f32x4* fgp = (const f32x4*)fg + lane;
#pragma unroll
        for (int j = 0; j < 4; ++j) xr[64 * j] = v[j] * rstd * fgp[64 * j];
    }
}

struct Args { const float* in[29]; float* out; unsigned char* ws; int ph_lo, ph_hi, li, pad; };
__global__ void __launch_bounds__(NWAVES * 64, 2) fwd_kernel(Args args) {
    extern __shared__ __attribute__((aligned(16))) unsigned char lds_raw[];
    LAS unsigned char* lds = (LAS unsigned char*)lds_raw;
    volatile LAS unsigned* MISC = (volatile LAS unsigned*)(lds + MISC_OFF);
    const int tid = threadIdx.x, lane = tid & 63, wave = __builtin_amdgcn_readfirstlane(tid >> 6);
    const int G = gridDim.x; const int bx = blockIdx.x; const int vcu = (G % 8 == 0) ? (bx % 8) * (G / 8) + bx / 8 : bx;
    Ptrs P;
#pragma unroll
    for (int i = 0; i < 29; ++i) P.in[i] = args.in[i];
    P.out = args.out; P.ws = args.ws;
    for (int u = tid; u < (LDS_BYTES - MISC_OFF) / 4; u += NWAVES * 64) MISC[u] = 0u;
    __syncthreads();
    unsigned* ctl = (unsigned*)(P.ws + WS_CTL);
    XcdBarrier bar; bar.bar = ctl + CW_BAR; bar.x = 0; bar.st = nullptr;
    if (N_LAUNCHES == 1) bar = xcd_barrier_post(ctl + CW_BAR, MISC);
#define GRID_BAR() do { if (N_LAUNCHES == 1) xcd_barrier(bar); } while (0)
    const int lo = args.ph_lo, hi = args.ph_hi;
#define IN(k) (lo <= (k) && (k) < hi)
#ifdef PROBE_LO
#define STAMP(k) do { if (bx == 0 && tid == 0) MISC[256 + (k)] = (unsigned)__builtin_amdgcn_s_memrealtime(); } while (0)
#else
#define STAMP(k) do {} while (0)
#endif
    STAMP(0);
#define BOTH(k) (IN(k) && IN((k) + 1))

    if (IN(0)) { phase_p0a(P, lds, tid, lane, wave, vcu, G); if (BOTH(0)) GRID_BAR(); STAMP(1); }
    if (IN(1)) { phase_p0b(P, lane, wave, vcu, G); if (BOTH(1)) GRID_BAR(); STAMP(2); }
    if (IN(2)) {
        pg8::Gemm g{(const pg8::bf16_t*)(P.ws + WS_RA), (const pg8::bf16_t*)(P.ws + WS_WIN), TA, INC, D};
        pg8::OrderInProj S; S.so.init(T, INC, G, bx);
        pg8::EpiStoreBf16 E{(pg8::bf16_t*)(P.ws + WS_RBB), INC};
        pg8::gemm_phase<pg8::EpiStoreBf16, pg8::OrderInProj, true, true>(lds + RING_OFF, g, S, E);
        if (BOTH(2)) GRID_BAR(); STAMP(3);
    }
    if (IN(3)) { phase_p2a(P, lds, tid, lane, wave, vcu, G); if (BOTH(3)) GRID_BAR(); STAMP(4); }
    if (IN(4)) { phase_p2b(P, lds, tid, vcu, G); if (BOTH(4)) GRID_BAR(); STAMP(5); }
    if (IN(5)) { phase_p2c(P, lds, tid, lane, wave, vcu, G); if (BOTH(5)) GRID_BAR(); STAMP(6); }
    if (IN(6)) {
        pg8::Gemm g{(const pg8::bf16_t*)(P.ws + WS_RC), (const pg8::bf16_t*)(P.ws + WS_WOUT), T, D, D};
        pg8::StaticOrder S; S.init(T, D, G, bx);
        pg8::EpiResid E{P.in[0], (const float*)(P.ws + WS_MOD) + 2048, 6144, P.out};
        pg8::gemm_phase<pg8::EpiResid, pg8::StaticOrder, true, true>(lds + RING_OFF, g, S, E);
        if (BOTH(6)) GRID_BAR(); STAMP(7);
    }
    if (IN(7)) { phase_p4a(P, lds, tid, lane, wave, vcu, G); if (BOTH(7)) GRID_BAR(); STAMP(8); }
    if (IN(8)) { build_tiles(P, MISC, tid); phase_p4b(P, MISC, lane, wave, vcu, G); if (BOTH(8)) GRID_BAR(); STAMP(9); }
    if (IN(9)) {
        build_tiles(P, MISC, tid);
        pg8::Gemm g{(const pg8::bf16_t*)(P.ws + WS_RA), (const pg8::bf16_t*)(P.ws + WS_W13), NSLOT, 2048, D};
        pg8::OrderMoe S{bx >> 3, 8, (const LAS int*)(lds + MISC_OFF + 256 + 64 * (bx & 7)), bx & 7};
        pg8::EpiSwiglu E{(pg8::bf16_t*)(P.ws + WS_RBB)};
        pg8::gemm_phase<pg8::EpiSwiglu, pg8::OrderMoe, true, true>(lds + RING_OFF, g, S, E);
        if (BOTH(9)) GRID_BAR(); STAMP(10);
    }
    if (IN(10)) {
        build_tiles(P, MISC, tid);
        pg8::Gemm g{(const pg8::bf16_t*)(P.ws + WS_RBB), (const pg8::bf16_t*)(P.ws + WS_W2), NSLOT, 1024, D};
        pg8::OrderMoe S{bx >> 3, 4, (const LAS int*)(lds + MISC_OFF + 256 + 64 * (bx & 7)), bx & 7};
        pg8::EpiGateBf16 E{(pg8::bf16_t*)(P.ws + WS_RC), (const float*)(P.ws + WS_GATE)};
        pg8::gemm_phase<pg8::EpiGateBf16, pg8::OrderMoe, true, true>(lds + RING_OFF, g, S, E);
        if (BOTH(10)) GRID_BAR(); STAMP(11);
    }
    if (IN(11)) { phase_p6(P, lane, wave, vcu, G); STAMP(12); }
#ifdef PROBE_LO
    if (bx == 0 && tid == 0) {
        const unsigned dt = (MISC[256 + PROBE_HI] - MISC[256 + PROBE_LO]) * PROBE_MULT;
        const unsigned t0 = (unsigned)__builtin_amdgcn_s_memrealtime();
        while ((unsigned)__builtin_amdgcn_s_memrealtime() - t0 < dt) __builtin_amdgcn_s_sleep(32);
    }
#endif
#undef IN
#undef BOTH
}

extern "C" void kernel_launch(void* const* d_in, const int* in_sizes, int n_in, void* d_out, int out_size, void* d_ws, size_t ws_size, hipStream_t stream) {
    static int grid = 0;
    if (grid == 0) {
        if (n_in != 29 || in_sizes[0] != T * D || out_size != T * D || ws_size < WS_END) { fprintf(stderr, "kernel_launch: built for 29 inputs, x and out of %d floats, >= %zu bytes of workspace; got n_in %d, in0 %d, out %d, ws %zu; nothing launched\n", T * D, (size_t)WS_END, n_in, n_in > 0 ? in_sizes[0] : -1, out_size, ws_size); grid = -1; return; }
        int dev = 0, cus = 0, per_cu = 0;
        if (hipGetDevice(&dev) != hipSuccess || hipDeviceGetAttribute(&cus, hipDeviceAttributeMultiprocessorCount, dev) != hipSuccess) { fprintf(stderr, "kernel_launch: hipGetDevice / hipDeviceGetAttribute failed\n"); grid = -1; return; }
        if (hipFuncSetAttribute((const void*)fwd_kernel, hipFuncAttributeMaxDynamicSharedMemorySize, LDS_BYTES) != hipSuccess) { fprintf(stderr, "kernel_launch: hipFuncSetAttribute failed (%d bytes of dynamic LDS)\n", LDS_BYTES); grid = -1; return; }
        if (hipOccupancyMaxActiveBlocksPerMultiprocessor(&per_cu, (const void*)fwd_kernel, NWAVES * 64, LDS_BYTES) != hipSuccess || per_cu < 1)
            fprintf(stderr, "kernel_launch: note: the occupancy query reports %d workgroups per CU\n", per_cu);
        (void)hipGetLastError();
        grid = cus;
    }
    if (grid < 0) return;
    if (hipMemsetAsync((char*)d_ws + WS_CTL, 0, CTL_ZERO_BYTES, stream) != hipSuccess) { fprintf(stderr, "kernel_launch: hipMemsetAsync failed\n"); return; }
    Args a{};
    for (int i = 0; i < 29; ++i) a.in[i] = (const float*)d_in[i];
    a.out = (float*)d_out; a.ws = (unsigned char*)d_ws;
    for (int li = 0; li < N_LAUNCHES; ++li) {
        a.ph_lo = (N_LAUNCHES == 1) ? 0 : li; a.ph_hi = (N_LAUNCHES == 1) ? NPH : li + 1; a.li = li;
        hipLaunchKernelGGL(fwd_kernel, dim3(grid), dim3(NWAVES * 64), LDS_BYTES, stream, a);
        const hipError_t le = hipPeekAtLastError();
        if (le != hipSuccess) { fprintf(stderr, "kernel_launch: launch %d failed: %s\n", li, hipGetErrorName(le)); break; }
    }
}
```
